# Optimizing an MI355X kernel written in HIP

```python
import math
import jax, jax.numpy as jnp
from jax import lax
import numpy as np

D_MODEL = 1024
BATCH = 16
SEQ = 4096
DEPTH = 1

CHUNK = 64
Q_BLOCK = 128
M_HEADS = 4
M_QK_DIM = 64
M_V_DIM = 128
CONV_WIDTH = 4
A_HEADS = 4
A_HEAD_DIM = 64
A_V_DIM = 2 * A_HEAD_DIM
ROPE_THETA = 10000.0
M_WIDTH = M_HEADS * M_V_DIM
A_WIDTH = A_HEADS * A_V_DIM
MIX_WIDTH = M_WIDTH + A_WIDTH
SPLIT_SIZES = (M_HEADS * M_QK_DIM, M_HEADS * M_QK_DIM, M_WIDTH, M_WIDTH, M_HEADS, M_HEADS,
               A_HEADS * 2 * A_HEAD_DIM, A_HEADS * 2 * A_HEAD_DIM, A_WIDTH)
IN_WIDTH = sum(SPLIT_SIZES)
N_EXPERTS = 32
TOP_K = 4
D_FF = D_MODEL
SWIGLU_ALPHA = 1.702
SWIGLU_LIMIT = 7.0
EXPERT_BLOCK = 512
EPS = 1e-6

kernel_name = "hybrid_mlstm_diffattn_moe_block"


def rms_norm(t, g):
    tf = t.astype(jnp.float32)
    y = tf * lax.rsqrt(jnp.mean(tf * tf, axis=-1, keepdims=True) + EPS)
    return (y * g.astype(jnp.float32)).astype(t.dtype)


def causal_depthwise_conv(u, w, b):
    K, C = w.shape
    y = lax.conv_general_dilated(u, w[:, None, :].astype(u.dtype), window_strides=(1,),
                                 padding=[(K - 1, 0)], dimension_numbers=('NWC', 'WIO', 'NWC'),
                                 feature_group_count=C)
    return y + b.astype(u.dtype)


def rope(t, cos, sin):
    half = t.shape[-1] // 2
    t1, t2 = t[..., :half], t[..., half:]
    return jnp.concatenate([t1 * cos - t2 * sin, t2 * cos + t1 * sin], axis=-1).astype(t.dtype)


def to_chunks(t):
    B, S, H, d = t.shape
    return t.reshape(B, S // CHUNK, CHUNK, H, d).transpose(0, 3, 1, 2, 4)


def mlstm_chunkwise(q, k, v, i_pre, logf):
    L = q.shape[3]
    q, k, v = (t.astype(jnp.float32) for t in (q, k, v))
    k = k * (k.shape[-1] ** -0.5)
    b = jnp.cumsum(logf, axis=-1)
    b_last = b[..., -1]
    a = b_last[..., None] - b + i_pre
    m_loc = jnp.max(a, axis=-1)
    w_s = jnp.exp(a - m_loc[..., None])
    C_loc = jnp.einsum('bhnsv,bhnsk->bhnvk', v * w_s[..., None], k)
    n_loc = jnp.einsum('bhns,bhnsk->bhnk', w_s, k)

    def step(carry, inp):
        C, n, m = carry
        Cl, nl, ml, bl = inp
        m_new = jnp.maximum(bl + m, ml)
        decay = jnp.exp(bl + m - m_new)
        fresh = jnp.exp(ml - m_new)
        C_new = decay[..., None, None] * C + fresh[..., None, None] * Cl
        n_new = decay[..., None] * n + fresh[..., None] * nl
        return (C_new, n_new, m_new), (C, n, m)

    Bsz, H, _, _, dk = k.shape
    dv = v.shape[-1]
    init = (jnp.zeros((Bsz, H, dv, dk), jnp.float32), jnp.zeros((Bsz, H, dk), jnp.float32),
            jnp.zeros((Bsz, H), jnp.float32))
    xs = tuple(jnp.moveaxis(t, 2, 0) for t in (C_loc, n_loc, m_loc, b_last))
    _, states = lax.scan(step, init, xs)
    C_prev, n_prev, m_prev = (jnp.moveaxis(t, 0, 2) for t in states)

    causal = jnp.tril(jnp.ones((L, L), dtype=bool))
    d_log = jnp.where(causal, b[..., :, None] - b[..., None, :] + i_pre[..., None, :], -jnp.inf)
    m_inter = b + m_prev[..., None]
    m_t = jnp.maximum(m_inter, jnp.max(d_log, axis=-1))
    d_w = jnp.exp(d_log - m_t[..., None])
    inter_w = jnp.exp(m_inter - m_t)
    s = jnp.einsum('bhntk,bhnsk->bhnts', q, k) * d_w
    num = jnp.einsum('bhnts,bhnsv->bhntv', s, v) + inter_w[..., None] * jnp.einsum('bhnvk,bhntk->bhntv', C_prev, q)
    den = jnp.sum(s, axis=-1) + inter_w * jnp.einsum('bhnk,bhntk->bhnt', n_prev, q)
    return num / jnp.maximum(jnp.abs(den), jnp.exp(-m_t))[..., None]


def diff_attention(q, k, v, lam):
    B, H, _, S, dh = q.shape
    dv = v.shape[-1]
    key_chunk = jnp.arange(S) // CHUNK
    scale = dh ** -0.5

    def block(i):
        start = i * Q_BLOCK
        qb = lax.dynamic_slice_in_dim(q, start, Q_BLOCK, axis=3)
        s = jnp.einsum('bhmqd,bhmkd->bhmqk', qb, k).astype(jnp.float32) * scale
        q_chunk = (start + jnp.arange(Q_BLOCK)) // CHUNK
        mask = key_chunk[None, :] <= q_chunk[:, None]
        p = jax.nn.softmax(jnp.where(mask, s, -jnp.inf), axis=-1)
        a = p[:, :, 0] - lam * p[:, :, 1]
        return jnp.einsum('bhqk,bhkv->bhqv', a.astype(v.dtype), v)

    o = lax.map(block, jnp.arange(S // Q_BLOCK))
    return o.transpose(1, 0, 3, 2, 4).reshape(B, S, H, dv)


def moe_ffn(h, w_router, b_router, w_gu, b_gu, w_down, b_down):
    B, S, D = h.shape
    N = B * S
    hf = h.reshape(N, D)
    logits = jnp.dot(hf, w_router).astype(jnp.float32) + b_router.astype(jnp.float32)
    top_val, top_idx = lax.top_k(logits, TOP_K)
    gates = jax.nn.softmax(top_val, axis=-1)
    n_slots = N * TOP_K
    e_flat = top_idx.reshape(-1)
    tok_flat = jnp.arange(n_slots, dtype=jnp.int32) // TOP_K
    g_flat = gates.reshape(-1)
    order = jnp.argsort(e_flat)
    e_sorted = e_flat[order]
    sizes = jnp.bincount(e_flat, length=N_EXPERTS)
    group_start = jnp.cumsum(sizes) - sizes
    padded = ((sizes + EXPERT_BLOCK - 1) // EXPERT_BLOCK) * EXPERT_BLOCK
    padded_end = jnp.cumsum(padded)
    padded_start = padded_end - padded
    dest = padded_start[e_sorted] + (jnp.arange(n_slots) - group_start[e_sorted])
    n_rows = ((n_slots + EXPERT_BLOCK - 1) // EXPERT_BLOCK) * EXPERT_BLOCK + N_EXPERTS * EXPERT_BLOCK
    row_tok = jnp.zeros((n_rows,), jnp.int32).at[dest].set(tok_flat[order])
    row_gate = jnp.zeros((n_rows,), jnp.float32).at[dest].set(g_flat[order])
    n_blocks = n_rows // EXPERT_BLOCK
    block_expert = jnp.minimum(jnp.searchsorted(padded_end, jnp.arange(n_blocks) * EXPERT_BLOCK, side='right'),
                               N_EXPERTS - 1)

    def body(y, inp):
        bi, e = inp
        idx = lax.dynamic_slice_in_dim(row_tok, bi * EXPERT_BLOCK, EXPERT_BLOCK)
        g = lax.dynamic_slice_in_dim(row_gate, bi * EXPERT_BLOCK, EXPERT_BLOCK)
        xb = hf[idx]
        gu = jnp.dot(xb, w_gu[e]) + b_gu[e]
        gate = jnp.minimum(gu[:, 0::2], SWIGLU_LIMIT)
        up = jnp.clip(gu[:, 1::2], -SWIGLU_LIMIT, SWIGLU_LIMIT)
        act = (up + 1.0) * (gate * jax.nn.sigmoid(SWIGLU_ALPHA * gate))
        out = jnp.dot(act, w_down[e]) + b_down[e]
        y = y.at[idx].add(out * g[:, None].astype(out.dtype))
        return y, None

    y, _ = lax.scan(body, jnp.zeros_like(hf), (jnp.arange(n_blocks), block_expert))
    return y.reshape(B, S, D)


def setup_inputs(seed: int = 0) -> dict:
    key = jax.random.key(seed)
    ks = jax.random.split(key, 32)
    f32 = jnp.float32
    L, D = DEPTH, D_MODEL
    nrm = lambda k, shape, s: jax.random.normal(k, shape, f32) * s
    return {
        "x": nrm(ks[0], (BATCH, SEQ, D), 1.0),
        "c": nrm(ks[1], (BATCH, D), 1.0),
        "w_ada": nrm(ks[2], (L, D, 6 * D), 0.5 * D ** -0.5),
        "b_ada": nrm(ks[3], (L, 6 * D), 0.02),
        "norm1_g": 1.0 + nrm(ks[4], (L, D), 0.02),
        "w_in": nrm(ks[5], (L, D, IN_WIDTH), D ** -0.5),
        "conv_w": nrm(ks[6], (L, CONV_WIDTH, 2 * M_HEADS * M_QK_DIM), CONV_WIDTH ** -0.5),
        "conv_b": nrm(ks[7], (L, 2 * M_HEADS * M_QK_DIM), 0.02),
        "b_igate": nrm(ks[8], (L, M_HEADS), 0.1),
        "b_fgate": jnp.linspace(3.0, 6.0, M_HEADS, dtype=f32)[None, :] + nrm(ks[9], (L, M_HEADS), 0.1),
        "mlstm_norm_g": 1.0 + nrm(ks[10], (L, M_WIDTH), 0.02),
        "q_norm_g": 1.0 + nrm(ks[11], (L, A_HEAD_DIM), 0.02),
        "k_norm_g": 1.0 + nrm(ks[12], (L, A_HEAD_DIM), 0.02),
        "lambda_q1": nrm(ks[13], (L, A_HEAD_DIM), 0.1),
        "lambda_k1": nrm(ks[14], (L, A_HEAD_DIM), 0.1),
        "lambda_q2": nrm(ks[15], (L, A_HEAD_DIM), 0.1),
        "lambda_k2": nrm(ks[16], (L, A_HEAD_DIM), 0.1),
        "diff_norm_g": 1.0 + nrm(ks[17], (L, A_WIDTH), 0.02),
        "w_out": nrm(ks[18], (L, MIX_WIDTH, D), MIX_WIDTH ** -0.5),
        "norm2_g": 1.0 + nrm(ks[19], (L, D), 0.02),
        "w_router": nrm(ks[20], (L, D, N_EXPERTS), D ** -0.5),
        "b_router": nrm(ks[21], (L, N_EXPERTS), 0.01),
        "w_gu": nrm(ks[22], (L, N_EXPERTS, D, 2 * D_FF), D ** -0.5),
        "b_gu": nrm(ks[23], (L, N_EXPERTS, 2 * D_FF), 0.01),
        "w_down": nrm(ks[24], (L, N_EXPERTS, D_FF, D), D_FF ** -0.5),
        "b_down": nrm(ks[25], (L, N_EXPERTS, D), 0.01),
    }


def reference(x, c, w_ada, b_ada, norm1_g, w_in, conv_w, conv_b, b_igate, b_fgate, mlstm_norm_g,
              q_norm_g, k_norm_g, lambda_q1, lambda_k1, lambda_q2, lambda_k2, diff_norm_g, w_out,
              norm2_g, w_router, b_router, w_gu, b_gu, w_down, b_down):
    B, S, D = x.shape
    split_idx = np.cumsum(SPLIT_SIZES)[:-1].tolist()
    pos = jnp.arange(S, dtype=jnp.float32)
    inv_freq = ROPE_THETA ** (-jnp.arange(0, A_HEAD_DIM, 2, dtype=jnp.float32) / A_HEAD_DIM)
    ang = pos[:, None] * inv_freq[None, :]
    cos, sin = jnp.cos(ang).astype(x.dtype), jnp.sin(ang).astype(x.dtype)
    cond = jax.nn.silu(c)
    for l in range(DEPTH):
        lambda_init = 0.8 - 0.6 * math.exp(-0.3 * l)
        mod = jnp.dot(cond, w_ada[l]) + b_ada[l]
        shift1, scale1, gate1, shift2, scale2, gate2 = (m[:, None, :] for m in jnp.split(mod, 6, axis=-1))

        h = rms_norm(x, norm1_g[l]) * (1.0 + scale1) + shift1
        p = jnp.dot(h, w_in[l])
        mq, mk, mv, mo, mi, mf, aq, ak, av = jnp.split(p, split_idx, axis=-1)

        qk = jax.nn.silu(causal_depthwise_conv(jnp.concatenate([mq, mk], axis=-1), conv_w[l], conv_b[l]))
        mq, mk = jnp.split(qk, 2, axis=-1)
        mq = mq.reshape(B, S, M_HEADS, M_QK_DIM)
        mk = mk.reshape(B, S, M_HEADS, M_QK_DIM)
        mv = mv.reshape(B, S, M_HEADS, M_V_DIM)
        i_pre = (mi.astype(jnp.float32) + b_igate[l].astype(jnp.float32)).reshape(B, S // CHUNK, CHUNK, M_HEADS).transpose(0, 3, 1, 2)
        logf = jax.nn.log_sigmoid(mf.astype(jnp.float32) + b_fgate[l].astype(jnp.float32)).reshape(B, S // CHUNK, CHUNK, M_HEADS).transpose(0, 3, 1, 2)
        hm = mlstm_chunkwise(to_chunks(mq), to_chunks(mk), to_chunks(mv), i_pre, logf)
        hm = hm.transpose(0, 2, 3, 1, 4).reshape(B, S, M_HEADS, M_V_DIM).astype(x.dtype)
        hm = rms_norm(hm, mlstm_norm_g[l].reshape(M_HEADS, M_V_DIM))
        hm = (hm * jax.nn.sigmoid(mo).reshape(B, S, M_HEADS, M_V_DIM)).reshape(B, S, M_WIDTH)

        aq = rms_norm(aq.reshape(B, S, A_HEADS, 2, A_HEAD_DIM), q_norm_g[l]).transpose(0, 2, 3, 1, 4)
        ak = rms_norm(ak.reshape(B, S, A_HEADS, 2, A_HEAD_DIM), k_norm_g[l]).transpose(0, 2, 3, 1, 4)
        aq, ak = rope(aq, cos, sin), rope(ak, cos, sin)
        av = av.reshape(B, S, A_HEADS, A_V_DIM).transpose(0, 2, 1, 3)
        lam = (jnp.exp(jnp.sum(lambda_q1[l].astype(jnp.float32) * lambda_k1[l].astype(jnp.float32)))
               - jnp.exp(jnp.sum(lambda_q2[l].astype(jnp.float32) * lambda_k2[l].astype(jnp.float32)))
               + lambda_init)
        ha = diff_attention(aq, ak, av, lam)
        ha = (rms_norm(ha, diff_norm_g[l].reshape(A_HEADS, A_V_DIM)) * (1.0 - lambda_init)).reshape(B, S, A_WIDTH)

        mix = jnp.dot(jnp.concatenate([hm, ha], axis=-1), w_out[l])
        x = x + gate1 * mix

        h2 = rms_norm(x, norm2_g[l]) * (1.0 + scale2) + shift2
        x = x + gate2 * moe_ffn(h2, w_router[l], b_router[l], w_gu[l], b_gu[l], w_down[l], b_down[l])
    return x
```

```cpp
#include <hip/hip_runtime.h>
#include <cstdio>
#include <cstdint>
#include <cmath>

#define LAS __attribute__((address_space(3)))
#define GAS __attribute__((address_space(1)))
typedef unsigned short bf16;
typedef short bf16x8 __attribute__((ext_vector_type(8)));
typedef short s16x4 __attribute__((ext_vector_type(4)));
typedef float f32x2 __attribute__((ext_vector_type(2)));
typedef float f32x4 __attribute__((ext_vector_type(4)));
typedef float f32x16 __attribute__((ext_vector_type(16)));
typedef unsigned u32x2 __attribute__((ext_vector_type(2)));
typedef unsigned u32x4 __attribute__((ext_vector_type(4)));
typedef __bf16 bf16x2_t __attribute__((ext_vector_type(2)));
typedef int i32x4 __attribute__((ext_vector_type(4)));
typedef int i32x8 __attribute__((ext_vector_type(8)));

constexpr int D = 1024, BATCH = 16, SEQ = 4096, NTOK = BATCH * SEQ;
constexpr int NP = 3072;
constexpr int P_MQ = 0, P_MK = 256, P_MV = 512, P_MO = 1024, P_AQ = 1536, P_AK = 2048, P_AV = 2560;
constexpr int IN_W = 3080;
constexpr int NE = 32, DFF = 1024, NSLOT = NTOK * 4;
constexpr int CHUNK = 64, NCH = SEQ / CHUNK, NUNIT = BATCH * 4 * NCH;
constexpr float EPS = 1e-6f;
constexpr int MAXTILES = 1056;

constexpr size_t MiB = 1u << 20;
constexpr size_t WS_CTL = 0, CTL_ZERO_BYTES = 65536;
constexpr size_t WS_MOD = 1 * MiB, WS_ROPE = 2 * MiB, WS_WG = 3 * MiB, WS_WRT = 3 * MiB + 65536, WS_BGU = 3 * MiB + 262144;
constexpr size_t WS_GATES = 4 * MiB, WS_WINT = 6 * MiB, WS_WOUTT = 12 * MiB;
constexpr size_t WS_ML = 14 * MiB, WS_BL = 14 * MiB + 65536, WS_MPREV = 14 * MiB + 131072, WS_NL = 15 * MiB, WS_NPREV = 16 * MiB;
constexpr size_t WS_META = 17 * MiB, WS_GATEW = 18 * MiB, WS_POS = 19 * MiB, WS_ROWTOK = 20 * MiB, WS_WGBASE = 22 * MiB, WS_IDENT = 22 * MiB + 65536;
constexpr size_t WS_H = 24 * MiB;
constexpr size_t WS_P = 152 * MiB;
constexpr size_t WS_CL = 536 * MiB, WS_CPREV = 600 * MiB, WS_O = 664 * MiB;
constexpr size_t WS_WGUT = 152 * MiB;
constexpr size_t WS_ACT = 560 * MiB;
constexpr size_t WS_OUTROWS = 24 * MiB;
constexpr size_t WS_WDT = 832 * MiB;
constexpr size_t WS_MIXG = 896 * MiB;
constexpr size_t WS_END = 1024 * MiB;
static_assert(WS_OUTROWS + (size_t)MAXTILES * 256 * 2048 <= WS_ACT && WS_ACT + (size_t)MAXTILES * 256 * 1024 <= WS_WDT, "ws map");
constexpr int CW_TMO = 0, CW_BAR = 4096, CW_GCNT = 8192;
static_assert((CW_GCNT + 64) * 4 <= (int)CTL_ZERO_BYTES && (CW_BAR + 3456) <= CW_GCNT, "control words inside the per-call memset");

constexpr int RING_OFF = 0, RING_BYTES = 131072;
constexpr int LDSCTL_OFF = RING_BYTES;
constexpr int MISC_OFF = LDSCTL_OFF + 320;
constexpr int TAB_OFF = LDSCTL_OFF + 1024;
constexpr int LDS_BYTES = 147456;
constexpr int NWAVES = 8;

__device__ __forceinline__ float bf2f(unsigned h) { return __uint_as_float(h << 16); }
__device__ __forceinline__ unsigned pk2(float lo, float hi) { f32x2 v = {lo, hi}; bf16x2_t b = __builtin_convertvector(v, bf16x2_t); return __builtin_bit_cast(unsigned, b); }
__device__ __forceinline__ bf16 f2bf(float f) { return (bf16)(pk2(f, 0.f) & 0xffffu); }
__device__ __forceinline__ unsigned pk4_fp8(float a, float b, float c, float d) { int p = __builtin_amdgcn_cvt_pk_fp8_f32(a, b, 0, false); return (unsigned)__builtin_amdgcn_cvt_pk_fp8_f32(c, d, p, true); }
#define DPP_STEP(T2I, I2T, OP, x, idn, ctrl, rmask) OP(x, I2T(__builtin_amdgcn_update_dpp(T2I(idn), T2I(x), ctrl, rmask, 0xF, false)))
#define DPP_REDUCE(T2I, I2T, OP, x, idn) do { x = DPP_STEP(T2I, I2T, OP, x, idn, 0x111, 0xF); x = DPP_STEP(T2I, I2T, OP, x, idn, 0x112, 0xF); x = DPP_STEP(T2I, I2T, OP, x, idn, 0x114, 0xF); \
    x = DPP_STEP(T2I, I2T, OP, x, idn, 0x118, 0xF); x = DPP_STEP(T2I, I2T, OP, x, idn, 0x142, 0xA); x = DPP_STEP(T2I, I2T, OP, x, idn, 0x143, 0xC); } while (0)
#define OP_ADDF(a, b) ((a) + (b))
#define OP_MAXF(a, b) fmaxf((a), (b))
#define OP_MINI(a, b) ((b) < (a) ? (b) : (a))
#define ID_I(x) (x)
__device__ __forceinline__ float wave_sum(float v) { DPP_REDUCE(__float_as_int, __int_as_float, OP_ADDF, v, 0.f); return __int_as_float(__builtin_amdgcn_readlane(__float_as_int(v), 63)); }
__device__ __forceinline__ float wave_max(float v) {
#pragma unroll
    for (int o = 1; o < 64; o <<= 1) v = fmaxf(v, __shfl_xor(v, o));
    return v;
}
__device__ __forceinline__ int wave_min_i(int v) {
#pragma unroll
    for (int o = 1; o < 64; o <<= 1) { int t = __shfl_xor(v, o); v = t < v ? t : v; }
    return v;
}
__device__ __forceinline__ float half_sum32(float v) {
#pragma unroll
    for (int o = 1; o < 32; o <<= 1) v += __shfl_xor(v, o);
    return v;
}
__device__ __forceinline__ float rcp_(float x) { return __builtin_amdgcn_rcpf(x); }
__device__ __forceinline__ float rsq_(float x) { return __builtin_amdgcn_rsqf(x); }
__device__ __forceinline__ float sigmoidf_(float z) { return rcp_(1.f + __expf(-z)); }
#define LDS_WAIT() asm volatile("s_waitcnt lgkmcnt(0)" ::: "memory")
#define VM_WAIT() asm volatile("s_waitcnt vmcnt(0)" ::: "memory")

namespace pg8 {
#define PG8_LAS __attribute__((address_space(3)))
constexpr int BM = 256, BK = 64, HALF = 128, HTB = HALF * BK * 2, STAGE_BYTES = 8 * HTB, NXCD = 8, WGM = 8;
__host__ __device__ __forceinline__ int lds_byte(int r, int c) { const int st = (r >> 4) * 2 + (c >> 5), rr = r & 15, cc = c & 31, ob = rr * 64 + cc * 2; return st * 1024 + (ob ^ (((ob >> 9) & 1) << 5)); }
__host__ __device__ __forceinline__ void stage_rc(int b, int& R, int& C) { const int st = b / 1024, sb = b % 1024, swz = sb ^ (((sb >> 9) & 1) << 5); R = (st >> 1) * 16 + swz / 64; C = (st & 1) * 32 + (swz % 64) / 2; }
__host__ __device__ __forceinline__ int perm32(int rho) { const int n = rho >> 4, i = rho & 15; return 8 * (i >> 2) + 4 * n + (i & 3); }

struct Unit { int pm, pn, e; const char* a; const char* b; };

__device__ __forceinline__ bool tile_of(long L, int nM, int nN, int& pm, int& pn) {
    const int nwg = nM * nN; if (L >= nwg) return false;
    int wgid = (int)L; { const int q = nwg / NXCD, r = nwg % NXCD, xcd = wgid % NXCD, off = wgid / NXCD; wgid = (xcd < r ? xcd * (q + 1) : r * (q + 1) + (xcd - r) * q) + off; }
    const int nig = WGM * nN, gid = wgid / nig, fm = gid * WGM, gsz = (nM - fm) < WGM ? (nM - fm) : WGM;
    pm = fm + ((wgid % nig) % gsz); pn = (wgid % nig) / gsz; return true;
}
struct PlainOrder {
    int nM, nN, G, c; const char* A; const char* Bt; size_t tstep;
    __device__ __forceinline__ void init(int M, int N, int K, int G_, int c_, const void* A_, const void* Bt_) { nM = M / BM; nN = N / BM; G = G_; c = c_; A = (const char*)A_; Bt = (const char*)Bt_; tstep = (size_t)BM * K * 2; }
    __device__ __forceinline__ bool next(int i, Unit& u) const {
        if (!tile_of((long)i * G + c, nM, nN, u.pm, u.pn)) return false;
        u.e = 0; u.a = A + (size_t)u.pm * tstep; u.b = Bt + (size_t)u.pn * tstep; return true;
    }
};
struct MoeOrder {
    int nM, nN, G, c; const char* A0; const char* Bt; size_t tstep, estride; const LAS int* ptile; bool gather;
    __device__ __forceinline__ bool next(int i, Unit& u) const {
        if (!tile_of((long)i * G + c, nM, nN, u.pm, u.pn)) return false;
        int e = 0;
#pragma unroll
        for (int s = 16; s >= 1; s >>= 1) { if (ptile[e + s] <= u.pm) e += s; }
        u.e = e; u.b = Bt + (size_t)e * estride + (size_t)u.pn * tstep;
        u.a = gather ? A0 : A0 + (size_t)u.pm * tstep;
        return true;
    }
};

template <bool OUT8, bool HASB>
struct EpiOut {
    static constexpr bool HAS_VEC = HASB, ACC_BIAS = false;
    bf16* O; int ldc; const float* bias; int bstride; float ascale;
    __device__ __forceinline__ const float* vec_ptr(const Unit& u) const { return bias + (size_t)u.e * bstride + u.pn * BM; }
    __device__ __forceinline__ void operator()(const f32x4 (&acc)[2][2][4][2], const Unit& u, int wr, int wc, int fr, int fq, const PG8_LAS float* vl) const {
        asm volatile("" : "+v"(fr), "+v"(fq));
        const int row0 = u.pm * BM + wr * 64 + fr, col0 = u.pn * BM + wc * 64 + 16 * fq;
        f32x4 bv[2][2];
#pragma unroll
        for (int bj = 0; bj < 2; ++bj)
#pragma unroll
            for (int n = 0; n < 2; ++n) bv[bj][n] = HASB ? *(const PG8_LAS f32x4*)(vl + wc * 64 + 16 * fq + 8 * bj + 4 * n) : (f32x4){0.f, 0.f, 0.f, 0.f};
#pragma unroll
        for (int ai = 0; ai < 2; ++ai)
#pragma unroll
            for (int m = 0; m < 4; ++m) { bf16* rowp = O + (size_t)(row0 + ai * HALF + m * 16) * ldc + col0;
                const f32x4 v00 = acc[ai][0][m][0] * ascale + bv[0][0], v01 = acc[ai][0][m][1] * ascale + bv[0][1], v10 = acc[ai][1][m][0] * ascale + bv[1][0], v11 = acc[ai][1][m][1] * ascale + bv[1][1];
                if constexpr (OUT8) { *(u32x4*)((unsigned char*)O + (size_t)(row0 + ai * HALF + m * 16) * ldc + col0) = (u32x4){pk4_fp8(v00[0], v00[1], v00[2], v00[3]), pk4_fp8(v01[0], v01[1], v01[2], v01[3]), pk4_fp8(v10[0], v10[1], v10[2], v10[3]), pk4_fp8(v11[0], v11[1], v11[2], v11[3])}; }
                else { *(u32x4*)rowp = (u32x4){pk2(v00[0], v00[1]), pk2(v00[2], v00[3]), pk2(v01[0], v01[1]), pk2(v01[2], v01[3])};
                    *(u32x4*)(rowp + 8) = (u32x4){pk2(v10[0], v10[1]), pk2(v10[2], v10[3]), pk2(v11[0], v11[1]), pk2(v11[2], v11[3])}; } }
    }
};
typedef EpiOut<false, false> EpiBf16;
struct EpiScaleBf16 {
    static constexpr bool HAS_VEC = true, ACC_BIAS = false;
    bf16* O; int ldc; const float* scale; int spitch;
    __device__ __forceinline__ const float* vec_ptr(const Unit& u) const { return scale + (size_t)((u.pm * BM) / SEQ) * spitch + u.pn * BM; }
    __device__ __forceinline__ void operator()(const f32x4 (&acc)[2][2][4][2], const Unit& u, int wr, int wc, int fr, int fq, const PG8_LAS float* vl) const {
        asm volatile("" : "+v"(fr), "+v"(fq));
        const int row0 = u.pm * BM + wr * 64 + fr, col0 = u.pn * BM + wc * 64 + 16 * fq;
        f32x4 sv[2][2];
#pragma unroll
        for (int bj = 0; bj < 2; ++bj)
#pragma unroll
            for (int n = 0; n < 2; ++n) sv[bj][n] = *(const PG8_LAS f32x4*)(vl + wc * 64 + 16 * fq + 8 * bj + 4 * n);
#pragma unroll
        for (int ai = 0; ai < 2; ++ai)
#pragma unroll
            for (int m = 0; m < 4; ++m) { bf16* rowp = O + (size_t)(row0 + ai * HALF + m * 16) * ldc + col0;
#pragma unroll
                for (int bj = 0; bj < 2; ++bj) { const f32x4 v0 = acc[ai][bj][m][0] * sv[bj][0], v1 = acc[ai][bj][m][1] * sv[bj][1];
                    u32x4 w; w.x = pk2(v0[0], v0[1]); w.y = pk2(v0[2], v0[3]); w.z = pk2(v1[0], v1[1]); w.w = pk2(v1[2], v1[3]);
                    *(u32x4*)(rowp + 8 * bj) = w; } }
    }
};
struct EpiSwiglu {
    static constexpr bool HAS_VEC = false, ACC_BIAS = true;
    unsigned char* O; const float* bias; float ascale;
    __device__ __forceinline__ const float* vec_ptr(const Unit& u) const { return bias + (size_t)u.e * 2048 + u.pn * BM; }
    __device__ __forceinline__ void acc_init(f32x4 (&acc)[2][2][4][2], const PG8_LAS float* vl, int wc, int fq) const {
        int q_ = fq; asm volatile("" : "+v"(q_));
        const PG8_LAS float* bp = vl + wc * 64 + 16 * q_;
        const float inv = 1.f / ascale;
#pragma unroll
        for (int b = 0; b < 2; ++b)
#pragma unroll
            for (int n = 0; n < 2; ++n) { const f32x4 v = *(const PG8_LAS f32x4*)(bp + 8 * b + 4 * n) * inv;
#pragma unroll
                for (int a = 0; a < 2; ++a)
#pragma unroll
                    for (int m = 0; m < 4; ++m) acc[a][b][m][n] = v; }
    }
    __device__ __forceinline__ void operator()(const f32x4 (&acc)[2][2][4][2], const Unit& u, int wr, int wc, int fr, int fq, const PG8_LAS float* vl) const {
        (void)vl;
        asm volatile("" : "+v"(fr), "+v"(fq));
        unsigned char* base = O + (size_t)u.pm * BM * DFF;
        const int row0 = wr * 64 + fr, cin = wc * 32 + 8 * fq;
        const float sc = ascale, lim = 7.f / sc, glo = -50.f / sc, s2 = sc * sc, kk = sc * (-1.702f * 1.4426950408889634f);
#pragma unroll
        for (int ai = 0; ai < 2; ++ai)
#pragma unroll
            for (int m = 0; m < 4; ++m) {
                float o[8];
#pragma unroll
                for (int n = 0; n < 2; ++n) { const f32x4 g4 = acc[ai][0][m][n], u4 = acc[ai][1][m][n];
#pragma unroll
                    for (int p = 0; p < 2; ++p) {
                        f32x2 g, up; g.x = __builtin_amdgcn_fmed3f(g4[2 * p], glo, lim); g.y = __builtin_amdgcn_fmed3f(g4[2 * p + 1], glo, lim);
                        up.x = __builtin_amdgcn_fmed3f(u4[2 * p], -lim, lim); up.y = __builtin_amdgcn_fmed3f(u4[2 * p + 1], -lim, lim);
                        const f32x2 t = g * kk;
                        f32x2 e; e.x = __builtin_amdgcn_exp2f(t.x); e.y = __builtin_amdgcn_exp2f(t.y);
                        const f32x2 d = e + 1.f;
                        const float rp = __builtin_amdgcn_rcpf(d.x * d.y);
                        const f32x2 r = (f32x2){d.y, d.x} * rp;
                        const f32x2 a2 = (up * s2 + sc) * g * r;
                        o[4 * n + 2 * p] = a2.x; o[4 * n + 2 * p + 1] = a2.y; } }
                *(u32x2*)(base + (size_t)(row0 + ai * HALF + m * 16) * DFF + u.pn * HALF + cin) = (u32x2){pk4_fp8(o[0], o[1], o[2], o[3]), pk4_fp8(o[4], o[5], o[6], o[7])};
                __builtin_amdgcn_sched_barrier(0);
            }
    }
};

template <class Epi, class Sched, bool GATHER, bool FP8 = false>
__device__ __forceinline__ void gemm_phase(PG8_LAS unsigned char* lds, const int K, const Sched& S, const Epi& E, const int* rowtok) {
    int tid_ = threadIdx.x; asm volatile("" : "+v"(tid_));
    const int tid = tid_, wid = __builtin_amdgcn_readfirstlane(tid >> 6), lane = tid & 63, wr = wid >> 2, wc = wid & 3, fr = lane & 15, fq = lane >> 4;
    const int rowB = FP8 ? K : 2 * K;
    const int nt = rowB / (BK * 2);
    unsigned voffB[2];
#pragma unroll
    for (int i = 0; i < 2; ++i) { int R, C; stage_rc(tid * 16 + i * 8192, R, C); const int Rb = 64 * (R >> 5) + 16 * ((R & 15) >> 2) + 4 * ((R >> 4) & 1) + (R & 3); voffB[i] = (unsigned)(Rb * rowB + C * 2); }
    const size_t kstep = (size_t)(BK * 2);
    const size_t hstep = (size_t)HALF * rowB, hstepB = (size_t)8 * rowB;
    const unsigned ldsw = (unsigned)wid * 1024u;
    const int aoff = lds_byte(wr * 64 + fr, fq * 8), boff = lds_byte(wc * 32 + fr, fq * 8);
#define PG8_SA(b, h) (((b) * 2 + (h)) * HTB)
#define PG8_SB(b, h) ((4 + (b) * 2 + (h)) * HTB)
#define PG8_STAGE2(bufoff, gbase, o0, o1) do { \
        __builtin_amdgcn_global_load_lds((const unsigned*)((const char*)(gbase) + (o0)), (PG8_LAS unsigned*)(lds + (bufoff) + ldsw), 16, 0, 0); \
        __builtin_amdgcn_global_load_lds((const unsigned*)((const char*)(gbase) + (o1)), (PG8_LAS unsigned*)(lds + (bufoff) + ldsw + 8192), 16, 0, 0); } while (0)
#define PG8_STAGE_B(bufoff, gbase) PG8_STAGE2(bufoff, gbase, voffB[0], voffB[1])
#define PG8_CAT8(x0, x1) __builtin_shufflevector(x0, x1, 0, 1, 2, 3, 4, 5, 6, 7)
#define PG8_LDA(dst, b, h) do { _Pragma("unroll") for (int m = 0; m < 4; ++m) { \
        if constexpr (FP8) dst##8[m] = PG8_CAT8(*(const PG8_LAS i32x4*)(lds + PG8_SA(b, h) + aoff + m * 2048), *(const PG8_LAS i32x4*)(lds + PG8_SA(b, h) + aoff + m * 2048 + 1024)); \
        else { _Pragma("unroll") for (int k = 0; k < 2; ++k) dst[m][k] = *(const PG8_LAS bf16x8*)(lds + PG8_SA(b, h) + aoff + m * 2048 + k * 1024); } } } while (0)
#define PG8_LDB(dst, b, h) do { _Pragma("unroll") for (int n = 0; n < 2; ++n) { \
        if constexpr (FP8) dst##8[n] = PG8_CAT8(*(const PG8_LAS i32x4*)(lds + PG8_SB(b, h) + boff + n * 2048), *(const PG8_LAS i32x4*)(lds + PG8_SB(b, h) + boff + n * 2048 + 1024)); \
        else { _Pragma("unroll") for (int k = 0; k < 2; ++k) dst[n][k] = *(const PG8_LAS bf16x8*)(lds + PG8_SB(b, h) + boff + n * 2048 + k * 1024); } } } while (0)
#define PG8_MMA(ai, bj, At, Bt) do { __builtin_amdgcn_s_setprio(1); _Pragma("unroll") for (int m = 0; m < 4; ++m) _Pragma("unroll") for (int n = 0; n < 2; ++n) { \
        if constexpr (FP8) acc[ai][bj][m][n] = __builtin_amdgcn_mfma_scale_f32_16x16x128_f8f6f4(Bt##8[n], At##8[m], acc[ai][bj][m][n], 0, 0, 0, 0x7F7F7F7F, 0, 0x7F7F7F7F); \
        else { _Pragma("unroll") for (int k = 0; k < 2; ++k) acc[ai][bj][m][n] = __builtin_amdgcn_mfma_f32_16x16x32_bf16(Bt[n][k], At[m][k], acc[ai][bj][m][n], 0, 0, 0); } } \
        __builtin_amdgcn_s_setprio(0); } while (0)
#define PG8_WAIT_V(n) asm volatile("s_waitcnt vmcnt(" #n ")" ::: "memory")
#define PG8_WAIT_L(n) asm volatile("s_waitcnt lgkmcnt(" #n ")" ::: "memory")
#define PG8_BAR __builtin_amdgcn_s_barrier()
#define PG8_SCHED __builtin_amdgcn_sched_barrier(0)
#define PG8_SETOFF(v, u) do { _Pragma("unroll") for (int h_ = 0; h_ < 2; ++h_) _Pragma("unroll") for (int i_ = 0; i_ < 2; ++i_) { int R_, C_; stage_rc(tid * 16 + i_ * 8192, R_, C_); \
        if constexpr (GATHER) { const unsigned tok_ = (unsigned)rowtok[(u).pm * BM + h_ * HALF + R_]; v[h_][i_] = tok_ * (unsigned)rowB + (unsigned)(C_ * 2); } \
        else v[h_][i_] = (unsigned)(R_ * rowB + C_ * 2) + (unsigned)(h_ * hstep); } } while (0)
    Unit cur, nxt; int ui = 0;
    if (!S.next(0, cur)) return;
    f32x4 acc[2][2][4][2];
#pragma unroll
    for (int a = 0; a < 2; ++a)
#pragma unroll
        for (int b = 0; b < 2; ++b)
#pragma unroll
            for (int m = 0; m < 4; ++m)
#pragma unroll
                for (int n = 0; n < 2; ++n) acc[a][b][m][n] = (f32x4){0.f, 0.f, 0.f, 0.f};
    bf16x8 At[4][2], B0[2][2], B1[2][2];
    i32x8 At8[4], B08[2], B18[2];
    unsigned vA[2][2];
    PG8_SETOFF(vA, cur);
    PG8_LAS float* vecbuf = (PG8_LAS float*)(lds + STAGE_BYTES + 4096 + 2048);
    PG8_LAS int* tokbuf = (PG8_LAS int*)(lds + STAGE_BYTES + 4096);
    const char* cA = cur.a; const char* cB = cur.b;
    if constexpr (Epi::ACC_BIAS) { if (wid == 0) __builtin_amdgcn_global_load_lds((const unsigned*)(E.vec_ptr(cur) + lane * 4), (PG8_LAS unsigned*)vecbuf, 16, 0, 0); }
    PG8_STAGE_B(PG8_SB(0, 0), cB); PG8_STAGE_B(PG8_SB(0, 1), cB + hstepB); PG8_STAGE2(PG8_SA(0, 0), cA, vA[0][0], vA[0][1]); PG8_STAGE2(PG8_SA(0, 1), cA, vA[1][0], vA[1][1]);
    if (wr == 1) PG8_BAR;
    PG8_WAIT_V(2); PG8_BAR;
    PG8_STAGE_B(PG8_SB(1, 0), cB + kstep); PG8_STAGE2(PG8_SA(1, 0), cA + kstep, vA[0][0], vA[0][1]); PG8_STAGE_B(PG8_SB(1, 1), cB + hstepB + kstep);
    PG8_WAIT_V(6); PG8_BAR;
    if constexpr (Epi::ACC_BIAS) E.acc_init(acc, vecbuf, wc, fq);
    for (;;) {
        const bool has_next = S.next(ui + 1, nxt);
        if constexpr (GATHER) { if (has_next && wid == 0) {
#pragma unroll
                for (int j_ = 0; j_ < 4; ++j_) __builtin_amdgcn_global_load_lds((const unsigned*)(rowtok + nxt.pm * BM + j_ * 64 + lane), (PG8_LAS unsigned*)(tokbuf + ((ui + 1) & 1) * 256 + j_ * 64), 4, 0, 0); } }
        if constexpr (Epi::HAS_VEC) { if (wid == 0) __builtin_amdgcn_global_load_lds((const unsigned*)(E.vec_ptr(cur) + lane * 4), (PG8_LAS unsigned*)(vecbuf + (ui & 1) * 256), 16, 0, 0); }
        if constexpr (Epi::ACC_BIAS) { if (has_next && wid == 0) __builtin_amdgcn_global_load_lds((const unsigned*)(E.vec_ptr(nxt) + lane * 4), (PG8_LAS unsigned*)(vecbuf + ((ui + 1) & 1) * 256), 16, 0, 0); }
        const char* nA = has_next ? nxt.a : cA; const char* nB = has_next ? nxt.b : cB;
        if constexpr (!GATHER) asm volatile("" : "+v"(vA[0][0]), "+v"(vA[0][1]), "+v"(vA[1][0]), "+v"(vA[1][1]));
#pragma unroll 1
        for (int t = 0; t < nt; t += 2) {
            const bool last = (t == nt - 2);
            const char* a1 = cA + (size_t)(t + 1) * kstep;
            const char* a2 = last ? nA : cA + (size_t)(t + 2) * kstep; const char* b2 = last ? nB : cB + (size_t)(t + 2) * kstep;
            const char* a3 = a2 + kstep; const char* b3 = b2 + kstep;
            PG8_LDB(B0, 0, 0); PG8_LDB(B1, 0, 1); PG8_SCHED; PG8_LDA(At, 0, 0); PG8_STAGE2(PG8_SA(1, 1), a1, vA[1][0], vA[1][1]);
            if constexpr (GATHER) { if (last && has_next) {
#pragma unroll
                for (int h_ = 0; h_ < 2; ++h_)
#pragma unroll
                    for (int i_ = 0; i_ < 2; ++i_) { int R_, C_; stage_rc(tid * 16 + i_ * 8192, R_, C_); vA[h_][i_] = (unsigned)tokbuf[((ui + 1) & 1) * 256 + h_ * HALF + R_] * (unsigned)rowB + (unsigned)(C_ * 2); } } }
            PG8_WAIT_V(8); PG8_WAIT_L(0); PG8_BAR; PG8_MMA(0, 0, At, B0); PG8_MMA(0, 1, At, B1); PG8_BAR; PG8_SCHED;
            PG8_LDA(At, 0, 1); PG8_STAGE_B(PG8_SB(0, 0), b2); PG8_STAGE_B(PG8_SB(0, 1), b2 + hstepB); PG8_STAGE2(PG8_SA(0, 0), a2, vA[0][0], vA[0][1]);
            PG8_WAIT_V(8); PG8_WAIT_L(0); PG8_BAR; PG8_MMA(1, 0, At, B0); PG8_MMA(1, 1, At, B1); PG8_BAR; PG8_SCHED;
            PG8_LDB(B0, 1, 0); PG8_LDB(B1, 1, 1); PG8_SCHED; PG8_LDA(At, 1, 0); PG8_STAGE2(PG8_SA(0, 1), a2, vA[1][0], vA[1][1]);
            PG8_WAIT_V(8); PG8_WAIT_L(0); PG8_BAR; PG8_MMA(0, 0, At, B0); PG8_MMA(0, 1, At, B1); PG8_BAR; PG8_SCHED;
            PG8_LDA(At, 1, 1); PG8_STAGE_B(PG8_SB(1, 0), b3); PG8_STAGE_B(PG8_SB(1, 1), b3 + hstepB); PG8_STAGE2(PG8_SA(1, 0), a3, vA[0][0], vA[0][1]);
            PG8_WAIT_V(8); PG8_WAIT_L(0); PG8_BAR; PG8_MMA(1, 0, At, B0); PG8_MMA(1, 1, At, B1); PG8_BAR; PG8_SCHED;
        }
        if (wr == 0) PG8_BAR;
        E(acc, cur, wr, wc, fr, fq, vecbuf + (ui & 1) * 256);
        if (!has_next) break;
        if constexpr (Epi::ACC_BIAS) E.acc_init(acc, vecbuf + ((ui + 1) & 1) * 256, wc, fq);
        else {
#pragma unroll
        for (int a = 0; a < 2; ++a)
#pragma unroll
            for (int b = 0; b < 2; ++b)
#pragma unroll
                for (int m = 0; m < 4; ++m)
#pragma unroll
                    for (int n = 0; n < 2; ++n) acc[a][b][m][n] = (f32x4){0.f, 0.f, 0.f, 0.f};
        }
        cur = nxt; cA = nA; cB = nB; ++ui;
        if (wr == 1) PG8_BAR;
    }
    PG8_WAIT_V(0);
    PG8_BAR;
#undef PG8_SA
#undef PG8_SB
#undef PG8_STAGE2
#undef PG8_STAGE_B
#undef PG8_LDA
#undef PG8_LDB
#undef PG8_MMA
#undef PG8_CAT8
#undef PG8_WAIT_V
#undef PG8_WAIT_L
#undef PG8_BAR
#undef PG8_SCHED
#undef PG8_SETOFF
}
}

#include <hip/hip_bf16.h>
namespace attn_body {
using bf16=__hip_bfloat16;
using bf16x8=__attribute__((ext_vector_type(8)))short;
using s16x4=__attribute__((ext_vector_type(4)))short;
using f32x16=__attribute__((ext_vector_type(16)))float;
using u32x4=__attribute__((ext_vector_type(4)))unsigned;
constexpr int SEQ=4096,D=64,PQ=3072,PO=1024;
constexpr int NW=8,QBLK=32,QB=QBLK*NW,KVBLK=64,NQB=SEQ/QB;
constexpr int ATTN_UNIT_ROWS=QB;
__device__ __forceinline__ int crow(int r,int hi){return (r&3)+8*(r>>2)+4*hi;}
#define SBAR() __builtin_amdgcn_sched_barrier(0)
__device__ __forceinline__ void cmask(f32x16&p0,f32x16&p1,int jb,int qrel,int hi){
  (void)hi; if(jb>(qrel>>6)){ const float NEG=-INFINITY;
    #pragma unroll
    for(int r=0;r<16;++r){p0[r]=NEG;p1[r]=NEG;} }
}

constexpr int NSLOT=3, SLOTB=8192, VSLOTB=2*SLOTB;
constexpr int LDS_K=0, LDS_V=NSLOT*SLOTB, LDS_WS=LDS_V+NSLOT*VSLOTB, LDS_OST=LDS_WS+NW*64*4, LDS_BYTES=LDS_OST+NW*4096;
constexpr float C2=0.125f*1.4426950408889634f;
__device__ __forceinline__ void glds16(const void*gsrc,unsigned lds_dst){unsigned keep;
  asm volatile("s_mov_b32 %0, m0\n\ts_mov_b32 m0, %2\n\ts_nop 0\n\tglobal_load_lds_dwordx4 %1, off\n\ts_mov_b32 m0, %0":"=&s"(keep):"v"(gsrc),"s"(lds_dst):"memory");}
__device__ __forceinline__ float max3f(float a,float b,float c){float r;asm("v_max3_f32 %0, %1, %2, %3":"=v"(r):"v"(a),"v"(b),"v"(c));return r;}
__device__ __forceinline__ float max2f(float a,float b){float r;asm("v_max_f32_e32 %0, %1, %2":"=v"(r):"v"(a),"v"(b));return r;}
__device__ __forceinline__ float fadd_s(float a,float b){float r;asm("v_add_f32_e32 %0, %1, %2":"=v"(r):"v"(a),"v"(b));return r;}
__device__ __forceinline__ float fsub_s(float a,float b){float r;asm("v_sub_f32_e32 %0, %1, %2":"=v"(r):"v"(a),"v"(b));return r;}
typedef float f32x2_t __attribute__((ext_vector_type(2))); typedef __bf16 bf16x2_t __attribute__((ext_vector_type(2)));
typedef int i32x4 __attribute__((ext_vector_type(4)));
typedef int i32x8 __attribute__((ext_vector_type(8)));
__device__ __forceinline__ unsigned cvtpk_s(float lo,float hi){f32x2_t v={lo,hi};bf16x2_t b=__builtin_convertvector(v,bf16x2_t);return __builtin_bit_cast(unsigned,b);}
#define WAIT_BAR(N) asm volatile("s_waitcnt vmcnt(" #N ") lgkmcnt(0)\n\ts_barrier":::"memory")

__device__ __forceinline__ void qkt(f32x16&p0,f32x16&p1,const char*Kslot,const bf16x8*qr,const f32x16&negm,int r32,int hi){
  const char*kb=Kslot+hi*1024+r32*16;
  #pragma unroll
  for(int d0=0;d0<4;++d0){
    const bf16x8 b0=*reinterpret_cast<const bf16x8*>(kb+d0*2048);
    const bf16x8 b1=*reinterpret_cast<const bf16x8*>(kb+d0*2048+512);
    if(d0==0){p0=__builtin_amdgcn_mfma_f32_32x32x16_bf16(b0,qr[0],negm,0,0,0);p1=__builtin_amdgcn_mfma_f32_32x32x16_bf16(b1,qr[0],negm,0,0,0);}
    else{p0=__builtin_amdgcn_mfma_f32_32x32x16_bf16(b0,qr[d0],p0,0,0,0);p1=__builtin_amdgcn_mfma_f32_32x32x16_bf16(b1,qr[d0],p1,0,0,0);}}
}
typedef __attribute__((address_space(3))) const char* lds_cptr;
typedef short v4i16_t __attribute__((ext_vector_type(4)));
__device__ __forceinline__ void kload8(bf16x8*kf,lds_cptr kp){
  kf[0]=*(const __attribute__((address_space(3))) bf16x8*)(kp);      kf[1]=*(const __attribute__((address_space(3))) bf16x8*)(kp+512);
  kf[2]=*(const __attribute__((address_space(3))) bf16x8*)(kp+2048); kf[3]=*(const __attribute__((address_space(3))) bf16x8*)(kp+2560);
  kf[4]=*(const __attribute__((address_space(3))) bf16x8*)(kp+4096); kf[5]=*(const __attribute__((address_space(3))) bf16x8*)(kp+4608);
  kf[6]=*(const __attribute__((address_space(3))) bf16x8*)(kp+6144); kf[7]=*(const __attribute__((address_space(3))) bf16x8*)(kp+6656);
}
__device__ __forceinline__ void kload2(bf16x8*kf,lds_cptr kp,int j){ kf[2*j]=*(const __attribute__((address_space(3))) bf16x8*)(kp+j*2048); kf[2*j+1]=*(const __attribute__((address_space(3))) bf16x8*)(kp+j*2048+512); }
__device__ __forceinline__ s16x4 vtr(lds_cptr p){ return __builtin_bit_cast(s16x4,__builtin_amdgcn_ds_read_tr16_b64_v4i16((__attribute__((address_space(3))) v4i16_t*)p)); }
__device__ __forceinline__ float rowmax(const f32x16&p0,const f32x16&p1){
  float a=max3f(p0[0],p0[1],p1[0]),b=max3f(p0[2],p0[3],p1[1]);a=max3f(a,p1[2],p1[3]);
  #pragma unroll
  for(int r=4;r<16;r+=4){a=max3f(a,p0[r],p0[r+1]);b=max3f(b,p0[r+2],p0[r+3]);a=max3f(a,p1[r],p1[r+1]);b=max3f(b,p1[r+2],p1[r+3]);}
  const float m=max2f(a,b);
  auto rr=__builtin_amdgcn_permlane32_swap(__float_as_uint(m),__float_as_uint(m),false,false);
  return max2f(__uint_as_float(rr[0]),__uint_as_float(rr[1]));
}
__device__ __forceinline__ void pv(f32x16*o,int vb,bf16x8 pa0,bf16x8 pa1,bf16x8 pa2,bf16x8 pa3){
  #pragma unroll
  for(int d0=0;d0<4;++d0){s16x4 lo[4],hi[4];
    #pragma unroll
    for(int ks=0;ks<4;++ks){
      asm volatile("ds_read_b64_tr_b16 %0,%1 offset:%c2":"=&v"(lo[ks]):"v"(vb),"i"(d0*4096+ks*1024):"memory");
      asm volatile("ds_read_b64_tr_b16 %0,%1 offset:%c2":"=&v"(hi[ks]):"v"(vb),"i"(d0*4096+ks*1024+512):"memory");}
    asm volatile("s_waitcnt lgkmcnt(0)":::"memory");SBAR();
    #define PK(k) (bf16x8){lo[k][0],lo[k][1],lo[k][2],lo[k][3],hi[k][0],hi[k][1],hi[k][2],hi[k][3]}
    o[d0]=__builtin_amdgcn_mfma_f32_32x32x16_bf16(pa0,PK(0),o[d0],0,0,0);
    o[d0]=__builtin_amdgcn_mfma_f32_32x32x16_bf16(pa1,PK(1),o[d0],0,0,0);
    o[d0]=__builtin_amdgcn_mfma_f32_32x32x16_bf16(pa2,PK(2),o[d0],0,0,0);
    o[d0]=__builtin_amdgcn_mfma_f32_32x32x16_bf16(pa3,PK(3),o[d0],0,0,0);
    #undef PK
  }
}

#ifndef ATTN_STORE16
#define ATTN_STORE16(p,v) (*(u32x4*)(p)=(v))
#endif
template<int THRL> __device__ __forceinline__ void attn_unit(long rowbase,int qb,const bf16*Qh,const bf16*__restrict__ Kh_,const bf16*__restrict__ Vh_,bf16*Oh,char*shm,int fuse,bf16*Ch,const float*gh,float lam){
  int tid_=threadIdx.x; asm volatile("":"+v"(tid_));
  const int tid=tid_,lane=tid&63,r32=lane&31,hi=lane>>5; const int wid=__builtin_amdgcn_readfirstlane(tid>>6);
  const int q0=qb*QB;
  const bf16*Qw=Qh+(rowbase+q0+wid*QBLK)*PQ;
  const bf16*Kh=Kh_+rowbase*PQ,*Vh=Vh_+rowbase*PQ;
  const unsigned lds0=(unsigned)(uintptr_t)shm;
  float*wsf=(float*)(shm+LDS_WS)+wid*64;
  const bf16*ksrc=Kh+(long)lane*PQ+wid*8;
  const bf16*vsrc=Vh+(long)(16*(wid&3)+(lane>>2))*PQ+(wid>>2)*32+(lane&3)*8;
  const unsigned kdst=lds0+LDS_K+wid*1024, vdst=lds0+LDS_V+wid*1024;
  #define DMA_K(t,slot) glds16(ksrc+(long)(t)*KVBLK*PQ,(unsigned)__builtin_amdgcn_readfirstlane(kdst+(slot)))
  #define DMA_V(t,slot) do{ glds16(vsrc+(long)(t)*KVBLK*PQ,(unsigned)__builtin_amdgcn_readfirstlane(vdst+2*(slot))); glds16(vsrc+(long)(t)*KVBLK*PQ+64,(unsigned)__builtin_amdgcn_readfirstlane(vdst+2*(slot)+8192)); }while(0)
  const int vb0=(int)(lds0+LDS_V)+((lane>>4)&1)*32+(lane&3)*8+(4*hi+((lane&15)>>2))*64;
  const char*Kbase=shm+LDS_K; bf16x8 kf[8];
  const lds_cptr shm3=(lds_cptr)shm; const lds_cptr kp0=shm3+LDS_K+hi*1024+r32*16; const lds_cptr vp0=shm3+LDS_V+((lane>>4)&1)*32+(lane&3)*8+(4*hi+((lane&15)>>2))*64;
  const int NT=(q0+QB)/KVBLK;
  DMA_K(0,0);DMA_V(0,0);DMA_K(1,SLOTB);
  bf16x8 qr[4];
  #pragma unroll
  for(int d0=0;d0<4;++d0)qr[d0]=*reinterpret_cast<const bf16x8*>(&Qw[(long)r32*PQ+d0*16+hi*8]);
  float z0_=0.f; asm volatile("":"+v"(z0_));
  f32x16 zv_; _Pragma("unroll") for(int r=0;r<16;++r)zv_[r]=z0_;
  float mhat=0.f,l_reg=0.f;f32x16 o[4];o[0]=zv_;o[1]=zv_;o[2]=zv_;o[3]=zv_;f32x16 negm=zv_;asm volatile("":"+v"(negm));
  const int qrel=wid*QBLK+r32;
  #define CMASK(P0,P1,t) do{int jb_=(t)-(NT-4); if(jb_>=0)cmask(P0,P1,jb_,qrel,hi);}while(0)
  bool resc=false;
  #define START(P0,P1) do{ const float rm=rowmax(P0,P1); resc=false; \
    { const float dl=rm; mhat=fadd_s(mhat,dl); \
      _Pragma("unroll") for(int r=0;r<16;++r){P0[r]=fsub_s(P0[r],dl);P1[r]=fsub_s(P1[r],dl);} \
      _Pragma("unroll") for(int r=0;r<16;++r)negm[r]=-mhat; asm volatile("":"+v"(negm)); } \
    _Pragma("unroll") for(int r=0;r<16;++r)P0[r]=__builtin_amdgcn_exp2f(P0[r]); }while(0)
  #define RESC() do{ if(resc){ asm volatile("s_waitcnt lgkmcnt(0)":::"memory"); \
      _Pragma("unroll") for(int d_=0;d_<4;++d_) _Pragma("unroll") for(int r=0;r<16;++r)o[d_][r]*=wsf[crow(r,hi)]; } }while(0)
  f32x16 pA0,pA1,pB0,pB1;
  int sl_prev=0,sl_cur=0,sl_next=SLOTB;
  #define ROT() do{sl_prev=sl_cur;sl_cur=sl_next;sl_next=(sl_next==(NSLOT-1)*SLOTB)?0:sl_next+SLOTB;}while(0)
  DMA_K(2,2*SLOTB);
  WAIT_BAR(4);
  qkt(pA0,pA1,Kbase,qr,negm,r32,hi);asm volatile("s_nop 15\n\ts_nop 7":"+v"(pA0),"+v"(pA1));CMASK(pA0,pA1,0);
  START(pA0,pA1);
  _Pragma("unroll") for(int r=0;r<16;++r)pA1[r]=__builtin_amdgcn_exp2f(pA1[r]);
  WAIT_BAR(0);
  DMA_K(3,0);DMA_V(1,SLOTB);
  ROT();
  kload8(kf,kp0+sl_cur);
  WAIT_BAR(3);
  s16x4 vlo[8],vhi[8]; u32x4 pw0,pw1,pw2,pw3;
  #define PKW(P,B) cvtpk_s(P[B],P[B+1])
  #define PAF(k) __builtin_bit_cast(bf16x8,pw##k)
  #define VFR(i) (bf16x8){vlo[i][0],vlo[i][1],vlo[i][2],vlo[i][3],vhi[i][0],vhi[i][1],vhi[i][2],vhi[i][3]}
  #define PIN(x) asm volatile("":"+v"(x))
  #define MX3(a,b,c) __builtin_fmaxf(__builtin_fmaxf((a),(b)),(c))
  #define GAPA(MF,A0,A1,A2,A3,W0,W1,PW) do{ MF; sacc+=A0; sacc+=A1; sacc+=A2; sacc+=A3; PIN(sacc); W0; W1; PIN(PW); SBAR(); }while(0)
  #define EX(v) __builtin_amdgcn_exp2f(v)
  #define GAPB2(MF,X,B) do{ MF; X[B]=EX(X[B]); X[B+1]=EX(X[B+1]); PIN(X); SBAR(); }while(0)
  #define VRD2(i) do{ vlo[i]=vtr(vp_+(8192+((i)>>2)*4096+((i)&3)*1024)); vhi[i]=vtr(vp_+(8192+((i)>>2)*4096+((i)&3)*1024+512)); SBAR(); }while(0)
  #define VRD(i) do{ vlo[i]=vtr(vp_+(((i)>>2)*4096+((i)&3)*1024)); vhi[i]=vtr(vp_+(((i)>>2)*4096+((i)&3)*1024+512)); }while(0)
  #define KRD(G,j) do{ if(G){ kload2(kf,kp0+sl_next,j); SBAR(); } }while(0)
  #define STEP(C0,C1,P0,P1,t,GK,GV,GL) do{ SBAR(); \
    const lds_cptr vp_=vp0+2*sl_prev; \
    VRD(0); SBAR(); float sacc=(P0[0]+P0[1]); \
    GAPA(C0=__builtin_amdgcn_mfma_f32_32x32x16_bf16(kf[0],qr[0],negm,0,0,0), P0[2],P0[3],P0[4],P0[5],     pw0[0]=PKW(P0,0), pw0[1]=PKW(P0,2), pw0); \
    VRD(4); SBAR(); GAPA(C1=__builtin_amdgcn_mfma_f32_32x32x16_bf16(kf[1],qr[0],negm,0,0,0), P0[6],P0[7],P0[8],P0[9],     pw0[2]=PKW(P0,4), pw0[3]=PKW(P0,6), pw0); \
    VRD(1); SBAR(); GAPA(C0=__builtin_amdgcn_mfma_f32_32x32x16_bf16(kf[2],qr[1],C0,0,0,0),   P0[10],P0[11],P0[12],P0[13], pw1[0]=PKW(P0,8), pw1[1]=PKW(P0,10), pw1); \
    VRD(5); SBAR(); GAPA(C1=__builtin_amdgcn_mfma_f32_32x32x16_bf16(kf[3],qr[1],C1,0,0,0),   P0[14],P0[15],P1[0],P1[1],   pw1[2]=PKW(P0,12),pw1[3]=PKW(P0,14), pw1); \
    VRD(2); SBAR(); GAPA(C0=__builtin_amdgcn_mfma_f32_32x32x16_bf16(kf[4],qr[2],C0,0,0,0),   P1[2],P1[3],P1[4],P1[5],     pw2[0]=PKW(P1,0), pw2[1]=PKW(P1,2), pw2); \
    VRD(6); SBAR(); GAPA(C1=__builtin_amdgcn_mfma_f32_32x32x16_bf16(kf[5],qr[2],C1,0,0,0),   P1[6],P1[7],P1[8],P1[9],     pw2[2]=PKW(P1,4), pw2[3]=PKW(P1,6), pw2); \
    VRD(3); SBAR(); GAPA(C0=__builtin_amdgcn_mfma_f32_32x32x16_bf16(kf[6],qr[3],C0,0,0,0),   P1[10],P1[11],P1[12],P1[13], pw3[0]=PKW(P1,8), pw3[1]=PKW(P1,10), pw3); \
    VRD(7); SBAR(); GAPA(C1=__builtin_amdgcn_mfma_f32_32x32x16_bf16(kf[7],qr[3],C1,0,0,0),   P1[14],P1[15],0.f,0.f,       pw3[2]=PKW(P1,12),pw3[3]=PKW(P1,14), pw3); \
    l_reg+=sacc; \
    if(GK){DMA_K((t)+3,sl_cur);} if(GV){DMA_V((t)+1,sl_next);} \
    CMASK(C0,C1,t); \
    { float a=MX3(C0[0],C0[1],C1[0]),b=MX3(C0[2],C0[3],C1[1]); a=MX3(a,C1[2],C1[3]); \
      _Pragma("unroll") for(int r=4;r<16;r+=4){a=MX3(a,C0[r],C0[r+1]);b=MX3(b,C0[r+2],C0[r+3]);a=MX3(a,C1[r],C1[r+1]);b=MX3(b,C1[r+2],C1[r+3]);} \
      float rm=__builtin_fmaxf(a,b); { auto rr=__builtin_amdgcn_permlane32_swap(__float_as_uint(rm),__float_as_uint(rm),false,false); rm=__builtin_fmaxf(__uint_as_float(rr[0]),__uint_as_float(rr[1])); } \
      resc=false; \
      if(__builtin_expect(__any(rm>(float)THRL),0)){ const float dl=__builtin_fmaxf(rm,0.f); mhat+=dl; \
        _Pragma("unroll") for(int r=0;r<16;++r){C0[r]-=dl;C1[r]-=dl;} \
        _Pragma("unroll") for(int r=0;r<16;++r)negm[r]=-mhat; asm volatile("":"+v"(negm)); \
        const float f=__builtin_amdgcn_exp2f(-dl); l_reg*=f; if(hi==0)wsf[r32]=f; resc=true; } } \
    SBAR(); \
    GAPB2(o[0]=__builtin_amdgcn_mfma_f32_32x32x16_bf16(PAF(0),VFR(0),o[0],0,0,0), C0,0);  VRD2(0); \
    GAPB2(o[1]=__builtin_amdgcn_mfma_f32_32x32x16_bf16(PAF(0),VFR(4),o[1],0,0,0), C0,2);  VRD2(4); \
    GAPB2(o[0]=__builtin_amdgcn_mfma_f32_32x32x16_bf16(PAF(1),VFR(1),o[0],0,0,0), C0,4);  VRD2(1); \
    GAPB2(o[1]=__builtin_amdgcn_mfma_f32_32x32x16_bf16(PAF(1),VFR(5),o[1],0,0,0), C0,6);  VRD2(5); \
    GAPB2(o[0]=__builtin_amdgcn_mfma_f32_32x32x16_bf16(PAF(2),VFR(2),o[0],0,0,0), C0,8);  VRD2(2); \
    GAPB2(o[1]=__builtin_amdgcn_mfma_f32_32x32x16_bf16(PAF(2),VFR(6),o[1],0,0,0), C0,10); VRD2(6); \
    GAPB2(o[0]=__builtin_amdgcn_mfma_f32_32x32x16_bf16(PAF(3),VFR(3),o[0],0,0,0), C0,12); VRD2(3); \
    GAPB2(o[1]=__builtin_amdgcn_mfma_f32_32x32x16_bf16(PAF(3),VFR(7),o[1],0,0,0), C0,14); VRD2(7); \
    GAPB2(o[2]=__builtin_amdgcn_mfma_f32_32x32x16_bf16(PAF(0),VFR(0),o[2],0,0,0), C1,0); \
    GAPB2(o[3]=__builtin_amdgcn_mfma_f32_32x32x16_bf16(PAF(0),VFR(4),o[3],0,0,0), C1,2); \
    KRD(GL,0); GAPB2(o[2]=__builtin_amdgcn_mfma_f32_32x32x16_bf16(PAF(1),VFR(1),o[2],0,0,0), C1,4); \
    KRD(GL,1); GAPB2(o[3]=__builtin_amdgcn_mfma_f32_32x32x16_bf16(PAF(1),VFR(5),o[3],0,0,0), C1,6); \
    KRD(GL,2); GAPB2(o[2]=__builtin_amdgcn_mfma_f32_32x32x16_bf16(PAF(2),VFR(2),o[2],0,0,0), C1,8); \
    KRD(GL,3); GAPB2(o[3]=__builtin_amdgcn_mfma_f32_32x32x16_bf16(PAF(2),VFR(6),o[3],0,0,0), C1,10); \
    GAPB2(o[2]=__builtin_amdgcn_mfma_f32_32x32x16_bf16(PAF(3),VFR(3),o[2],0,0,0), C1,12); \
    GAPB2(o[3]=__builtin_amdgcn_mfma_f32_32x32x16_bf16(PAF(3),VFR(7),o[3],0,0,0), C1,14); \
    }while(0)
  int t=1;
  #undef CMASK
  #define CMASK(P0,P1,t) do{}while(0)
  for(;t+5<NT;t+=2){
    STEP(pB0,pB1,pA0,pA1,t,true,true,true);     WAIT_BAR(3); RESC(); ROT();
    STEP(pA0,pA1,pB0,pB1,t+1,true,true,true);   WAIT_BAR(3); RESC(); ROT();
  }
  #undef CMASK
  #define CMASK(P0,P1,t) do{int jb_=(t)-(NT-4); if(jb_>=0)cmask(P0,P1,jb_,qrel,hi);}while(0)
  #define ENDW(tt) do{ if((tt)+3<NT){WAIT_BAR(3);} else if((tt)+2<NT){WAIT_BAR(2);} else {WAIT_BAR(0);} }while(0)
  for(;t+1<NT;t+=2){
    STEP(pB0,pB1,pA0,pA1,t,(t+3<NT),(t+1<NT),(t+1<NT));       ENDW(t);   RESC(); ROT();
    STEP(pA0,pA1,pB0,pB1,t+1,(t+4<NT),(t+2<NT),(t+2<NT));     ENDW(t+1); RESC(); ROT();
  }
  STEP(pB0,pB1,pA0,pA1,NT-1,false,false,false); RESC();
  { float sacc=pB0[0]+pB0[1]; _Pragma("unroll") for(int r=2;r<16;++r)sacc+=pB0[r]; _Pragma("unroll") for(int r=0;r<16;++r)sacc+=pB1[r]; l_reg+=sacc;
    pw0=(u32x4){PKW(pB0,0),PKW(pB0,2),PKW(pB0,4),PKW(pB0,6)};pw1=(u32x4){PKW(pB0,8),PKW(pB0,10),PKW(pB0,12),PKW(pB0,14)};pw2=(u32x4){PKW(pB1,0),PKW(pB1,2),PKW(pB1,4),PKW(pB1,6)};pw3=(u32x4){PKW(pB1,8),PKW(pB1,10),PKW(pB1,12),PKW(pB1,14)};
    SBAR(); pv(o,vb0+2*sl_cur,PAF(0),PAF(1),PAF(2),PAF(3)); }
  #undef PKW
  #undef PAF
  #undef VFR
  #undef PIN
  #undef MX3
  #undef GAPA
  #undef GAPB2
  #undef VRD2
  #undef EX
  #undef VRD
  #undef KRD
  #undef STEP
  #undef ENDW
  {auto rr=__builtin_amdgcn_permlane32_swap(__float_as_uint(l_reg),__float_as_uint(l_reg),false,false);l_reg=__uint_as_float(rr[0])+__uint_as_float(rr[1]);}
  if(hi==0)wsf[32+r32]=l_reg;asm volatile("s_waitcnt lgkmcnt(0)":::"memory");
  float rli[16];
  #pragma unroll
  for(int r=0;r<16;++r)rli[r]=__builtin_amdgcn_rcpf(wsf[32+crow(r,hi)]);
  bf16*Ow=Oh+(rowbase+q0+wid*QBLK)*PO;
  { bf16*stg=(bf16*)(shm+LDS_OST)+wid*2048;
    if(!fuse){
    #pragma unroll
    for(int hf=0;hf<2;++hf){
      #pragma unroll
      for(int r=0;r<16;++r){const int orow=crow(r,hi);
        #pragma unroll
        for(int d0=0;d0<2;++d0)stg[orow*64+d0*32+r32]=__float2bfloat16(o[2*hf+d0][r]*rli[r]);}
      asm volatile("s_waitcnt lgkmcnt(0)":::"memory");
      #pragma unroll
      for(int i=0;i<4;++i){const int row=i*8+(lane>>3),ch=lane&7; const u32x4 v=*(const u32x4*)(stg+row*64+ch*8); ATTN_STORE16(Ow+(long)row*PO+hf*64+ch*8,v);}
      asm volatile("s_waitcnt lgkmcnt(0)":::"memory");
    } }
    else{
      bf16*Cw=Ch+(rowbase+q0+wid*QBLK)*PO;
      u32x4 dp[2][4]; float ss[4]={0.f,0.f,0.f,0.f};
      #pragma unroll
      for(int hf=0;hf<2;++hf){
        u32x4 v0[4];
        #pragma unroll
        for(int i=0;i<4;++i){const int row=i*8+(lane>>3),ch=lane&7; v0[i]=*(const u32x4*)(Ow+(long)row*PO+hf*64+ch*8);}
        #pragma unroll
        for(int r=0;r<16;++r){const int orow=crow(r,hi);
          #pragma unroll
          for(int d0=0;d0<2;++d0)stg[orow*64+d0*32+r32]=__float2bfloat16(o[2*hf+d0][r]*rli[r]);}
        asm volatile("s_waitcnt lgkmcnt(0)":::"memory");
        #pragma unroll
        for(int i=0;i<4;++i){const int row=i*8+(lane>>3),ch=lane&7; const u32x4 v1=*(const u32x4*)(stg+row*64+ch*8);
          float d[8];
          #pragma unroll
          for(int j=0;j<4;++j){d[2*j]=bf2f(v0[i][j]&0xffffu)-lam*bf2f(v1[j]&0xffffu);d[2*j+1]=bf2f(v0[i][j]>>16)-lam*bf2f(v1[j]>>16);}
          #pragma unroll
          for(int j=0;j<8;++j)ss[i]+=d[j]*d[j];
          dp[hf][i]=(u32x4){pk2(d[0],d[1]),pk2(d[2],d[3]),pk2(d[4],d[5]),pk2(d[6],d[7])};}
        asm volatile("s_waitcnt lgkmcnt(0)":::"memory");
      }
      float rsn[4];
      #pragma unroll
      for(int i=0;i<4;++i){float sv=ss[i];sv+=__shfl_xor(sv,1);sv+=__shfl_xor(sv,2);sv+=__shfl_xor(sv,4);rsn[i]=0.8f*rsq_(sv*(1.f/128.f)+EPS);}
      #pragma unroll
      for(int hf=0;hf<2;++hf){const int ch=lane&7; const f32x4 g0=*(const f32x4*)(gh+hf*64+ch*8),g1=*(const f32x4*)(gh+hf*64+ch*8+4);
        #pragma unroll
        for(int i=0;i<4;++i){const int row=i*8+(lane>>3); const u32x4 q=dp[hf][i]; const float rs=rsn[i];
          const u32x4 w={pk2(bf2f(q[0]&0xffffu)*rs*g0.x,bf2f(q[0]>>16)*rs*g0.y),pk2(bf2f(q[1]&0xffffu)*rs*g0.z,bf2f(q[1]>>16)*rs*g0.w),pk2(bf2f(q[2]&0xffffu)*rs*g1.x,bf2f(q[2]>>16)*rs*g1.y),pk2(bf2f(q[3]&0xffffu)*rs*g1.z,bf2f(q[3]>>16)*rs*g1.w)};
          ATTN_STORE16(Cw+(long)row*PO+hf*64+ch*8,w);} }
    } }
  asm volatile("s_waitcnt lgkmcnt(0)\n\ts_barrier":::"memory");
  #undef DMA_K
  #undef DMA_V
  #undef CMASK
  #undef START
  #undef RESC
  #undef ROT
}
constexpr int ATTN_LDS_BYTES=LDS_BYTES;
template<int THRL=8> __device__ __forceinline__ void attn_pair(char*lds,const bf16*P,bf16*O,bf16*cat,const float*dng,float lam,int item){
  const int qd=item&3, h=(item>>2)&3, b=item>>4;
  const bf16*Vh=P+2560+h*128; bf16*Oh=O+(h*2)*128; bf16*Ch=cat+512+h*128; const float*gh=dng+h*128;
  for(int i=0;i<8;++i){ long rowbase=(long)b*SEQ; asm volatile("":"+s"(rowbase));
    const int map=i&1, k=i>>1, qb=(k==0)?15-qd:(k==1)?8+qd:(k==2)?7-qd:qd;
    const bf16*Qh=P+1536+(h*2+map)*64, *Kh=P+2048+(h*2+map)*64;
    attn_unit<THRL>(rowbase,qb,Qh,Kh,Vh,Oh,lds,map,Ch,gh,lam); }
}
#undef SBAR
#undef WAIT_BAR
}

#ifndef MK_N_LAUNCHES
#define MK_N_LAUNCHES 1
#endif
#ifndef RPT_MASK
#define RPT_MASK 0
#endif
#ifndef RPT_SUB
#define RPT_SUB 0
#endif
constexpr int NPHASE = 12;
constexpr int N_LAUNCHES = MK_N_LAUNCHES;
static_assert(N_LAUNCHES == 1 || N_LAUNCHES == NPHASE, "MK_N_LAUNCHES is 1 or 12");

#define XB_TMO      128
#define XB_XCNT(j)  (256  + 64 * (j))
#define XB_XSUB(j)  (1280 + 64 * (j))
#define XB_XGEN(j)  (2304 + 64 * (j))
#define XB_TOP      3328
#define XB_TOPGEN   3392
#define XCD_BAR_WORDS 3456
#define XB_SPIN_CAP (1u << 18)

__device__ __forceinline__ unsigned xb_ld(unsigned* p)              { return __hip_atomic_load(p, __ATOMIC_RELAXED, __HIP_MEMORY_SCOPE_AGENT); }
__device__ __forceinline__ unsigned xb_add(unsigned* p, unsigned v) { return __hip_atomic_fetch_add(p, v, __ATOMIC_RELAXED, __HIP_MEMORY_SCOPE_AGENT); }
__device__ __forceinline__ unsigned xb_xcc_id() { return (unsigned)__builtin_amdgcn_s_getreg((3 << 11) | 20) & 0xFu; }
#define XB_SPIN(cond, bar) do { unsigned _sp = 0; while (cond) { __builtin_amdgcn_s_sleep(1); \
    if ((++_sp & 255u) == 0u) { if (xb_ld(&(bar)[XB_TMO])) break; if (_sp > XB_SPIN_CAP) { atomicAdd(&(bar)[XB_TMO], 1u); break; } } } } while (0)

struct XcdBarrier {
    unsigned* bar; unsigned x;
    volatile LAS unsigned* st;
};

__device__ __forceinline__ XcdBarrier xcd_barrier_post(unsigned* bar, volatile LAS unsigned* st) {
    XcdBarrier b; b.bar = bar; b.x = xb_xcc_id(); b.st = st;
    if (threadIdx.x == 0) (void)xb_add(&bar[XB_XCNT(b.x)], 1u);
    return b;
}
__device__ __forceinline__ void xcd_barrier_complete(unsigned* bar, unsigned x, unsigned& nloc, unsigned& nx) {
    const unsigned G = gridDim.x * gridDim.y * gridDim.z;
    unsigned sum, cnt, mine, sp = 0u;
    for (;;) {
        sum = 0u; cnt = 0u; mine = 0u;
#pragma unroll
        for (unsigned j = 0; j < 16; ++j) { const unsigned c = xb_ld(&bar[XB_XCNT(j)]); sum += c; cnt += (c > 0u) ? 1u : 0u; mine = (j == x) ? c : mine; }
        if (sum == G) break;
        __builtin_amdgcn_s_sleep(1);
        if ((++sp & 255u) == 0u) { if (xb_ld(&bar[XB_TMO])) break; if (sp > XB_SPIN_CAP) { atomicAdd(&bar[XB_TMO], 1u); break; } }
    }
    nloc = mine > 0u ? mine : 1u; nx = cnt > 0u ? cnt : 1u;
}

__device__ __forceinline__ void xcd_barrier(const XcdBarrier& b) {
    asm volatile("s_waitcnt vmcnt(0)" ::: "memory");
    __syncthreads();
    if (threadIdx.x == 0) {
        unsigned* bar = b.bar;
        __builtin_amdgcn_s_waitcnt(0);
        unsigned nloc = b.st[0], nx = b.st[1];
        if (nloc == 0u) { xcd_barrier_complete(bar, b.x, nloc, nx); b.st[0] = nloc; b.st[1] = nx; }
        const unsigned old = xb_add(&bar[XB_XSUB(b.x)], 1u);
        const unsigned gen = old / nloc;
        if (old + 1u == (gen + 1u) * nloc) {
            __builtin_amdgcn_fence(__ATOMIC_RELEASE, "agent");
            asm volatile("s_waitcnt vmcnt(0)" ::: "memory");
            const unsigned og = xb_add(&bar[XB_TOP], 1u);
            const unsigned tg = og / nx;
            if (og + 1u == (tg + 1u) * nx) xb_add(&bar[XB_TOPGEN], 1u);
            else XB_SPIN(xb_ld(&bar[XB_TOPGEN]) == tg, bar);
            __builtin_amdgcn_fence(__ATOMIC_ACQUIRE, "agent");
            xb_add(&bar[XB_XGEN(b.x)], 1u);
            asm volatile("s_waitcnt vmcnt(0)" ::: "memory");
        } else {
            XB_SPIN(xb_ld(&bar[XB_XGEN(b.x)]) == gen, bar);
            __builtin_amdgcn_fence(__ATOMIC_ACQUIRE, "agent");
            asm volatile("s_waitcnt vmcnt(0)" ::: "memory");
        }
    }
    __syncthreads();
}

struct Args { const float* in[26]; float* out; unsigned char* ws; int ph_lo, ph_hi, sub, pad; };
struct Frame {
    LAS unsigned char* lds;
    volatile LAS unsigned* MISC;
    unsigned* ctl;
    int tid, lane, wave, bx, vcu, G;
};
enum { I_X = 0, I_C, I_WADA, I_BADA, I_N1G, I_WIN, I_CONVW, I_CONVB, I_BI, I_BF, I_MNG, I_QNG, I_KNG, I_LQ1, I_LK1, I_LQ2, I_LK2, I_DNG, I_WOUT, I_N2G, I_WR, I_BR, I_WGU, I_BGU, I_WD, I_BD };

__device__ __forceinline__ void transpose_item(const float* W, int ldw, int col0, int cstride, bf16* WT, int K, int drow0, int k0, LAS float* scr, int lane) {
    float wv_[32];
#pragma unroll
    for (int i = 0; i < 32; ++i) wv_[i] = W[(size_t)(k0 + 2 * i + (lane >> 5)) * ldw + col0 + cstride * (lane & 31)];
#pragma unroll
    for (int i = 0; i < 32; ++i) scr[(2 * i + (lane >> 5)) * 33 + (lane & 31)] = wv_[i];
    LDS_WAIT();
    const int c = lane & 7;
#pragma unroll
    for (int j = 0; j < 4; ++j) { const int n = (lane >> 3) + 8 * j; const LAS float* s = scr + (8 * c) * 33 + n;
        u32x4 o; o.x = pk2(s[0 * 33], s[1 * 33]); o.y = pk2(s[2 * 33], s[3 * 33]); o.z = pk2(s[4 * 33], s[5 * 33]); o.w = pk2(s[6 * 33], s[7 * 33]);
        *(u32x4*)(WT + (size_t)(drow0 + n) * K + k0 + 8 * c) = o; }
    LDS_WAIT();
}

__device__ __forceinline__ void transpose_item_fp8(const float* W, int ldw, int col0, int cstride, unsigned char* WT, int K, int drow0, int k0, float scale, LAS float* scr, int lane) {
    float wv_[32];
#pragma unroll
    for (int i = 0; i < 32; ++i) wv_[i] = W[(size_t)(k0 + 2 * i + (lane >> 5)) * ldw + col0 + cstride * (lane & 31)];
#pragma unroll
    for (int i = 0; i < 32; ++i) scr[(2 * i + (lane >> 5)) * 33 + (lane & 31)] = wv_[i];
    LDS_WAIT();
    const int c = lane & 7;
#pragma unroll
    for (int j = 0; j < 4; ++j) { const int n = (lane >> 3) + 8 * j; const LAS float* s = scr + (8 * c) * 33 + n;
        const u32x2 o = {pk4_fp8(s[0 * 33] * scale, s[1 * 33] * scale, s[2 * 33] * scale, s[3 * 33] * scale), pk4_fp8(s[4 * 33] * scale, s[5 * 33] * scale, s[6 * 33] * scale, s[7 * 33] * scale)};
        *(u32x2*)(WT + (size_t)(drow0 + n) * K + k0 + 8 * c) = o; }
    LDS_WAIT();
}
constexpr float WQ_SCALE = 32.f;

__device__ __forceinline__ void phase0(const Args& a, Frame& F) {
    const int tid = F.tid, lane = F.lane, wave = F.wave;
    {
        LAS float* cond = (LAS float*)(F.lds);
        LAS float* part = (LAS float*)(F.lds + 65536);
        const float* c = a.in[I_C]; const float* w_ada = a.in[I_WADA]; const float* b_ada = a.in[I_BADA];
        float* mod = (float*)(a.ws + WS_MOD);
        bool have = false;
        for (int task = F.bx; task < 96; task += F.G) {
            if (!have) { for (int idx = tid; idx < 16384; idx += 512) { const int b = idx >> 10, k = idx & 1023; const float cv = c[idx]; cond[k * 16 + b] = cv / (1.f + expf(-cv)); } __syncthreads(); have = true; }
            const int col = task * 64 + lane;
            float acc[16];
#pragma unroll
            for (int b = 0; b < 16; ++b) acc[b] = 0.f;
            const float* wp = w_ada + (size_t)(128 * wave) * 6144 + col;
#pragma unroll 32
            for (int k = 0; k < 128; ++k) {
                const float wv = wp[(size_t)k * 6144];
                const LAS f32x4* c4 = (const LAS f32x4*)(cond + (128 * wave + k) * 16);
#pragma unroll
                for (int q = 0; q < 4; ++q) { const f32x4 cc = c4[q]; acc[4 * q + 0] += cc.x * wv; acc[4 * q + 1] += cc.y * wv; acc[4 * q + 2] += cc.z * wv; acc[4 * q + 3] += cc.w * wv; }
            }
#pragma unroll
            for (int b = 0; b < 16; ++b) part[(wave * 16 + b) * 64 + lane] = acc[b];
            __syncthreads();
            for (int o = tid; o < 1024; o += 512) { const int b = o >> 6, l = o & 63; float s = 0.f;
#pragma unroll
                for (int w = 0; w < 8; ++w) s += part[(w * 16 + b) * 64 + l];
                mod[b * 6144 + task * 64 + l] = s + b_ada[task * 64 + l]; }
            __syncthreads();
        }
    }
    {
        const int gtid = F.bx * 512 + tid, NT = F.G * 512;
        const float* w_in = a.in[I_WIN]; const float* w_r = a.in[I_WR]; const float* b_gu = a.in[I_BGU];
        float* Wg = (float*)(a.ws + WS_WG); float* wrT = (float*)(a.ws + WS_WRT); float* bgu = (float*)(a.ws + WS_BGU); f32x2* rope = (f32x2*)(a.ws + WS_ROPE);
        for (int idx = gtid; idx < 8192; idx += NT) { const int g = idx >> 10, k = idx & 1023; Wg[idx] = w_in[(size_t)k * IN_W + 1536 + g]; }
        { int* ident = (int*)(a.ws + WS_IDENT); for (int i = gtid; i < MAXTILES * 256; i += NT) ident[i] = i; }
        for (int idx = gtid; idx < 32768; idx += NT) { const int k = idx >> 5, e = idx & 31; wrT[(k >> 2) * 128 + e * 4 + (k & 3)] = w_r[idx]; }
        for (int idx = gtid; idx < 65536; idx += NT) { const int e = idx >> 11, r = idx & 2047, pn = r >> 8, half = (r >> 3) & 1, j = 8 * ((r & 255) >> 4) + (r & 7); bgu[idx] = b_gu[e * 2048 + 2 * (128 * pn + j) + half]; }
        for (int idx = gtid; idx < 131072; idx += NT) { const int pos = idx >> 5, j = idx & 31;
            const float invf = (float)pow(10000.0, -(double)(2 * j) / 64.0); const float ang = (float)pos * invf;
            rope[idx] = (f32x2){(float)cos((double)ang), (float)sin((double)ang)}; }
    }
    {
        LAS float* scr = (LAS float*)(F.lds + wave * 16384);
        const int gw = F.vcu * NWAVES + wave, NGW = F.G * NWAVES;
        constexpr int I_IN = 16 * 96, I_OUT = 16 * 32, I_DN = 32 * 16 * 32;
        for (int it = gw; it < I_IN + I_OUT + I_DN; it += NGW) {
            int r = it;
            if (r < I_IN) { const int kb = r / 96, nb = r % 96, d0 = 32 * nb; transpose_item(a.in[I_WIN], IN_W, d0 < 1536 ? d0 : d0 + 8, 1, (bf16*)(a.ws + WS_WINT), D, d0, 64 * kb, scr, lane); continue; } r -= I_IN;
            if (r < I_OUT) { const int kb = r / 32, nb = r % 32; transpose_item(a.in[I_WOUT], D, 32 * nb, 1, (bf16*)(a.ws + WS_WOUTT), D, 32 * nb, 64 * kb, scr, lane); continue; } r -= I_OUT;
            { const int e = r >> 9, q = r & 511, kb = q >> 5, nb = q & 31;
              transpose_item_fp8(a.in[I_WD] + (size_t)e * DFF * D, D, 32 * nb, 1, a.ws + WS_WDT + (size_t)e * D * DFF, DFF, 32 * nb, 64 * kb, WQ_SCALE, scr, lane); }
        }
    }
}
__device__ __forceinline__ void wgu_copy(const Args& a, Frame& F) {
    LAS float* scr = (LAS float*)(F.lds + F.wave * 16384);
    const int lane = F.lane;
    const int gw = F.vcu * NWAVES + F.wave, NGW = F.G * NWAVES;
    for (int it = gw; it < 32 * 16 * 32; it += NGW) {
        const int e = it >> 9, q = it & 511, kb = q >> 5, jb = q & 31, pn = jb >> 2, j0 = (jb & 3) * 32, k0 = 64 * kb;
        const float* W = a.in[I_WGU] + (size_t)e * D * 2048 + (size_t)k0 * 2048 + 2 * (128 * pn + j0);
        f32x2 gu[32];
#pragma unroll
        for (int i = 0; i < 32; ++i) gu[i] = *(const f32x2*)(W + (size_t)(2 * i + (lane >> 5)) * 2048 + 2 * (lane & 31));
        unsigned char* WT = a.ws + WS_WGUT + (size_t)e * 2048 * D;
#pragma unroll
        for (int half = 0; half < 2; ++half) {
#pragma unroll
            for (int i = 0; i < 32; ++i) scr[(2 * i + (lane >> 5)) * 33 + (lane & 31)] = half ? gu[i].y : gu[i].x;
            LDS_WAIT();
            const int c = lane & 7;
#pragma unroll
            for (int j = 0; j < 4; ++j) { const int n = (lane >> 3) + 8 * j; const LAS float* sp = scr + (8 * c) * 33 + n;
                const u32x2 o = {pk4_fp8(sp[0 * 33] * WQ_SCALE, sp[1 * 33] * WQ_SCALE, sp[2 * 33] * WQ_SCALE, sp[3 * 33] * WQ_SCALE), pk4_fp8(sp[4 * 33] * WQ_SCALE, sp[5 * 33] * WQ_SCALE, sp[6 * 33] * WQ_SCALE, sp[7 * 33] * WQ_SCALE)};
                *(u32x2*)(WT + (size_t)(pn * 256 + 16 * ((j0 + n) >> 3) + 8 * half + ((j0 + n) & 7)) * D + k0 + 8 * c) = o; }
            LDS_WAIT();
        }
    }
}

__device__ __forceinline__ void phase1(const Args& a, Frame& F) {
    const int tid = F.tid, lane = F.lane;
    LAS float* wg = (LAS float*)F.lds;
    { const float* Wg = (const float*)(a.ws + WS_WG); for (int i = tid; i < 8192; i += 512) wg[i] = Wg[i]; }
    __syncthreads();
    const float* x = a.in[I_X]; const float* g1 = a.in[I_N1G]; const float* mod = (const float*)(a.ws + WS_MOD);
    const float* bi = a.in[I_BI]; const float* bfg = a.in[I_BF];
    bf16* h = (bf16*)(a.ws + WS_H); float* gates = (float*)(a.ws + WS_GATES);
    const int gw = F.vcu * NWAVES + F.wave, NGW = F.G * NWAVES;
#define P1_LOAD(buf, r0) do { _Pragma("unroll") for (int k = 0; k < 2; ++k) { const f32x4* xr = (const f32x4*)(x + (size_t)((r0) + k * NGW) * D) + lane; \
        _Pragma("unroll") for (int j = 0; j < 4; ++j) buf[k][j] = xr[64 * j]; } } while (0)
#define P1_COMP(buf, r0) do { _Pragma("unroll") for (int k = 0; k < 2; ++k) { \
        float ss = 0.f; \
        _Pragma("unroll") for (int j = 0; j < 4; ++j) ss += (buf[k][j].x * buf[k][j].x + buf[k][j].y * buf[k][j].y) + (buf[k][j].z * buf[k][j].z + buf[k][j].w * buf[k][j].w); \
        const float rs = rsq_(wave_sum(ss) * (1.f / D) + EPS); \
        const int row = (r0) + k * NGW, b = row >> 12; \
        float ga[8]; \
        _Pragma("unroll") for (int g = 0; g < 8; ++g) ga[g] = 0.f; \
        _Pragma("unroll") for (int j = 0; j < 4; ++j) { \
            const int col = 256 * j + 4 * lane; \
            const f32x4 gg = *(const f32x4*)(g1 + col), sc = *(const f32x4*)(mod + b * 6144 + 1024 + col), sh = *(const f32x4*)(mod + b * 6144 + col); \
            const f32x4 hv = buf[k][j] * rs * gg * (sc + 1.f) + sh; \
            *(u32x2*)(h + (size_t)row * D + col) = (u32x2){pk2(hv.x, hv.y), pk2(hv.z, hv.w)}; \
            _Pragma("unroll") for (int g = 0; g < 8; ++g) { const f32x4 w4 = *(const LAS f32x4*)(wg + g * 1024 + col); ga[g] += (hv.x * w4.x + hv.y * w4.y) + (hv.z * w4.z + hv.w * w4.w); } } \
        _Pragma("unroll") for (int g = 0; g < 8; ++g) ga[g] = wave_sum(ga[g]); \
          \
        float pre = ga[0]; \
        _Pragma("unroll") for (int g = 1; g < 8; ++g) pre = (lane == g) ? ga[g] : pre; \
        const float z = pre + ((lane < 4) ? bi[lane & 3] : bfg[lane & 3]); \
        const float lsg = fminf(z, 0.f) - __logf(1.f + __expf(-fabsf(z))); \
        if (lane < 8) gates[(size_t)row * 8 + lane] = (lane < 4) ? z : lsg; \
        asm volatile("" ::: "memory");     \
    } } while (0)
    f32x4 va[2][4], vb[2][4], vc[2][4];
    const int lastp = gw + (NTOK / NGW - 2) * NGW;
    P1_LOAD(va, gw); P1_LOAD(vb, gw + 2 * NGW);
    for (int row0 = gw; row0 < NTOK; row0 += 6 * NGW) {
        const int r2 = row0 + 4 * NGW, r3 = row0 + 6 * NGW, r4 = row0 + 8 * NGW;
        P1_LOAD(vc, r2 < NTOK ? r2 : lastp);
        P1_COMP(va, row0);
        P1_LOAD(va, r3 < NTOK ? r3 : lastp);
        if (row0 + 2 * NGW < NTOK) P1_COMP(vb, row0 + 2 * NGW);
        P1_LOAD(vb, r4 < NTOK ? r4 : lastp);
        if (r2 < NTOK) P1_COMP(vc, r2);
    }
#undef P1_LOAD
#undef P1_COMP
}

__device__ __forceinline__ void rope_rows4(const Args& a, int row0, int rstride, int lane) {
    const int seg = lane >> 2, q = lane & 3;
    const float* gp = (seg < 8) ? a.in[I_QNG] : a.in[I_KNG];
    const float sc = (seg < 8) ? attn_body::C2 : 1.f;
    const f32x4 ga = *(const f32x4*)(gp + q * 8), gb = *(const f32x4*)(gp + q * 8 + 4), gc = *(const f32x4*)(gp + 32 + q * 8), gd = *(const f32x4*)(gp + 32 + q * 8 + 4);
    const float g1[8] = {ga.x, ga.y, ga.z, ga.w, gb.x, gb.y, gb.z, gb.w}, g2[8] = {gc.x, gc.y, gc.z, gc.w, gd.x, gd.y, gd.z, gd.w};
    u32x4 lo[4], hi[4]; f32x4 cs[4][4];
#pragma unroll
    for (int k = 0; k < 4; ++k) { const int row = row0 + k * rstride;
        const bf16* pr = (const bf16*)(a.ws + WS_P) + (size_t)row * NP + P_AQ;
        lo[k] = *(const u32x4*)(pr + seg * 64 + q * 8); hi[k] = *(const u32x4*)(pr + seg * 64 + 32 + q * 8);
        const f32x4* tab = (const f32x4*)((const float*)(a.ws + WS_ROPE) + ((size_t)(row & (SEQ - 1)) * 32 + q * 8) * 2);
#pragma unroll
        for (int i = 0; i < 4; ++i) cs[k][i] = tab[i]; }
#pragma unroll
    for (int k = 0; k < 4; ++k) {
        bf16* pr = (bf16*)(a.ws + WS_P) + (size_t)(row0 + k * rstride) * NP + P_AQ;
        float x1[8], x2[8]; float ss = 0.f;
#pragma unroll
        for (int i = 0; i < 4; ++i) { x1[2 * i] = bf2f(lo[k][i] & 0xffffu); x1[2 * i + 1] = bf2f(lo[k][i] >> 16); x2[2 * i] = bf2f(hi[k][i] & 0xffffu); x2[2 * i + 1] = bf2f(hi[k][i] >> 16); }
#pragma unroll
        for (int i = 0; i < 8; ++i) ss += x1[i] * x1[i] + x2[i] * x2[i];
        ss += __shfl_xor(ss, 1); ss += __shfl_xor(ss, 2);
        const float rs = rsq_(ss * (1.f / 64.f) + EPS);
        float o1[8], o2[8];
#pragma unroll
        for (int i = 0; i < 4; ++i) {
#pragma unroll
            for (int e = 0; e < 2; ++e) { const int kk = 2 * i + e; const float c = e ? cs[k][i].z : cs[k][i].x, sn = e ? cs[k][i].w : cs[k][i].y;
                const float y1 = x1[kk] * rs * g1[kk], y2 = x2[kk] * rs * g2[kk];
                o1[kk] = (y1 * c - y2 * sn) * sc; o2[kk] = (y2 * c + y1 * sn) * sc; } }
        *(u32x4*)(pr + seg * 64 + q * 8) = (u32x4){pk2(o1[0], o1[1]), pk2(o1[2], o1[3]), pk2(o1[4], o1[5]), pk2(o1[6], o1[7])};
        *(u32x4*)(pr + seg * 64 + 32 + q * 8) = (u32x4){pk2(o2[0], o2[1]), pk2(o2[2], o2[3]), pk2(o2[4], o2[5]), pk2(o2[6], o2[7])};
    }
}
__device__ __forceinline__ float wave_scan_add(float v, int lane) {
#pragma unroll
    for (int o = 1; o < 64; o <<= 1) { const float t = __shfl_up(v, o); if (lane >= o) v += t; }
    return v;
}
__device__ __forceinline__ float wave_scan_max(float v, int lane) {
#pragma unroll
    for (int o = 1; o < 64; o <<= 1) { const float t = __shfl_up(v, o); if (lane >= o) v = fmaxf(v, t); }
    return v;
}
__device__ __forceinline__ float silu_(float y) { return y * rcp_(1.f + __expf(-y)); }
__device__ __forceinline__ bf16x8 gather8(const LAS bf16* t, int pitch, int s0, int c) {
    bf16x8 f;
#pragma unroll
    for (int j = 0; j < 8; ++j) f[j] = (short)t[(s0 + j) * pitch + c];
    return f;
}
__device__ __forceinline__ int crow(int i, int hh) { return (i & 3) + 8 * (i >> 2) + 4 * hh; }

struct MPref { u32x4 tq, tk, tv0, tv1, th; float ip, lf, mp; float cq[5], ck[5]; f32x4 npv; };
template <bool WITH_Q>
__device__ __forceinline__ void mlstm_prefetch(const Args& a, int u, int tid, MPref& p) {
    const int b = u >> 8, h = (u >> 6) & 3, n = u & 63;
    const long r0 = (long)b * SEQ + (long)n * 64;
    const bf16* P = (const bf16*)(a.ws + WS_P);
    const int row = tid >> 3, c8 = tid & 7;
    if (WITH_Q) p.tq = *(const u32x4*)(P + (size_t)(r0 + row) * NP + P_MQ + h * 64 + c8 * 8);
    p.tk = *(const u32x4*)(P + (size_t)(r0 + row) * NP + P_MK + h * 64 + c8 * 8);
    p.tv0 = *(const u32x4*)(P + (size_t)(r0 + (tid >> 4)) * NP + P_MV + h * 128 + (tid & 15) * 8);
    p.tv1 = *(const u32x4*)(P + (size_t)(r0 + 32 + (tid >> 4)) * NP + P_MV + h * 128 + (tid & 15) * 8);
    p.th = (u32x4){0u, 0u, 0u, 0u};
    if (n > 0 && tid < 48) { const int hk = tid >= 24, t2 = tid - 24 * hk;
        if (WITH_Q || hk) p.th = *(const u32x4*)(P + (size_t)(r0 - 3 + (t2 >> 3)) * NP + (hk ? P_MK : P_MQ) + h * 64 + (t2 & 7) * 8); }
    if (tid < 64) { const float* gates = (const float*)(a.ws + WS_GATES); p.ip = gates[(r0 + tid) * 8 + h]; p.lf = gates[(r0 + tid) * 8 + 4 + h]; }
    if (WITH_Q) p.mp = ((const float*)(a.ws + WS_MPREV))[u];
    { const float* cw = a.in[I_CONVW]; const float* cb = a.in[I_CONVB]; const int c = tid & 63;
#pragma unroll
      for (int j = 0; j < 4; ++j) { if (WITH_Q) p.cq[j] = cw[512 * j + h * 64 + c]; p.ck[j] = cw[512 * j + 256 + h * 64 + c]; }
      if (WITH_Q) p.cq[4] = cb[h * 64 + c]; p.ck[4] = cb[256 + h * 64 + c]; }
    if (WITH_Q && tid < 16) p.npv = *(const f32x4*)((const float*)(a.ws + WS_NPREV) + (size_t)u * 64 + 4 * tid);
}
template <bool WITH_Q>
__device__ __forceinline__ void mlstm_pref_to_lds(const MPref& p, LAS bf16* rawq, LAS bf16* rawk, LAS bf16* Vt, int tid) {
    if (WITH_Q) *(LAS u32x4*)(rawq + (3 + (tid >> 3)) * 64 + (tid & 7) * 8) = p.tq;
    *(LAS u32x4*)(rawk + (3 + (tid >> 3)) * 64 + (tid & 7) * 8) = p.tk;
    *(LAS u32x4*)(Vt + (tid >> 4) * 128 + (tid & 15) * 8) = p.tv0;
    *(LAS u32x4*)(Vt + (32 + (tid >> 4)) * 128 + (tid & 15) * 8) = p.tv1;
    if (tid < 48) { const int hk = tid >= 24, t2 = tid - 24 * hk; if (WITH_Q || hk) *(LAS u32x4*)((hk ? rawk : rawq) + (t2 >> 3) * 64 + (t2 & 7) * 8) = p.th; }
}
__device__ __forceinline__ float conv_tile(LAS bf16* out, const LAS bf16* raw, const float (&cf)[5], float scale, const LAS float* ws, int tid) {
    const int c = tid & 63, rg = tid >> 6;
    const float cw0 = cf[0], cw1 = cf[1], cw2 = cf[2], cw3 = cf[3], cb = cf[4];
    float u0 = bf2f(raw[(rg * 8 + 0) * 64 + c]), u1 = bf2f(raw[(rg * 8 + 1) * 64 + c]), u2 = bf2f(raw[(rg * 8 + 2) * 64 + c]);
    float nsum = 0.f;
#pragma unroll
    for (int i = 0; i < 8; ++i) { const int sI = rg * 8 + i;
        const float cur = bf2f(raw[(sI + 3) * 64 + c]);
        const float y = cb + cw0 * u0 + cw1 * u1 + cw2 * u2 + cw3 * cur;
        const bf16 o = f2bf(silu_(y) * scale * (ws ? ws[sI] : 1.f));
        out[sI * 72 + c] = o; nsum += bf2f(o);
        u0 = u1; u1 = u2; u2 = cur; }
    return nsum;
}
__device__ __forceinline__ void mlstm_A_phase(const Args& a, Frame& F) {
    const int tid = F.tid, lane = F.lane, wave = F.wave, r = lane & 31, hh = lane >> 5;
    LAS bf16* rawk = (LAS bf16*)(F.lds);
    LAS bf16* Vt = (LAS bf16*)(F.lds + 8704);
    LAS bf16* kw = (LAS bf16*)(F.lds + 25088);
    LAS float* wS = (LAS float*)(F.lds + 34304);
    LAS float* nsum = (LAS float*)(F.lds + 34560);
    MPref p; p.ip = 0.f; p.lf = 0.f;
    if (F.vcu < NUNIT) mlstm_prefetch<false>(a, F.vcu, tid, p);
    for (int u = F.vcu; u < NUNIT; u += F.G) {
        mlstm_pref_to_lds<false>(p, rawk, rawk, Vt, tid);
        if (wave == 0) {
            const float bc = wave_scan_add(p.lf, lane);
            const float blast = __shfl(bc, 63);
            const float av = blast - bc + p.ip;
            const float mloc = wave_max(av);
            wS[lane] = __expf(av - mloc);
            if (lane == 0) { ((float*)(a.ws + WS_ML))[u] = mloc; ((float*)(a.ws + WS_BL))[u] = blast; }
        }
        __syncthreads();
        float ckc[5];
#pragma unroll
        for (int j = 0; j < 5; ++j) ckc[j] = p.ck[j];
        mlstm_prefetch<false>(a, (u + F.G < NUNIT) ? u + F.G : u, tid, p);
        nsum[(tid >> 6) * 64 + (tid & 63)] = conv_tile(kw, rawk, ckc, 0.125f, wS, tid);
        __syncthreads();
        {
            const int vt = wave & 3, kt = wave >> 2;
            f32x16 acc = {};
#pragma unroll
            for (int st = 0; st < 4; ++st) acc = __builtin_amdgcn_mfma_f32_32x32x16_bf16(gather8(Vt, 128, 16 * st + 8 * hh, 32 * vt + r), gather8(kw, 72, 16 * st + 8 * hh, 32 * kt + r), acc, 0, 0, 0);
            bf16* Cl = (bf16*)(a.ws + WS_CL) + (size_t)u * 8192;
            int rs_ = r, hs_ = hh; asm volatile("" : "+v"(rs_), "+v"(hs_));
#pragma unroll
            for (int i = 0; i < 16; ++i) Cl[(32 * vt + crow(i, hs_)) * 64 + 32 * kt + rs_] = f2bf(acc[i]);
            if (tid < 64) { float sN = 0.f;
#pragma unroll
                for (int g = 0; g < 8; ++g) sN += nsum[g * 64 + tid];
                ((float*)(a.ws + WS_NL))[(size_t)u * 64 + tid] = sN; }
        }
        __syncthreads();
    }
}

__device__ __forceinline__ void phase4_scan(const Args& a, Frame& F) {
    const int tid = F.tid;
    LAS float* sd = (LAS float*)F.lds;
    const float* ml = (const float*)(a.ws + WS_ML); const float* bl = (const float*)(a.ws + WS_BL);
    for (int item = F.bx; item < 256; item += F.G) {
        const int bh = item >> 2, qtr = item & 3;
        const int e4 = qtr * 512 + tid;
        const bf16* Cl = (const bf16*)(a.ws + WS_CL) + (size_t)bh * 64 * 8192 + 4 * e4;
        bf16* Cp = (bf16*)(a.ws + WS_CPREV) + (size_t)bh * 64 * 8192 + 4 * e4;
        u32x2 clv[64];
#pragma unroll
        for (int n = 0; n < 64; ++n) clv[n] = *(const u32x2*)(Cl + (size_t)n * 8192);
        if (tid < 64) { sd[192 + tid] = ml[bh * 64 + tid]; sd[256 + tid] = bl[bh * 64 + tid]; }
        __syncthreads();
        if (tid == 0) { float m = 0.f;
            for (int n = 0; n < 64; ++n) { const float mlv = sd[192 + n], blv = sd[256 + n]; sd[128 + n] = m; const float mn = fmaxf(blv + m, mlv); sd[n] = __expf(blv + m - mn); sd[64 + n] = __expf(mlv - mn); m = mn; } }
        __syncthreads();
        float c0 = 0.f, c1 = 0.f, c2 = 0.f, c3 = 0.f;
#pragma unroll
        for (int n = 0; n < 64; ++n) {
            *(u32x2*)(Cp + (size_t)n * 8192) = (u32x2){pk2(c0, c1), pk2(c2, c3)};
            const u32x2 cl = clv[n];
            const float d = sd[n], f = sd[64 + n];
            c0 = d * c0 + f * bf2f(cl.x & 0xffffu); c1 = d * c1 + f * bf2f(cl.x >> 16); c2 = d * c2 + f * bf2f(cl.y & 0xffffu); c3 = d * c3 + f * bf2f(cl.y >> 16);
        }
        if (qtr == 0 && tid < 16) {
            const float* nl = (const float*)(a.ws + WS_NL) + (size_t)bh * 64 * 64 + 4 * tid; float* np = (float*)(a.ws + WS_NPREV) + (size_t)bh * 64 * 64 + 4 * tid;
            f32x4 nn = {0.f, 0.f, 0.f, 0.f};
            for (int n = 0; n < 64; ++n) { *(f32x4*)(np + n * 64) = nn; const f32x4 l4 = *(const f32x4*)(nl + n * 64); nn = nn * sd[n] + l4 * sd[64 + n]; }
        }
        if (qtr == 0 && tid >= 64 && tid < 128) ((float*)(a.ws + WS_MPREV))[bh * 64 + tid - 64] = sd[128 + tid - 64];
        __syncthreads();
    }
}

__device__ __forceinline__ void mlstm_C_phase(const Args& a, Frame& F) {
    const int tid = F.tid, lane = F.lane, wave = F.wave, r = lane & 31, hh = lane >> 5;
    const bf16* P = (const bf16*)(a.ws + WS_P);
    LAS bf16* rawq = (LAS bf16*)(F.lds);
    LAS bf16* rawk = (LAS bf16*)(F.lds + 8704);
    LAS bf16* Vt = (LAS bf16*)(F.lds + 17408);
    LAS bf16* qc = (LAS bf16*)(F.lds + 33792);
    LAS bf16* kc = (LAS bf16*)(F.lds + 43008);
    LAS bf16* Sb = (LAS bf16*)(F.lds + 52224);
    LAS float* gS = (LAS float*)(F.lds + 61440);
    LAS float* Ms = (LAS float*)(F.lds + 61696);
    LAS float* bs = (LAS float*)(F.lds + 61952);
    LAS float* ssum = (LAS float*)(F.lds + 62208);
    LAS float* npl = (LAS float*)(F.lds + 63232);
    const int tt = wave >> 2, vt = wave & 3;
    MPref p; p.ip = 0.f; p.lf = 0.f; p.mp = 0.f;
    if (F.vcu < NUNIT) mlstm_prefetch<true>(a, F.vcu, tid, p);
    for (int u = F.vcu; u < NUNIT; u += F.G) {
        const int b = u >> 8, h = (u >> 6) & 3, n = u & 63;
        const long r0 = (long)b * SEQ + (long)n * 64;
        const float mp = p.mp;
        int rg_ = r, hg_ = hh; asm volatile("" : "+v"(rg_), "+v"(hg_));
        mlstm_pref_to_lds<true>(p, rawq, rawk, Vt, tid);
        if (tid < 16) *(LAS f32x4*)(npl + 4 * tid) = p.npv;
        if (wave == 0) {
            const float bc = wave_scan_add(p.lf, lane);
            const float g = p.ip - bc;
            const float cm = wave_scan_max(g, lane);
            gS[lane] = g; Ms[lane] = fmaxf(mp, cm); bs[lane] = bc;
        }
        const bf16* Cp = (const bf16*)(a.ws + WS_CPREV) + (size_t)u * 8192;
        bf16x8 cfr[4];
#pragma unroll
        for (int st = 0; st < 4; ++st) cfr[st] = *(const bf16x8*)(Cp + (32 * vt + rg_) * 64 + 16 * st + 8 * hg_);
        u32x2 mo2[4]; f32x4 gv4[4];
#pragma unroll
        for (int g = 0; g < 4; ++g) { mo2[g] = *(const u32x2*)(P + (size_t)(r0 + 32 * tt + rg_) * NP + P_MO + h * 128 + 32 * vt + 8 * g + 4 * hg_);
            gv4[g] = *(const f32x4*)(a.in[I_MNG] + h * 128 + 32 * vt + 8 * g + 4 * hg_); }
        __syncthreads();
        float cqc[5], ckc[5];
#pragma unroll
        for (int j = 0; j < 5; ++j) { cqc[j] = p.cq[j]; ckc[j] = p.ck[j]; }
        mlstm_prefetch<true>(a, (u + F.G < NUNIT) ? u + F.G : u, tid, p);
        (void)conv_tile(qc, rawq, cqc, 1.f, nullptr, tid);
        (void)conv_tile(kc, rawk, ckc, 0.125f, nullptr, tid);
        __syncthreads();
        if (wave < 3) {
            const int ts = wave > 0, st = wave > 1;
            f32x16 acc = {};
#pragma unroll
            for (int kk = 0; kk < 4; ++kk) acc = __builtin_amdgcn_mfma_f32_32x32x16_bf16(*(const LAS bf16x8*)(qc + (32 * ts + r) * 72 + 16 * kk + 8 * hh), *(const LAS bf16x8*)(kc + (32 * st + r) * 72 + 16 * kk + 8 * hh), acc, 0, 0, 0);
            const int sabs = 32 * st + r; const float gs = gS[sabs];
#pragma unroll
            for (int i = 0; i < 16; ++i) { const int tabs = 32 * ts + crow(i, hh);
                const float val = (sabs <= tabs) ? acc[i] * __expf(gs - Ms[tabs]) : 0.f;
                Sb[tabs * 72 + sabs] = f2bf(val); }
        }
        __syncthreads();
        f32x16 outv;
        {
            bf16x8 qa[4], sa[4];
#pragma unroll
            for (int st = 0; st < 4; ++st) { qa[st] = *(const LAS bf16x8*)(qc + (32 * tt + r) * 72 + 16 * st + 8 * hh);
                sa[st] = (st < 2 * (tt + 1)) ? *(const LAS bf16x8*)(Sb + (32 * tt + r) * 72 + 16 * st + 8 * hh) : (bf16x8){0, 0, 0, 0, 0, 0, 0, 0}; }
            f32x16 d1 = {}, d2 = {}, a1 = {}, a2 = {};
            const short one = (r == 0) ? (short)0x3F80 : (short)0;
            const bf16x8 ones = {one, one, one, one, one, one, one, one};
#pragma unroll
            for (int st = 0; st < 4; ++st) {
                d1 = __builtin_amdgcn_mfma_f32_32x32x16_bf16(ones, sa[st], d1, 0, 0, 0);
                { const f32x4 n0 = *(const LAS f32x4*)(npl + 16 * st + 8 * hh), n1 = *(const LAS f32x4*)(npl + 16 * st + 8 * hh + 4);
                  const u32x4 pk = {pk2(n0.x, n0.y), pk2(n0.z, n0.w), pk2(n1.x, n1.y), pk2(n1.z, n1.w)}; const u32x4 zz = {0u, 0u, 0u, 0u};
                  d2 = __builtin_amdgcn_mfma_f32_32x32x16_bf16(__builtin_bit_cast(bf16x8, (r == 0) ? pk : zz), qa[st], d2, 0, 0, 0); }
                a1 = __builtin_amdgcn_mfma_f32_32x32x16_bf16(gather8(Vt, 128, 16 * st + 8 * hh, 32 * vt + r), sa[st], a1, 0, 0, 0);
                a2 = __builtin_amdgcn_mfma_f32_32x32x16_bf16(cfr[st], qa[st], a2, 0, 0, 0);
            }
            const int tabs = 32 * tt + r;
            const float Mt = Ms[tabs], iw = __expf(mp - Mt);
            float den = d1[0] + iw * d2[0];
            den += __shfl_xor(den, 32);
            const float inv = rcp_(fmaxf(fabsf(den), __expf(-(bs[tabs] + Mt))));
            float sq = 0.f;
#pragma unroll
            for (int i = 0; i < 16; ++i) { const float o = (a1[i] + iw * a2[i]) * inv; outv[i] = o; sq += o * o; }
            sq += __shfl_xor(sq, 32);
            if (hh == 0) ssum[tabs * 4 + vt] = sq;
        }
        __syncthreads();
        {
            bf16* cat = (bf16*)(a.ws + WS_H);
            int rs_ = r, hs_ = hh; asm volatile("" : "+v"(rs_), "+v"(hs_));
            const f32x4 s4 = *(const LAS f32x4*)(ssum + (32 * tt + r) * 4);
            const float rsn = rsq_(((s4.x + s4.y) + (s4.z + s4.w)) * (1.f / 128.f) + EPS);
#pragma unroll
            for (int g = 0; g < 4; ++g) {
                const float m0 = bf2f(mo2[g].x & 0xffffu), m1 = bf2f(mo2[g].x >> 16), m2 = bf2f(mo2[g].y & 0xffffu), m3 = bf2f(mo2[g].y >> 16);
                const float o0 = outv[4 * g] * rsn * gv4[g].x * sigmoidf_(m0), o1 = outv[4 * g + 1] * rsn * gv4[g].y * sigmoidf_(m1);
                const float o2 = outv[4 * g + 2] * rsn * gv4[g].z * sigmoidf_(m2), o3 = outv[4 * g + 3] * rsn * gv4[g].w * sigmoidf_(m3);
                *(u32x2*)(cat + (size_t)(r0 + 32 * tt + rs_) * D + h * 128 + 32 * vt + 8 * g + 4 * hs_) = (u32x2){pk2(o0, o1), pk2(o2, o3)};
            }
        }
        __syncthreads();
    }
}
__device__ __forceinline__ void pa_rows4(const Args& a, int row, int rstride, int lane, float lam) {
    const int head = lane >> 4, v0 = (lane & 15) * 8;
    u32x4 o0[4], o1[4];
#pragma unroll
    for (int k = 0; k < 4; ++k) { const bf16* O = (const bf16*)(a.ws + WS_O) + (size_t)(row + k * rstride) * D;
        o0[k] = *(const u32x4*)(O + (head * 2 + 0) * 128 + v0); o1[k] = *(const u32x4*)(O + (head * 2 + 1) * 128 + v0); }
    const float* g = a.in[I_DNG] + head * 128 + v0;
    const f32x4 g0 = *(const f32x4*)g, g1 = *(const f32x4*)(g + 4);
#pragma unroll
    for (int k = 0; k < 4; ++k) {
        float d[8]; float ss = 0.f;
#pragma unroll
        for (int i = 0; i < 4; ++i) { d[2 * i] = bf2f(o0[k][i] & 0xffffu) - lam * bf2f(o1[k][i] & 0xffffu); d[2 * i + 1] = bf2f(o0[k][i] >> 16) - lam * bf2f(o1[k][i] >> 16); }
#pragma unroll
        for (int i = 0; i < 8; ++i) ss += d[i] * d[i];
        ss += __shfl_xor(ss, 1); ss += __shfl_xor(ss, 2); ss += __shfl_xor(ss, 4); ss += __shfl_xor(ss, 8);
        const float rs = 0.8f * rsq_(ss * (1.f / 128.f) + EPS);
        *(u32x4*)((bf16*)(a.ws + WS_H) + (size_t)(row + k * rstride) * D + 512 + head * 128 + v0) =
            (u32x4){pk2(d[0] * rs * g0.x, d[1] * rs * g0.y), pk2(d[2] * rs * g0.z, d[3] * rs * g0.w), pk2(d[4] * rs * g1.x, d[5] * rs * g1.y), pk2(d[6] * rs * g1.z, d[7] * rs * g1.w)};
    }
}

__device__ __forceinline__ bool rt_better(float av, int ae, float bv, int be) { return av > bv || (av == bv && ae < be); }
__device__ __forceinline__ void phase7(const Args& a, Frame& F) {
    const int wave = F.wave;
    LAS float* gsl = (LAS float*)(F.lds + LDSCTL_OFF + 4096);
    LAS float* shl = (LAS float*)(F.lds + LDSCTL_OFF + 8192);
    LAS float* rsl = (LAS float*)(F.lds + LDSCTL_OFF + 12288);
    LAS float* cbl = (LAS float*)(F.lds + LDSCTL_OFF + 2048);
    LAS float* region = (LAS float*)F.lds;
    LAS float* fin = (LAS float*)(F.lds + 73728);
    LAS float* ssp = (LAS float*)(F.lds + 106496);
    LAS float* cbp = (LAS float*)(F.lds + 108544);
    const float* Wt = (const float*)(a.ws + WS_WRT);
    LAS int* lcount = (LAS int*)(F.lds + TAB_OFF + 160);
    if (F.tid < 32) lcount[F.tid] = 0;
    const float* x = a.in[I_X]; const float* g2 = a.in[I_N2G]; const float* mod = (const float*)(a.ws + WS_MOD); const float* brt = a.in[I_BR];
    const bf16* mixg = (const bf16*)(a.ws + WS_MIXG); unsigned char* h2 = a.ws + WS_H;
    unsigned* meta = (unsigned*)(a.ws + WS_META); float* gatew = (float*)(a.ws + WS_GATEW);
    unsigned* gcnt = F.ctl + CW_GCNT; int* wgbase = (int*)(a.ws + WS_WGBASE);
    for (int rb = F.bx; rb < NTOK / 256; rb += F.G) {
        int tid_ = F.tid; asm volatile("" : "+v"(tid_));
        const int tid = tid_, lane = tid & 63;
        const int b = rb >> 4;
        __syncthreads();
        for (int k = tid; k < 1024; k += 512) { gsl[k] = g2[k] * (1.f + mod[b * 6144 + 4096 + k]); shl[k] = mod[b * 6144 + 3072 + k]; }
        __syncthreads();
        {
            const int e = tid & 31, part = tid >> 5; float sacc = 0.f;
#pragma unroll 4
            for (int q = 0; q < 16; ++q) { const f32x4 w4 = *(const f32x4*)(Wt + (size_t)(16 * part + q) * 128 + e * 4); const f32x4 s4 = *(const LAS f32x4*)(shl + 64 * part + 4 * q);
                sacc += (w4.x * s4.x + w4.y * s4.y) + (w4.z * s4.z + w4.w * s4.w); }
            cbp[part * 32 + e] = sacc;
        }
        __syncthreads();
        if (tid < 32) { float sacc = brt[tid];
#pragma unroll
            for (int q = 0; q < 16; ++q) sacc += cbp[q * 32 + tid];
            cbl[tid] = sacc; }
        const int wrow0 = rb * 256 + wave * 32;
        {
            const int lr = lane >> 3, pc = lane & 7, rl = lane & 31, kk = lane >> 5, kbase = wave * 128;
            const unsigned lo_h = (unsigned)(lr * D + 4 * pc), lo_m = 2u * lo_h, lo_x = 4u * lo_h, lo_w = (unsigned)((4 * kk * 128 + rl * 4) * 4);
            const char* xu = (const char*)(x + (size_t)(rb * 256) * D + kbase); const char* mu = (const char*)(mixg + (size_t)(rb * 256) * D + kbase);
            unsigned char* hu = h2 + (size_t)(rb * 256) * D + kbase; const char* wu = (const char*)(Wt + (size_t)(kbase / 4) * 128);
            f32x4 xa[4], xb[4], xc[4], xd[4], wv[4]; u32x2 ma[4], mb[4], mc[4], md[4];
            u32x2 hb[4][4]; f32x16 acc; float ss4[4];
#define P7_LOAD(xv, mv, T, S) do { _Pragma("unroll") for (int i = 0; i < 4; ++i) { const size_t ro_ = (size_t)(32 * (T) + 8 * i) * D + 32 * (S); \
                xv[i] = *(const f32x4*)(xu + ro_ * 4 + ox); mv[i] = *(const u32x2*)(mu + ro_ * 2 + om); } } while (0)
#define P7_LOADW(wv, S) do { _Pragma("unroll") for (int q = 0; q < 4; ++q) wv[q] = *(const f32x4*)(wu + (size_t)((8 * (S) + q) * 512) + ow); } while (0)
#define P7_COMP(xv, mv, S, SN) do { const f32x4 g4 = *(const LAS f32x4*)(gsl + kbase + 32 * (S) + 4 * pc); \
                _Pragma("unroll") for (int i = 0; i < 4; ++i) { f32x4 v = xv[i]; \
                    v.x += bf2f(mv[i].x & 0xffffu); v.y += bf2f(mv[i].x >> 16); v.z += bf2f(mv[i].y & 0xffffu); v.w += bf2f(mv[i].y >> 16); \
                    ss4[i] += (v.x * v.x + v.y * v.y) + (v.z * v.z + v.w * v.w); \
                    const f32x4 h = v * g4; \
                    *(LAS f32x4*)(slab + (8 * i + lr) * 36 + 4 * pc) = h; hb[S][i] = (u32x2){pk2(h.x, h.y), pk2(h.z, h.w)}; } \
                LDS_WAIT(); \
                f32x4 hq[4]; \
                _Pragma("unroll") for (int q = 0; q < 4; ++q) hq[q] = *(const LAS f32x4*)(slab + rl * 36 + 16 * kk + 4 * q); \
                LDS_WAIT(); \
                _Pragma("unroll") for (int q = 0; q < 4; ++q) { \
                    acc = __builtin_amdgcn_mfma_f32_32x32x2f32(wv[q].x, hq[q].x, acc, 0, 0, 0); acc = __builtin_amdgcn_mfma_f32_32x32x2f32(wv[q].y, hq[q].y, acc, 0, 0, 0); \
                    acc = __builtin_amdgcn_mfma_f32_32x32x2f32(wv[q].z, hq[q].z, acc, 0, 0, 0); acc = __builtin_amdgcn_mfma_f32_32x32x2f32(wv[q].w, hq[q].w, acc, 0, 0, 0); \
                    wv[q] = *(const f32x4*)(wu + (size_t)((8 * (SN) + q) * 512) + ow); } } while (0)
            unsigned ox = lo_x, om = lo_m, oh = lo_h, ow = lo_w;
            P7_LOAD(xa, ma, 0, 0); P7_LOAD(xb, mb, 0, 1); P7_LOADW(wv, 0);
#pragma unroll 1
            for (int t = 0; t < 8; ++t) {
                asm volatile("" : "+v"(ox), "+v"(om), "+v"(oh), "+v"(ow));
                const int tn = (t + 1 < 8) ? t + 1 : 7;
                LAS float* slab = region + ((t & 1) * 8 + wave) * 1152;
                LAS float* sspb = ssp + (t & 1) * 256;
#pragma unroll
                for (int i = 0; i < 16; ++i) acc[i] = 0.f;
#pragma unroll
                for (int i = 0; i < 4; ++i) ss4[i] = 0.f;
#define P7_SB __builtin_amdgcn_sched_barrier(0)
                P7_SB; P7_LOAD(xc, mc, t, 2);  P7_SB; P7_COMP(xa, ma, 0, 1);
                P7_SB; P7_LOAD(xd, md, t, 3);  P7_SB; P7_COMP(xb, mb, 1, 2);
                P7_SB; P7_LOAD(xa, ma, tn, 0); P7_SB; P7_COMP(xc, mc, 2, 3);
                P7_SB; P7_LOAD(xb, mb, tn, 1); P7_SB; P7_COMP(xd, md, 3, 0); P7_SB;
#undef P7_SB
#pragma unroll
                for (int i = 0; i < 4; ++i) { float sv = ss4[i]; sv += __shfl_xor(sv, 1); sv += __shfl_xor(sv, 2); sv += __shfl_xor(sv, 4); ss4[i] = sv; }
                if (pc == 0) {
#pragma unroll
                    for (int i = 0; i < 4; ++i) sspb[wave * 32 + 8 * i + lr] = ss4[i]; }
#pragma unroll
                for (int i = 0; i < 16; ++i) slab[i * 64 + lane] = acc[i];
                LDS_WAIT(); asm volatile("" ::: "memory"); __builtin_amdgcn_s_barrier(); asm volatile("" ::: "memory");
                float rs4[4];
#pragma unroll
                for (int i = 0; i < 4; ++i) { float sv = 0.f;
#pragma unroll
                    for (int w = 0; w < 8; ++w) sv += sspb[w * 32 + 8 * i + lr];
                    rs4[i] = rsq_(sv * (1.f / D) + EPS); }
                if (wave == 0 && pc == 0) {
#pragma unroll
                    for (int i = 0; i < 4; ++i) rsl[t * 32 + 8 * i + lr] = rs4[i]; }
                {
                    const LAS float* rt = region + (t & 1) * 8 * 1152;
#pragma unroll
                    for (int o = 0; o < 2; ++o) { float sv = 0.f;
#pragma unroll
                        for (int w = 0; w < 8; ++w) sv += rt[w * 1152 + o * 512 + tid];
                        fin[t * 1024 + o * 512 + tid] = sv; } }
#pragma unroll
                for (int S = 0; S < 4; ++S) { const f32x4 s4 = *(const LAS f32x4*)(shl + kbase + 32 * S + 4 * pc);
#pragma unroll
                    for (int i = 0; i < 4; ++i) { const u32x2 hv = hb[S][i];
                        *(unsigned*)(hu + (size_t)(32 * t + 8 * i) * D + 32 * S + oh) = pk4_fp8(bf2f(hv.x & 0xffffu) * rs4[i] + s4.x, bf2f(hv.x >> 16) * rs4[i] + s4.y, bf2f(hv.y & 0xffffu) * rs4[i] + s4.z, bf2f(hv.y >> 16) * rs4[i] + s4.w); } }
            }
#undef P7_LOAD
#undef P7_LOADW
#undef P7_COMP
        }
        __syncthreads();
        f32x16 acc;
        { const float rsr = rsl[wave * 32 + (lane & 31)];
#pragma unroll
          for (int i = 0; i < 16; ++i) acc[i] = fin[wave * 1024 + i * 64 + lane] * rsr; }
        {
            const int hh = lane >> 5;
            float v[16];
#pragma unroll
            for (int i = 0; i < 16; ++i) v[i] = acc[i] + cbl[crow(i, hh)];
            float cv[8]; int ce[8];
#pragma unroll
            for (int k = 0; k < 4; ++k) { float bv = v[0]; int bi_ = 0;
#pragma unroll
                for (int i = 1; i < 16; ++i) { if (v[i] > bv) { bv = v[i]; bi_ = i; } }
                cv[k] = bv; ce[k] = crow(bi_, hh);
#pragma unroll
                for (int i = 0; i < 16; ++i) v[i] = (i == bi_) ? -INFINITY : v[i]; }
#pragma unroll
            for (int k = 0; k < 4; ++k) { cv[4 + k] = __shfl_xor(cv[k], 32); ce[4 + k] = __shfl_xor(ce[k], 32); }
            float tv[4]; int te[4];
#pragma unroll
            for (int k = 0; k < 4; ++k) { float bv = cv[0]; int be = ce[0], bj = 0;
#pragma unroll
                for (int j = 1; j < 8; ++j) { if (rt_better(cv[j], ce[j], bv, be)) { bv = cv[j]; be = ce[j]; bj = j; } }
                tv[k] = bv; te[k] = be;
#pragma unroll
                for (int j = 0; j < 8; ++j) cv[j] = (j == bj) ? -INFINITY : cv[j]; }
            const float p1 = __expf(tv[1] - tv[0]), p2 = __expf(tv[2] - tv[0]), p3 = __expf(tv[3] - tv[0]); const float isum = rcp_(1.f + p1 + p2 + p3);
            if (hh == 0) {
                const int row = wrow0 + lane;
                u32x4 m4; const f32x4 g4 = {isum, p1 * isum, p2 * isum, p3 * isum};
#pragma unroll
                for (int k = 0; k < 4; ++k) { const int lr = __hip_atomic_fetch_add(lcount + (te[k] & 31), 1, __ATOMIC_RELAXED, __HIP_MEMORY_SCOPE_WORKGROUP); m4[k] = (unsigned)(te[k] & 31) | ((unsigned)lr << 8); }
                *(u32x4*)(meta + (size_t)row * 4) = m4; *(f32x4*)(gatew + (size_t)row * 4) = g4;
            }
        }
        __syncthreads();
        if (tid < 32) { const int c = lcount[tid]; const unsigned base = __hip_atomic_fetch_add(gcnt + tid, (unsigned)c, __ATOMIC_RELAXED, __HIP_MEMORY_SCOPE_AGENT); wgbase[rb * 32 + tid] = (int)base; lcount[tid] = 0; }
    }
    __syncthreads();
}

__device__ __forceinline__ void phase8(const Args& a, Frame& F) {
    const int tid = F.tid;
    LAS int* pstart = (LAS int*)(F.lds + TAB_OFF + 320);
    LAS int* cntl = (LAS int*)(F.lds + TAB_OFF + 480);
    const unsigned* gcnt = F.ctl + CW_GCNT;
    if (tid < 64) {
        const int c = (tid < 32) ? (int)gcnt[tid] : 0; const int pad = ((c + 255) >> 8) << 8;
        int inc = pad;
#pragma unroll
        for (int o = 1; o < 32; o <<= 1) { const int t = __shfl_up(inc, o); if ((tid & 63) >= o) inc += t; }
        if (tid < 32) { cntl[tid] = c; pstart[tid] = inc - pad; }
        if (tid == 31) pstart[32] = inc;
    }
    __syncthreads();
    const unsigned* meta = (const unsigned*)(a.ws + WS_META); const int* wgbase = (const int*)(a.ws + WS_WGBASE);
    int* pos = (int*)(a.ws + WS_POS); int* rowtok = (int*)(a.ws + WS_ROWTOK);
    for (int slot = F.bx * 512 + tid; slot < NSLOT; slot += F.G * 512) {
        const unsigned m = meta[slot]; const int e = m & 255, lr = m >> 8, row = slot >> 2, rb = row >> 8;
        const int dest = pstart[e] + wgbase[rb * 32 + e] + lr;
        pos[slot] = dest; rowtok[dest] = row;
    }
    for (int e = F.bx; e < 32; e += F.G) for (int d = pstart[e] + cntl[e] + tid; d < pstart[e + 1]; d += 512) rowtok[d] = 0;
}
__device__ __forceinline__ const LAS int* moe_tiles(Frame& F) {
    LAS int* ptile = (LAS int*)(F.lds + TAB_OFF);
    const unsigned* gcnt = F.ctl + CW_GCNT;
    if (F.tid < 64) {
        const int nt_ = (F.tid < 32) ? (((int)gcnt[F.tid] + 255) >> 8) : 0;
        int inc = nt_;
#pragma unroll
        for (int o = 1; o < 32; o <<= 1) { const int t = __shfl_up(inc, o); if ((F.tid & 63) >= o) inc += t; }
        if (F.tid < 32) ptile[F.tid] = inc - nt_;
        if (F.tid == 31) ptile[32] = inc;
    }
    __syncthreads();
    return ptile;
}

__device__ __forceinline__ void phase11(const Args& a, Frame& F) {
    const int lane = F.lane;
    const float* x = a.in[I_X]; const float* mod = (const float*)(a.ws + WS_MOD);
    const bf16* mixg = (const bf16*)(a.ws + WS_MIXG); const unsigned char* orow = a.ws + WS_OUTROWS;
    const int* pos = (const int*)(a.ws + WS_POS); const float* gatew = (const float*)(a.ws + WS_GATEW);
    const int gw = F.vcu * NWAVES + F.wave, NGW = F.G * NWAVES;
    for (int row = gw; row < NTOK; row += NGW) {
        const int b = row >> 12;
        const int p0 = pos[row * 4], p1 = pos[row * 4 + 1], p2 = pos[row * 4 + 2], p3 = pos[row * 4 + 3];
        const f32x4 gk = *(const f32x4*)(gatew + (size_t)row * 4);
#pragma unroll
        for (int j = 0; j < 4; ++j) {
            const int col = 256 * j + 4 * lane; const size_t off = (size_t)row * D + col;
            const f32x4 xv = *(const f32x4*)(x + off); const u32x2 mg = *(const u32x2*)(mixg + off);
            const f32x4 g2 = *(const f32x4*)(mod + b * 6144 + 5120 + col);
            const unsigned e0 = *(const unsigned*)(orow + (size_t)p0 * D + col), e1 = *(const unsigned*)(orow + (size_t)p1 * D + col), e2 = *(const unsigned*)(orow + (size_t)p2 * D + col), e3 = *(const unsigned*)(orow + (size_t)p3 * D + col);
            const f32x2 a0 = __builtin_amdgcn_cvt_pk_f32_fp8((int)e0, false), b0 = __builtin_amdgcn_cvt_pk_f32_fp8((int)e0, true), a1 = __builtin_amdgcn_cvt_pk_f32_fp8((int)e1, false), b1 = __builtin_amdgcn_cvt_pk_f32_fp8((int)e1, true);
            const f32x2 a2 = __builtin_amdgcn_cvt_pk_f32_fp8((int)e2, false), b2 = __builtin_amdgcn_cvt_pk_f32_fp8((int)e2, true), a3 = __builtin_amdgcn_cvt_pk_f32_fp8((int)e3, false), b3 = __builtin_amdgcn_cvt_pk_f32_fp8((int)e3, true);
            f32x4 m;
            m.x = gk.x * a0.x + gk.y * a1.x + gk.z * a2.x + gk.w * a3.x; m.y = gk.x * a0.y + gk.y * a1.y + gk.z * a2.y + gk.w * a3.y;
            m.z = gk.x * b0.x + gk.y * b1.x + gk.z * b2.x + gk.w * b3.x; m.w = gk.x * b0.y + gk.y * b1.y + gk.z * b2.y + gk.w * b3.y;
            f32x4 o; o.x = xv.x + bf2f(mg.x & 0xffffu) + g2.x * m.x; o.y = xv.y + bf2f(mg.x >> 16) + g2.y * m.y; o.z = xv.z + bf2f(mg.y & 0xffffu) + g2.z * m.z; o.w = xv.w + bf2f(mg.y >> 16) + g2.w * m.w;
            *(f32x4*)(a.out + off) = o;
        }
    }
}

__global__ void __launch_bounds__(NWAVES * 64, 2) hybrid_fwd(Args args) {
    extern __shared__ __attribute__((aligned(16))) unsigned char lds[];
    Frame F;
    F.lds = (LAS unsigned char*)lds;
    F.MISC = (volatile LAS unsigned*)(F.lds + MISC_OFF);
    F.tid = threadIdx.x; F.lane = F.tid & 63; F.wave = __builtin_amdgcn_readfirstlane(F.tid >> 6);
    F.G = gridDim.x; F.bx = blockIdx.x; F.vcu = (F.G % 8 == 0) ? (F.bx % 8) * (F.G / 8) + F.bx / 8 : F.bx;
    F.ctl = (unsigned*)(args.ws + WS_CTL);
    for (int u = F.tid; u < (LDS_BYTES - LDSCTL_OFF) / 4; u += NWAVES * 64) ((LAS unsigned*)(F.lds + LDSCTL_OFF))[u] = 0u;
    __syncthreads();
    XcdBarrier bar; bar.bar = F.ctl + CW_BAR; bar.x = 0; bar.st = nullptr;
    if (N_LAUNCHES == 1) bar = xcd_barrier_post(F.ctl + CW_BAR, F.MISC + 8);
    const int lo = args.ph_lo, hi = args.ph_hi;
#ifndef PH_MASK
#define PH_MASK 0xFFF
#endif
#define IN(k) (((PH_MASK >> (k)) & 1) && lo <= (k) && (k) < hi)
#define REFRESH() do { int t_ = threadIdx.x; asm volatile("" : "+v"(t_)); F.tid = t_; F.lane = t_ & 63; F.wave = __builtin_amdgcn_readfirstlane(t_ >> 6); } while (0)
#define SEAM(k) do { if (IN(k) && IN((k) + 1)) { if (N_LAUNCHES == 1) xcd_barrier(bar); } } while (0)
    unsigned char* ws = args.ws;

    if (IN(0)) { REFRESH(); phase0(args, F); } SEAM(0);
    if (IN(1)) { REFRESH(); phase1(args, F); } SEAM(1);
    if (IN(2)) { REFRESH();
        pg8::PlainOrder S; S.init(NTOK, NP, D, F.G, F.bx, ws + WS_H, ws + WS_WINT);
        pg8::EpiBf16 E{(bf16*)(ws + WS_P), NP, nullptr, 0, 1.f};
        pg8::gemm_phase<pg8::EpiBf16, pg8::PlainOrder, false>(F.lds + RING_OFF, D, S, E, nullptr);
    } SEAM(2);
    if (IN(3)) { REFRESH();
        if (args.sub != 1) for (int row = F.vcu * NWAVES + F.wave; row < NTOK; row += 4 * F.G * NWAVES) rope_rows4(args, row, F.G * NWAVES, F.lane);
        if (args.sub != 2) mlstm_A_phase(args, F);
    } SEAM(3);
    if (IN(4)) { REFRESH();
        if (args.sub != 1) phase4_scan(args, F);
        if (args.sub != 2) {
            const float s1 = wave_sum(args.in[I_LQ1][F.lane] * args.in[I_LK1][F.lane]), s2 = wave_sum(args.in[I_LQ2][F.lane] * args.in[I_LK2][F.lane]);
            const float lam = expf(s1) - expf(s2) + 0.2f;
            for (int item = F.vcu; item < 256; item += F.G) attn_body::attn_pair<8>((char*)lds + RING_OFF, (const attn_body::bf16*)(ws + WS_P), (attn_body::bf16*)(ws + WS_O), (attn_body::bf16*)(ws + WS_H), args.in[I_DNG], lam, item);
        }
    } SEAM(4);
    if (IN(5)) { REFRESH();
        if (args.sub != 2) mlstm_C_phase(args, F);
    } SEAM(5);
    if (IN(6)) { REFRESH();
        pg8::PlainOrder S; S.init(NTOK, D, D, F.G, F.bx, ws + WS_H, ws + WS_WOUTT);
        pg8::EpiScaleBf16 E{(bf16*)(ws + WS_MIXG), D, (const float*)(ws + WS_MOD) + 2048, 6144};
        pg8::gemm_phase<pg8::EpiScaleBf16, pg8::PlainOrder, false>(F.lds + RING_OFF, D, S, E, nullptr);
        if (args.sub != 2) wgu_copy(args, F);
    } SEAM(6);
    if (IN(7)) { REFRESH(); phase7(args, F); } SEAM(7);
    if (IN(8)) { REFRESH(); phase8(args, F); } SEAM(8);
    if (IN(9)) { REFRESH();
        const LAS int* ptile = moe_tiles(F);
        pg8::MoeOrder S{ptile[32], 8, F.G, F.bx, (const char*)(ws + WS_H), (const char*)(ws + WS_WGUT), (size_t)256 * D, (size_t)2048 * D, ptile, true};
        pg8::EpiSwiglu E{ws + WS_ACT, (const float*)(ws + WS_BGU), 1.f / WQ_SCALE};
        pg8::gemm_phase<pg8::EpiSwiglu, pg8::MoeOrder, true, true>(F.lds + RING_OFF, D, S, E, (const int*)(ws + WS_ROWTOK));
    } SEAM(9);
    if (IN(10)) { REFRESH();
        const LAS int* ptile = moe_tiles(F);
        pg8::MoeOrder S{ptile[32], 4, F.G, F.bx, (const char*)(ws + WS_ACT), (const char*)(ws + WS_WDT), (size_t)256 * DFF, (size_t)D * DFF, ptile, true};
        pg8::EpiOut<true, true> E{(bf16*)(ws + WS_OUTROWS), D, args.in[I_BD], D, 1.f / WQ_SCALE};
        pg8::gemm_phase<pg8::EpiOut<true, true>, pg8::MoeOrder, true, true>(F.lds + RING_OFF, DFF, S, E, (const int*)(ws + WS_IDENT));
    } SEAM(10);
    if (IN(11)) { REFRESH(); phase11(args, F); }
#undef IN
#undef SEAM
}

extern "C" void kernel_launch(void* const* d_in, const int* in_sizes, int n_in, void* d_out, int out_size, void* d_ws, size_t ws_size, hipStream_t stream) {
    static int grid = 0;
    if (grid == 0) {
        if (n_in != 26 || in_sizes[0] != NTOK * D || out_size != NTOK * D || ws_size < WS_END) { fprintf(stderr, "kernel_launch: unexpected shapes (n_in %d, ws %zu); nothing launched\n", n_in, ws_size); grid = -1; return; }
        int dev = 0, cus = 0, per_cu = 0;
        if (hipGetDevice(&dev) != hipSuccess || hipDeviceGetAttribute(&cus, hipDeviceAttributeMultiprocessorCount, dev) != hipSuccess) { grid = -1; return; }
        if (hipFuncSetAttribute((const void*)hybrid_fwd, hipFuncAttributeMaxDynamicSharedMemorySize, LDS_BYTES) != hipSuccess) { grid = -1; return; }
        if (hipOccupancyMaxActiveBlocksPerMultiprocessor(&per_cu, (const void*)hybrid_fwd, NWAVES * 64, LDS_BYTES) != hipSuccess || per_cu < 1) { fprintf(stderr, "kernel_launch: occupancy query says %d\n", per_cu); }
        (void)hipGetLastError();
        grid = cus;
        if (NTOK % (4 * grid * NWAVES) != 0 || grid % 8 != 0) { fprintf(stderr, "kernel_launch: grid %d does not divide the row batches; nothing launched\n", grid); grid = -1; return; }
    }
    if (grid < 0) return;
    if (hipMemsetAsync((char*)d_ws + WS_CTL, 0, CTL_ZERO_BYTES, stream) != hipSuccess) return;
    Args a{};
    for (int i = 0; i < 26; ++i) a.in[i] = (const float*)d_in[i];
    a.out = (float*)d_out; a.ws = (unsigned char*)d_ws;
    for (int li = 0; li < N_LAUNCHES; ++li) {
        a.ph_lo = (N_LAUNCHES == 1) ? 0 : li; a.ph_hi = (N_LAUNCHES == 1) ? NPHASE : li + 1;
        for (int rep = 0; rep < 1 + ((N_LAUNCHES == 1) ? 0 : ((RPT_MASK >> li) & 1)); ++rep) {
            a.sub = rep ? RPT_SUB : 0;
            hipLaunchKernelGGL(hybrid_fwd, dim3(grid), dim3(NWAVES * 64), LDS_BYTES, stream, a); }
    }
}
```

```cpp
#include <hip/hip_runtime.h>
#include <cstdio>
#include <cstdint>
#include <cmath>

#define LAS __attribute__((address_space(3)))
#define GAS __attribute__((address_space(1)))
typedef unsigned short bf16;
typedef short bf16x8 __attribute__((ext_vector_type(8)));
typedef short s16x4 __attribute__((ext_vector_type(4)));
typedef float f32x2 __attribute__((ext_vector_type(2)));
typedef float f32x4 __attribute__((ext_vector_type(4)));
typedef float f32x16 __attribute__((ext_vector_type(16)));
typedef unsigned u32x2 __attribute__((ext_vector_type(2)));
typedef unsigned u32x4 __attribute__((ext_vector_type(4)));
typedef __bf16 bf16x2_t __attribute__((ext_vector_type(2)));
typedef int i32x4 __attribute__((ext_vector_type(4)));
typedef int i32x8 __attribute__((ext_vector_type(8)));

constexpr int D = 1024, BATCH = 16, SEQ = 4096, NTOK = BATCH * SEQ;
constexpr int NP = 3072;
constexpr int P_MQ = 0, P_MK = 256, P_MV = 512, P_MO = 1024, P_AQ = 1536, P_AK = 2048, P_AV = 2560;
constexpr int IN_W = 3080;
constexpr int NE = 32, DFF = 1024, NSLOT = NTOK * 4;
constexpr int CHUNK = 64, NCH = SEQ / CHUNK, NUNIT = BATCH * 4 * NCH;
constexpr float EPS = 1e-6f;
constexpr int MAXTILES = 1056;

constexpr size_t MiB = 1u << 20;
constexpr size_t WS_CTL = 0, CTL_ZERO_BYTES = 65536;
constexpr size_t WS_MOD = 1 * MiB, WS_ROPE = 2 * MiB, WS_WG = 3 * MiB, WS_WRT = 3 * MiB + 65536, WS_BGU = 3 * MiB + 262144;
constexpr size_t WS_GATES = 4 * MiB, WS_WINT = 6 * MiB, WS_WOUTT = 12 * MiB;
constexpr size_t WS_ML = 14 * MiB, WS_BL = 14 * MiB + 65536, WS_MPREV = 14 * MiB + 131072, WS_NL = 15 * MiB, WS_NPREV = 16 * MiB;
constexpr size_t WS_META = 17 * MiB, WS_GATEW = 18 * MiB, WS_POS = 19 * MiB, WS_ROWTOK = 20 * MiB, WS_WGBASE = 22 * MiB, WS_IDENT = 22 * MiB + 65536;
constexpr size_t WS_H = 24 * MiB;
constexpr size_t WS_P = 152 * MiB;
constexpr size_t WS_CL = 536 * MiB, WS_CPREV = 600 * MiB, WS_O = 664 * MiB;
constexpr size_t WS_WGUT = 152 * MiB;
constexpr size_t WS_ACT = 560 * MiB;
constexpr size_t WS_OUTROWS = 24 * MiB;
constexpr size_t WS_WDT = 832 * MiB;
constexpr size_t WS_MIXG = 896 * MiB;
constexpr size_t WS_END = 1024 * MiB;
static_assert(WS_OUTROWS + (size_t)MAXTILES * 256 * 2048 <= WS_ACT && WS_ACT + (size_t)MAXTILES * 256 * 1024 <= WS_WDT, "ws map");
constexpr int CW_TMO = 0, CW_BAR = 4096, CW_GCNT = 8192;
static_assert((CW_GCNT + 64) * 4 <= (int)CTL_ZERO_BYTES && (CW_BAR + 3456) <= CW_GCNT, "control words inside the per-call memset");

constexpr int RING_OFF = 0, RING_BYTES = 131072;
constexpr int LDSCTL_OFF = RING_BYTES;
constexpr int MISC_OFF = LDSCTL_OFF + 320;
constexpr int TAB_OFF = LDSCTL_OFF + 1024;
constexpr int LDS_BYTES = 147456;
constexpr int NWAVES = 8;

__device__ __forceinline__ float bf2f(unsigned h) { return __uint_as_float(h << 16); }
__device__ __forceinline__ unsigned pk2(float lo, float hi) { f32x2 v = {lo, hi}; bf16x2_t b = __builtin_convertvector(v, bf16x2_t); return __builtin_bit_cast(unsigned, b); }
__device__ __forceinline__ bf16 f2bf(float f) { return (bf16)(pk2(f, 0.f) & 0xffffu); }
__device__ __forceinline__ unsigned pk4_fp8(float a, float b, float c, float d) { int p = __builtin_amdgcn_cvt_pk_fp8_f32(a, b, 0, false); return (unsigned)__builtin_amdgcn_cvt_pk_fp8_f32(c, d, p, true); }
#define DPP_STEP(T2I, I2T, OP, x, idn, ctrl, rmask) OP(x, I2T(__builtin_amdgcn_update_dpp(T2I(idn), T2I(x), ctrl, rmask, 0xF, false)))
#define DPP_REDUCE(T2I, I2T, OP, x, idn) do { x = DPP_STEP(T2I, I2T, OP, x, idn, 0x111, 0xF); x = DPP_STEP(T2I, I2T, OP, x, idn, 0x112, 0xF); x = DPP_STEP(T2I, I2T, OP, x, idn, 0x114, 0xF); \
    x = DPP_STEP(T2I, I2T, OP, x, idn, 0x118, 0xF); x = DPP_STEP(T2I, I2T, OP, x, idn, 0x142, 0xA); x = DPP_STEP(T2I, I2T, OP, x, idn, 0x143, 0xC); } while (0)
#define OP_ADDF(a, b) ((a) + (b))
#define OP_MAXF(a, b) fmaxf((a), (b))
#define OP_MINI(a, b) ((b) < (a) ? (b) : (a))
#define ID_I(x) (x)
__device__ __forceinline__ float wave_sum(float v) { DPP_REDUCE(__float_as_int, __int_as_float, OP_ADDF, v, 0.f); return __int_as_float(__builtin_amdgcn_readlane(__float_as_int(v), 63)); }
__device__ __forceinline__ float wave_max(float v) {
#pragma unroll
    for (int o = 1; o < 64; o <<= 1) v = fmaxf(v, __shfl_xor(v, o));
    return v;
}
__device__ __forceinline__ int wave_min_i(int v) {
#pragma unroll
    for (int o = 1; o < 64; o <<= 1) { int t = __shfl_xor(v, o); v = t < v ? t : v; }
    return v;
}
__device__ __forceinline__ float half_sum32(float v) {
#pragma unroll
    for (int o = 1; o < 32; o <<= 1) v += __shfl_xor(v, o);
    return v;
}
__device__ __forceinline__ float rcp_(float x) { return __builtin_amdgcn_rcpf(x); }
__device__ __forceinline__ float rsq_(float x) { return __builtin_amdgcn_rsqf(x); }
__device__ __forceinline__ float sigmoidf_(float z) { return rcp_(1.f + __expf(-z)); }
#define LDS_WAIT() asm volatile("s_waitcnt lgkmcnt(0)" ::: "memory")
#define VM_WAIT() asm volatile("s_waitcnt vmcnt(0)" ::: "memory")

namespace pg8 {
#define PG8_LAS __attribute__((address_space(3)))
constexpr int BM = 256, BK = 64, HALF = 128, HTB = HALF * BK * 2, STAGE_BYTES = 8 * HTB, NXCD = 8, WGM = 8;
__host__ __device__ __forceinline__ int lds_byte(int r, int c) { const int st = (r >> 4) * 2 + (c >> 5), rr = r & 15, cc = c & 31, ob = rr * 64 + cc * 2; return st * 1024 + (ob ^ (((ob >> 9) & 1) << 5)); }
__host__ __device__ __forceinline__ void stage_rc(int b, int& R, int& C) { const int st = b / 1024, sb = b % 1024, swz = sb ^ (((sb >> 9) & 1) << 5); R = (st >> 1) * 16 + swz / 64; C = (st & 1) * 32 + (swz % 64) / 2; }
__host__ __device__ __forceinline__ int perm32(int rho) { const int n = rho >> 4, i = rho & 15; return 8 * (i >> 2) + 4 * n + (i & 3); }

struct Unit { int pm, pn, e; const char* a; const char* b; };

__device__ __forceinline__ bool tile_of(long L, int nM, int nN, int& pm, int& pn) {
    const int nwg = nM * nN; if (L >= nwg) return false;
    int wgid = (int)L; { const int q = nwg / NXCD, r = nwg % NXCD, xcd = wgid % NXCD, off = wgid / NXCD; wgid = (xcd < r ? xcd * (q + 1) : r * (q + 1) + (xcd - r) * q) + off; }
    const int nig = WGM * nN, gid = wgid / nig, fm = gid * WGM, gsz = (nM - fm) < WGM ? (nM - fm) : WGM;
    pm = fm + ((wgid % nig) % gsz); pn = (wgid % nig) / gsz; return true;
}
struct PlainOrder {
    int nM, nN, G, c; const char* A; const char* Bt; size_t tstep;
    __device__ __forceinline__ void init(int M, int N, int K, int G_, int c_, const void* A_, const void* Bt_) { nM = M / BM; nN = N / BM; G = G_; c = c_; A = (const char*)A_; Bt = (const char*)Bt_; tstep = (size_t)BM * K * 2; }
    __device__ __forceinline__ bool next(int i, Unit& u) const {
        if (!tile_of((long)i * G + c, nM, nN, u.pm, u.pn)) return false;
        u.e = 0; u.a = A + (size_t)u.pm * tstep; u.b = Bt + (size_t)u.pn * tstep; return true;
    }
};
struct MoeOrder {
    int nM, nN, G, c; const char* A0; const char* Bt; size_t tstep, estride; const LAS int* ptile; bool gather;
    __device__ __forceinline__ bool next(int i, Unit& u) const {
        if (!tile_of((long)i * G + c, nM, nN, u.pm, u.pn)) return false;
        int e = 0;
#pragma unroll
        for (int s = 16; s >= 1; s >>= 1) { if (ptile[e + s] <= u.pm) e += s; }
        u.e = e; u.b = Bt + (size_t)e * estride + (size_t)u.pn * tstep;
        u.a = gather ? A0 : A0 + (size_t)u.pm * tstep;
        return true;
    }
};

template <bool OUT8, bool HASB>
struct EpiOut {
    static constexpr bool HAS_VEC = HASB, ACC_BIAS = false;
    bf16* O; int ldc; const float* bias; int bstride; float ascale;
    __device__ __forceinline__ const float* vec_ptr(const Unit& u) const { return bias + (size_t)u.e * bstride + u.pn * BM; }
    __device__ __forceinline__ void operator()(const f32x4 (&acc)[2][2][4][2], const Unit& u, int wr, int wc, int fr, int fq, const PG8_LAS float* vl) const {
        asm volatile("" : "+v"(fr), "+v"(fq));
        const int row0 = u.pm * BM + wr * 64 + fr, col0 = u.pn * BM + wc * 64 + 16 * fq;
        f32x4 bv[2][2];
#pragma unroll
        for (int bj = 0; bj < 2; ++bj)
#pragma unroll
            for (int n = 0; n < 2; ++n) bv[bj][n] = HASB ? *(const PG8_LAS f32x4*)(vl + wc * 64 + 16 * fq + 8 * bj + 4 * n) : (f32x4){0.f, 0.f, 0.f, 0.f};
#pragma unroll
        for (int ai = 0; ai < 2; ++ai)
#pragma unroll
            for (int m = 0; m < 4; ++m) { bf16* rowp = O + (size_t)(row0 + ai * HALF + m * 16) * ldc + col0;
                const f32x4 v00 = acc[ai][0][m][0] * ascale + bv[0][0], v01 = acc[ai][0][m][1] * ascale + bv[0][1], v10 = acc[ai][1][m][0] * ascale + bv[1][0], v11 = acc[ai][1][m][1] * ascale + bv[1][1];
                if constexpr (OUT8) { *(u32x4*)((unsigned char*)O + (size_t)(row0 + ai * HALF + m * 16) * ldc + col0) = (u32x4){pk4_fp8(v00[0], v00[1], v00[2], v00[3]), pk4_fp8(v01[0], v01[1], v01[2], v01[3]), pk4_fp8(v10[0], v10[1], v10[2], v10[3]), pk4_fp8(v11[0], v11[1], v11[2], v11[3])}; }
                else { *(u32x4*)rowp = (u32x4){pk2(v00[0], v00[1]), pk2(v00[2], v00[3]), pk2(v01[0], v01[1]), pk2(v01[2], v01[3])};
                    *(u32x4*)(rowp + 8) = (u32x4){pk2(v10[0], v10[1]), pk2(v10[2], v10[3]), pk2(v11[0], v11[1]), pk2(v11[2], v11[3])}; } }
    }
};
typedef EpiOut<false, false> EpiBf16;
struct EpiScaleBf16 {
    static constexpr bool HAS_VEC = true, ACC_BIAS = false;
    bf16* O; int ldc; const float* scale; int spitch;
    __device__ __forceinline__ const float* vec_ptr(const Unit& u) const { return scale + (size_t)((u.pm * BM) / SEQ) * spitch + u.pn * BM; }
    __device__ __forceinline__ void operator()(const f32x4 (&acc)[2][2][4][2], const Unit& u, int wr, int wc, int fr, int fq, const PG8_LAS float* vl) const {
        asm volatile("" : "+v"(fr), "+v"(fq));
        const int row0 = u.pm * BM + wr * 64 + fr, col0 = u.pn * BM + wc * 64 + 16 * fq;
        f32x4 sv[2][2];
#pragma unroll
        for (int bj = 0; bj < 2; ++bj)
#pragma unroll
            for (int n = 0; n < 2; ++n) sv[bj][n] = *(const PG8_LAS f32x4*)(vl + wc * 64 + 16 * fq + 8 * bj + 4 * n);
#pragma unroll
        for (int ai = 0; ai < 2; ++ai)
#pragma unroll
            for (int m = 0; m < 4; ++m) { bf16* rowp = O + (size_t)(row0 + ai * HALF + m * 16) * ldc + col0;
#pragma unroll
                for (int bj = 0; bj < 2; ++bj) { const f32x4 v0 = acc[ai][bj][m][0] * sv[bj][0], v1 = acc[ai][bj][m][1] * sv[bj][1];
                    u32x4 w; w.x = pk2(v0[0], v0[1]); w.y = pk2(v0[2], v0[3]); w.z = pk2(v1[0], v1[1]); w.w = pk2(v1[2], v1[3]);
                    *(u32x4*)(rowp + 8 * bj) = w; } }
    }
};
struct EpiSwiglu {
    static constexpr bool HAS_VEC = false, ACC_BIAS = true;
    unsigned char* O; const float* bias; float ascale;
    __device__ __forceinline__ const float* vec_ptr(const Unit& u) const { return bias + (size_t)u.e * 2048 + u.pn * BM; }
    __device__ __forceinline__ void acc_init(f32x4 (&acc)[2][2][4][2], const PG8_LAS float* vl, int wc, int fq) const {
        int q_ = fq; asm volatile("" : "+v"(q_));
        const PG8_LAS float* bp = vl + wc * 64 + 16 * q_;
        const float inv = 1.f / ascale;
#pragma unroll
        for (int b = 0; b < 2; ++b)
#pragma unroll
            for (int n = 0; n < 2; ++n) { const f32x4 v = *(const PG8_LAS f32x4*)(bp + 8 * b + 4 * n) * inv;
#pragma unroll
                for (int a = 0; a < 2; ++a)
#pragma unroll
                    for (int m = 0; m < 4; ++m) acc[a][b][m][n] = v; }
    }
    __device__ __forceinline__ void operator()(const f32x4 (&acc)[2][2][4][2], const Unit& u, int wr, int wc, int fr, int fq, const PG8_LAS float* vl) const {
        (void)vl;
        asm volatile("" : "+v"(fr), "+v"(fq));
        unsigned char* base = O + (size_t)u.pm * BM * DFF;
        const int row0 = wr * 64 + fr, cin = wc * 32 + 8 * fq;
        const float sc = ascale, lim = 7.f / sc, glo = -50.f / sc, s2 = sc * sc, kk = sc * (-1.702f * 1.4426950408889634f);
#pragma unroll
        for (int ai = 0; ai < 2; ++ai)
#pragma unroll
            for (int m = 0; m < 4; ++m) {
                float o[8];
#pragma unroll
                for (int n = 0; n < 2; ++n) { const f32x4 g4 = acc[ai][0][m][n], u4 = acc[ai][1][m][n];
#pragma unroll
                    for (int p = 0; p < 2; ++p) {
                        f32x2 g, up; g.x = __builtin_amdgcn_fmed3f(g4[2 * p], glo, lim); g.y = __builtin_amdgcn_fmed3f(g4[2 * p + 1], glo, lim);
                        up.x = __builtin_amdgcn_fmed3f(u4[2 * p], -lim, lim); up.y = __builtin_amdgcn_fmed3f(u4[2 * p + 1], -lim, lim);
                        const f32x2 t = g * kk;
                        f32x2 e; e.x = __builtin_amdgcn_exp2f(t.x); e.y = __builtin_amdgcn_exp2f(t.y);
                        const f32x2 d = e + 1.f;
                        const float rp = __builtin_amdgcn_rcpf(d.x * d.y);
                        const f32x2 r = (f32x2){d.y, d.x} * rp;
                        const f32x2 a2 = (up * s2 + sc) * g * r;
                        o[4 * n + 2 * p] = a2.x; o[4 * n + 2 * p + 1] = a2.y; } }
                *(u32x2*)(base + (size_t)(row0 + ai * HALF + m * 16) * DFF + u.pn * HALF + cin) = (u32x2){pk4_fp8(o[0], o[1], o[2], o[3]), pk4_fp8(o[4], o[5], o[6], o[7])};
                __builtin_amdgcn_sched_barrier(0);
            }
    }
};

template <class Epi, class Sched, bool GATHER, bool FP8 = false>
__device__ __forceinline__ void gemm_phase(PG8_LAS unsigned char* lds, const int K, const Sched& S, const Epi& E, const int* rowtok) {
    int tid_ = threadIdx.x; asm volatile("" : "+v"(tid_));
    const int tid = tid_, wid = __builtin_amdgcn_readfirstlane(tid >> 6), lane = tid & 63, wr = wid >> 2, wc = wid & 3, fr = lane & 15, fq = lane >> 4;
    const int rowB = FP8 ? K : 2 * K;
    const int nt = rowB / (BK * 2);
    unsigned voffB[2];
#pragma unroll
    for (int i = 0; i < 2; ++i) { int R, C; stage_rc(tid * 16 + i * 8192, R, C); const int Rb = 64 * (R >> 5) + 16 * ((R & 15) >> 2) + 4 * ((R >> 4) & 1) + (R & 3); voffB[i] = (unsigned)(Rb * rowB + C * 2); }
    const size_t kstep = (size_t)(BK * 2);
    const size_t hstep = (size_t)HALF * rowB, hstepB = (size_t)8 * rowB;
    const unsigned ldsw = (unsigned)wid * 1024u;
    const int aoff = lds_byte(wr * 64 + fr, fq * 8), boff = lds_byte(wc * 32 + fr, fq * 8);
#define PG8_SA(b, h) (((b) * 2 + (h)) * HTB)
#define PG8_SB(b, h) ((4 + (b) * 2 + (h)) * HTB)
#define PG8_STAGE2(bufoff, gbase, o0, o1) do { \
        __builtin_amdgcn_global_load_lds((const unsigned*)((const char*)(gbase) + (o0)), (PG8_LAS unsigned*)(lds + (bufoff) + ldsw), 16, 0, 0); \
        __builtin_amdgcn_global_load_lds((const unsigned*)((const char*)(gbase) + (o1)), (PG8_LAS unsigned*)(lds + (bufoff) + ldsw + 8192), 16, 0, 0); } while (0)
#define PG8_STAGE_B(bufoff, gbase) PG8_STAGE2(bufoff, gbase, voffB[0], voffB[1])
#define PG8_CAT8(x0, x1) __builtin_shufflevector(x0, x1, 0, 1, 2, 3, 4, 5, 6, 7)
#define PG8_LDA(dst, b, h) do { _Pragma("unroll") for (int m = 0; m < 4; ++m) { \
        if constexpr (FP8) dst##8[m] = PG8_CAT8(*(const PG8_LAS i32x4*)(lds + PG8_SA(b, h) + aoff + m * 2048), *(const PG8_LAS i32x4*)(lds + PG8_SA(b, h) + aoff + m * 2048 + 1024)); \
        else { _Pragma("unroll") for (int k = 0; k < 2; ++k) dst[m][k] = *(const PG8_LAS bf16x8*)(lds + PG8_SA(b, h) + aoff + m * 2048 + k * 1024); } } } while (0)
#define PG8_LDB(dst, b, h) do { _Pragma("unroll") for (int n = 0; n < 2; ++n) { \
        if constexpr (FP8) dst##8[n] = PG8_CAT8(*(const PG8_LAS i32x4*)(lds + PG8_SB(b, h) + boff + n * 2048), *(const PG8_LAS i32x4*)(lds + PG8_SB(b, h) + boff + n * 2048 + 1024)); \
        else { _Pragma("unroll") for (int k = 0; k < 2; ++k) dst[n][k] = *(const PG8_LAS bf16x8*)(lds + PG8_SB(b, h) + boff + n * 2048 + k * 1024); } } } while (0)
#define PG8_MMA(ai, bj, At, Bt) do { __builtin_amdgcn_s_setprio(1); _Pragma("unroll") for (int m = 0; m < 4; ++m) _Pragma("unroll") for (int n = 0; n < 2; ++n) { \
        if constexpr (FP8) acc[ai][bj][m][n] = __builtin_amdgcn_mfma_scale_f32_16x16x128_f8f6f4(Bt##8[n], At##8[m], acc[ai][bj][m][n], 0, 0, 0, 0x7F7F7F7F, 0, 0x7F7F7F7F); \
        else { _Pragma("unroll") for (int k = 0; k < 2; ++k) acc[ai][bj][m][n] = __builtin_amdgcn_mfma_f32_16x16x32_bf16(Bt[n][k], At[m][k], acc[ai][bj][m][n], 0, 0, 0); } } \
        __builtin_amdgcn_s_setprio(0); } while (0)
#define PG8_WAIT_V(n) asm volatile("s_waitcnt vmcnt(" #n ")" ::: "memory")
#define PG8_WAIT_L(n) asm volatile("s_waitcnt lgkmcnt(" #n ")" ::: "memory")
#define PG8_BAR __builtin_amdgcn_s_barrier()
#define PG8_SCHED __builtin_amdgcn_sched_barrier(0)
#define PG8_SETOFF(v, u) do { _Pragma("unroll") for (int h_ = 0; h_ < 2; ++h_) _Pragma("unroll") for (int i_ = 0; i_ < 2; ++i_) { int R_, C_; stage_rc(tid * 16 + i_ * 8192, R_, C_); \
        if constexpr (GATHER) { const unsigned tok_ = (unsigned)rowtok[(u).pm * BM + h_ * HALF + R_]; v[h_][i_] = tok_ * (unsigned)rowB + (unsigned)(C_ * 2); } \
        else v[h_][i_] = (unsigned)(R_ * rowB + C_ * 2) + (unsigned)(h_ * hstep); } } while (0)
    Unit cur, nxt; int ui = 0;
    if (!S.next(0, cur)) return;
    f32x4 acc[2][2][4][2];
#pragma unroll
    for (int a = 0; a < 2; ++a)
#pragma unroll
        for (int b = 0; b < 2; ++b)
#pragma unroll
            for (int m = 0; m < 4; ++m)
#pragma unroll
                for (int n = 0; n < 2; ++n) acc[a][b][m][n] = (f32x4){0.f, 0.f, 0.f, 0.f};
    bf16x8 At[4][2], B0[2][2], B1[2][2];
    i32x8 At8[4], B08[2], B18[2];
    unsigned vA[2][2];
    PG8_SETOFF(vA, cur);
    PG8_LAS float* vecbuf = (PG8_LAS float*)(lds + STAGE_BYTES + 4096 + 2048);
    PG8_LAS int* tokbuf = (PG8_LAS int*)(lds + STAGE_BYTES + 4096);
    const char* cA = cur.a; const char* cB = cur.b;
    if constexpr (Epi::ACC_BIAS) { if (wid == 0) __builtin_amdgcn_global_load_lds((const unsigned*)(E.vec_ptr(cur) + lane * 4), (PG8_LAS unsigned*)vecbuf, 16, 0, 0); }
    PG8_STAGE_B(PG8_SB(0, 0), cB); PG8_STAGE_B(PG8_SB(0, 1), cB + hstepB); PG8_STAGE2(PG8_SA(0, 0), cA, vA[0][0], vA[0][1]); PG8_STAGE2(PG8_SA(0, 1), cA, vA[1][0], vA[1][1]);
    if (wr == 1) PG8_BAR;
    PG8_WAIT_V(2); PG8_BAR;
    PG8_STAGE_B(PG8_SB(1, 0), cB + kstep); PG8_STAGE2(PG8_SA(1, 0), cA + kstep, vA[0][0], vA[0][1]); PG8_STAGE_B(PG8_SB(1, 1), cB + hstepB + kstep);
    PG8_WAIT_V(6); PG8_BAR;
    if constexpr (Epi::ACC_BIAS) E.acc_init(acc, vecbuf, wc, fq);
    for (;;) {
        const bool has_next = S.next(ui + 1, nxt);
        if constexpr (GATHER) { if (has_next && wid == 0) {
#pragma unroll
                for (int j_ = 0; j_ < 4; ++j_) __builtin_amdgcn_global_load_lds((const unsigned*)(rowtok + nxt.pm * BM + j_ * 64 + lane), (PG8_LAS unsigned*)(tokbuf + ((ui + 1) & 1) * 256 + j_ * 64), 4, 0, 0); } }
        if constexpr (Epi::HAS_VEC) { if (wid == 0) __builtin_amdgcn_global_load_lds((const unsigned*)(E.vec_ptr(cur) + lane * 4), (PG8_LAS unsigned*)(vecbuf + (ui & 1) * 256), 16, 0, 0); }
        if constexpr (Epi::ACC_BIAS) { if (has_next && wid == 0) __builtin_amdgcn_global_load_lds((const unsigned*)(E.vec_ptr(nxt) + lane * 4), (PG8_LAS unsigned*)(vecbuf + ((ui + 1) & 1) * 256), 16, 0, 0); }
        const char* nA = has_next ? nxt.a : cA; const char* nB = has_next ? nxt.b : cB;
        if constexpr (!GATHER) asm volatile("" : "+v"(vA[0][0]), "+v"(vA[0][1]), "+v"(vA[1][0]), "+v"(vA[1][1]));
#pragma unroll 1
        for (int t = 0; t < nt; t += 2) {
            const bool last = (t == nt - 2);
            const char* a1 = cA + (size_t)(t + 1) * kstep;
            const char* a2 = last ? nA : cA + (size_t)(t + 2) * kstep; const char* b2 = last ? nB : cB + (size_t)(t + 2) * kstep;
            const char* a3 = a2 + kstep; const char* b3 = b2 + kstep;
            PG8_LDB(B0, 0, 0); PG8_LDB(B1, 0, 1); PG8_SCHED; PG8_LDA(At, 0, 0); PG8_STAGE2(PG8_SA(1, 1), a1, vA[1][0], vA[1][1]);
            if constexpr (GATHER) { if (last && has_next) {
#pragma unroll
                for (int h_ = 0; h_ < 2; ++h_)
#pragma unroll
                    for (int i_ = 0; i_ < 2; ++i_) { int R_, C_; stage_rc(tid * 16 + i_ * 8192, R_, C_); vA[h_][i_] = (unsigned)tokbuf[((ui + 1) & 1) * 256 + h_ * HALF + R_] * (unsigned)rowB + (unsigned)(C_ * 2); } } }
            PG8_WAIT_V(8); PG8_WAIT_L(0); PG8_BAR; PG8_MMA(0, 0, At, B0); PG8_MMA(0, 1, At, B1); PG8_BAR; PG8_SCHED;
            PG8_LDA(At, 0, 1); PG8_STAGE_B(PG8_SB(0, 0), b2); PG8_STAGE_B(PG8_SB(0, 1), b2 + hstepB); PG8_STAGE2(PG8_SA(0, 0), a2, vA[0][0], vA[0][1]);
            PG8_WAIT_V(8); PG8_WAIT_L(0); PG8_BAR; PG8_MMA(1, 0, At, B0); PG8_MMA(1, 1, At, B1); PG8_BAR; PG8_SCHED;
            PG8_LDB(B0, 1, 0); PG8_LDB(B1, 1, 1); PG8_SCHED; PG8_LDA(At, 1, 0); PG8_STAGE2(PG8_SA(0, 1), a2, vA[1][0], vA[1][1]);
            PG8_WAIT_V(8); PG8_WAIT_L(0); PG8_BAR; PG8_MMA(0, 0, At, B0); PG8_MMA(0, 1, At, B1); PG8_BAR; PG8_SCHED;
            PG8_LDA(At, 1, 1); PG8_STAGE_B(PG8_SB(1, 0), b3); PG8_STAGE_B(PG8_SB(1, 1), b3 + hstepB); PG8_STAGE2(PG8_SA(1, 0), a3, vA[0][0], vA[0][1]);
            PG8_WAIT_V(8); PG8_WAIT_L(0); PG8_BAR; PG8_MMA(1, 0, At, B0); PG8_MMA(1, 1, At, B1); PG8_BAR; PG8_SCHED;
        }
        if (wr == 0) PG8_BAR;
        E(acc, cur, wr, wc, fr, fq, vecbuf + (ui & 1) * 256);
        if (!has_next) break;
        if constexpr (Epi::ACC_BIAS) E.acc_init(acc, vecbuf + ((ui + 1) & 1) * 256, wc, fq);
        else {
#pragma unroll
        for (int a = 0; a < 2; ++a)
#pragma unroll
            for (int b = 0; b < 2; ++b)
#pragma unroll
                for (int m = 0; m < 4; ++m)
#pragma unroll
                    for (int n = 0; n < 2; ++n) acc[a][b][m][n] = (f32x4){0.f, 0.f, 0.f, 0.f};
        }
        cur = nxt; cA = nA; cB = nB; ++ui;
        if (wr == 1) PG8_BAR;
    }
    PG8_WAIT_V(0);
    PG8_BAR;
#undef PG8_SA
#undef PG8_SB
#undef PG8_STAGE2
#undef PG8_STAGE_B
#undef PG8_LDA
#undef PG8_LDB
#undef PG8_MMA
#undef PG8_CAT8
#undef PG8_WAIT_V
#undef PG8_WAIT_L
#undef PG8_BAR
#undef PG8_SCHED
#undef PG8_SETOFF
}
}

#include <hip/hip_bf16.h>
namespace attn_body {
using bf16=__hip_bfloat16;
using bf16x8=__attribute__((ext_vector_type(8)))short;
using s16x4=__attribute__((ext_vector_type(4)))short;
using f32x16=__attribute__((ext_vector_type(16)))float;
using u32x4=__attribute__((ext_vector_type(4)))unsigned;
constexpr int SEQ=4096,D=64,PQ=3072,PO=1024;
constexpr int NW=8,QBLK=32,QB=QBLK*NW,KVBLK=64,NQB=SEQ/QB;
constexpr int ATTN_UNIT_ROWS=QB;
__device__ __forceinline__ int crow(int r,int hi){return (r&3)+8*(r>>2)+4*hi;}
#define SBAR() __builtin_amdgcn_sched_barrier(0)
__device__ __forceinline__ void cmask(f32x16&p0,f32x16&p1,int jb,int qrel,int hi){
  (void)hi; if(jb>(qrel>>6)){ const float NEG=-INFINITY;
    #pragma unroll
    for(int r=0;r<16;++r){p0[r]=NEG;p1[r]=NEG;} }
}

constexpr int NSLOT=3, SLOTB=8192, VSLOTB=2*SLOTB;
constexpr int LDS_K=0, LDS_V=NSLOT*SLOTB, LDS_WS=LDS_V+NSLOT*VSLOTB, LDS_OST=LDS_WS+NW*64*4, LDS_BYTES=LDS_OST+NW*4096;
constexpr float C2=0.125f*1.4426950408889634f;
__device__ __forceinline__ void glds16(const void*gsrc,unsigned lds_dst){unsigned keep;
  asm volatile("s_mov_b32 %0, m0\n\ts_mov_b32 m0, %2\n\ts_nop 0\n\tglobal_load_lds_dwordx4 %1, off\n\ts_mov_b32 m0, %0":"=&s"(keep):"v"(gsrc),"s"(lds_dst):"memory");}
__device__ __forceinline__ float max3f(float a,float b,float c){float r;asm("v_max3_f32 %0, %1, %2, %3":"=v"(r):"v"(a),"v"(b),"v"(c));return r;}
__device__ __forceinline__ float max2f(float a,float b){float r;asm("v_max_f32_e32 %0, %1, %2":"=v"(r):"v"(a),"v"(b));return r;}
__device__ __forceinline__ float fadd_s(float a,float b){float r;asm("v_add_f32_e32 %0, %1, %2":"=v"(r):"v"(a),"v"(b));return r;}
__device__ __forceinline__ float fsub_s(float a,float b){float r;asm("v_sub_f32_e32 %0, %1, %2":"=v"(r):"v"(a),"v"(b));return r;}
typedef float f32x2_t __attribute__((ext_vector_type(2))); typedef __bf16 bf16x2_t __attribute__((ext_vector_type(2)));
typedef int i32x4 __attribute__((ext_vector_type(4)));
typedef int i32x8 __attribute__((ext_vector_type(8)));
__device__ __forceinline__ unsigned cvtpk_s(float lo,float hi){f32x2_t v={lo,hi};bf16x2_t b=__builtin_convertvector(v,bf16x2_t);return __builtin_bit_cast(unsigned,b);}
#define WAIT_BAR(N) asm volatile("s_waitcnt vmcnt(" #N ") lgkmcnt(0)\n\ts_barrier":::"memory")

__device__ __forceinline__ void qkt(f32x16&p0,f32x16&p1,const char*Kslot,const bf16x8*qr,const f32x16&negm,int r32,int hi){
  const char*kb=Kslot+hi*1024+r32*16;
  #pragma unroll
  for(int d0=0;d0<4;++d0){
    const bf16x8 b0=*reinterpret_cast<const bf16x8*>(kb+d0*2048);
    const bf16x8 b1=*reinterpret_cast<const bf16x8*>(kb+d0*2048+512);
    if(d0==0){p0=__builtin_amdgcn_mfma_f32_32x32x16_bf16(b0,qr[0],negm,0,0,0);p1=__builtin_amdgcn_mfma_f32_32x32x16_bf16(b1,qr[0],negm,0,0,0);}
    else{p0=__builtin_amdgcn_mfma_f32_32x32x16_bf16(b0,qr[d0],p0,0,0,0);p1=__builtin_amdgcn_mfma_f32_32x32x16_bf16(b1,qr[d0],p1,0,0,0);}}
}
typedef __attribute__((address_space(3))) const char* lds_cptr;
typedef short v4i16_t __attribute__((ext_vector_type(4)));
__device__ __forceinline__ void kload8(bf16x8*kf,lds_cptr kp){
  kf[0]=*(const __attribute__((address_space(3))) bf16x8*)(kp);      kf[1]=*(const __attribute__((address_space(3))) bf16x8*)(kp+512);
  kf[2]=*(const __attribute__((address_space(3))) bf16x8*)(kp+2048); kf[3]=*(const __attribute__((address_space(3))) bf16x8*)(kp+2560);
  kf[4]=*(const __attribute__((address_space(3))) bf16x8*)(kp+4096); kf[5]=*(const __attribute__((address_space(3))) bf16x8*)(kp+4608);
  kf[6]=*(const __attribute__((address_space(3))) bf16x8*)(kp+6144); kf[7]=*(const __attribute__((address_space(3))) bf16x8*)(kp+6656);
}
__device__ __forceinline__ void kload2(bf16x8*kf,lds_cptr kp,int j){ kf[2*j]=*(const __attribute__((address_space(3))) bf16x8*)(kp+j*2048); kf[2*j+1]=*(const __attribute__((address_space(3))) bf16x8*)(kp+j*2048+512); }
__device__ __forceinline__ s16x4 vtr(lds_cptr p){ return __builtin_bit_cast(s16x4,__builtin_amdgcn_ds_read_tr16_b64_v4i16((__attribute__((address_space(3))) v4i16_t*)p)); }
__device__ __forceinline__ float rowmax(const f32x16&p0,const f32x16&p1){
  float a=max3f(p0[0],p0[1],p1[0]),b=max3f(p0[2],p0[3],p1[1]);a=max3f(a,p1[2],p1[3]);
  #pragma unroll
  for(int r=4;r<16;r+=4){a=max3f(a,p0[r],p0[r+1]);b=max3f(b,p0[r+2],p0[r+3]);a=max3f(a,p1[r],p1[r+1]);b=max3f(b,p1[r+2],p1[r+3]);}
  const float m=max2f(a,b);
  auto rr=__builtin_amdgcn_permlane32_swap(__float_as_uint(m),__float_as_uint(m),false,false);
  return max2f(__uint_as_float(rr[0]),__uint_as_float(rr[1]));
}
__device__ __forceinline__ void pv(f32x16*o,int vb,bf16x8 pa0,bf16x8 pa1,bf16x8 pa2,bf16x8 pa3){
  #pragma unroll
  for(int d0=0;d0<4;++d0){s16x4 lo[4],hi[4];
    #pragma unroll
    for(int ks=0;ks<4;++ks){
      asm volatile("ds_read_b64_tr_b16 %0,%1 offset:%c2":"=&v"(lo[ks]):"v"(vb),"i"(d0*4096+ks*1024):"memory");
      asm volatile("ds_read_b64_tr_b16 %0,%1 offset:%c2":"=&v"(hi[ks]):"v"(vb),"i"(d0*4096+ks*1024+512):"memory");}
    asm volatile("s_waitcnt lgkmcnt(0)":::"memory");SBAR();
    #define PK(k) (bf16x8){lo[k][0],lo[k][1],lo[k][2],lo[k][3],hi[k][0],hi[k][1],hi[k][2],hi[k][3]}
    o[d0]=__builtin_amdgcn_mfma_f32_32x32x16_bf16(pa0,PK(0),o[d0],0,0,0);
    o[d0]=__builtin_amdgcn_mfma_f32_32x32x16_bf16(pa1,PK(1),o[d0],0,0,0);
    o[d0]=__builtin_amdgcn_mfma_f32_32x32x16_bf16(pa2,PK(2),o[d0],0,0,0);
    o[d0]=__builtin_amdgcn_mfma_f32_32x32x16_bf16(pa3,PK(3),o[d0],0,0,0);
    #undef PK
  }
}

#ifndef ATTN_STORE16
#define ATTN_STORE16(p,v) (*(u32x4*)(p)=(v))
#endif
template<int THRL> __device__ __forceinline__ void attn_unit(long rowbase,int qb,const bf16*Qh,const bf16*__restrict__ Kh_,const bf16*__restrict__ Vh_,bf16*Oh,char*shm,int fuse,bf16*Ch,const float*gh,float lam){
  int tid_=threadIdx.x; asm volatile("":"+v"(tid_));
  const int tid=tid_,lane=tid&63,r32=lane&31,hi=lane>>5; const int wid=__builtin_amdgcn_readfirstlane(tid>>6);
  const int q0=qb*QB;
  const bf16*Qw=Qh+(rowbase+q0+wid*QBLK)*PQ;
  const bf16*Kh=Kh_+rowbase*PQ,*Vh=Vh_+rowbase*PQ;
  const unsigned lds0=(unsigned)(uintptr_t)shm;
  float*wsf=(float*)(shm+LDS_WS)+wid*64;
  const bf16*ksrc=Kh+(long)lane*PQ+wid*8;
  const bf16*vsrc=Vh+(long)(16*(wid&3)+(lane>>2))*PQ+(wid>>2)*32+(lane&3)*8;
  const unsigned kdst=lds0+LDS_K+wid*1024, vdst=lds0+LDS_V+wid*1024;
  #define DMA_K(t,slot) glds16(ksrc+(long)(t)*KVBLK*PQ,(unsigned)__builtin_amdgcn_readfirstlane(kdst+(slot)))
  #define DMA_V(t,slot) do{ glds16(vsrc+(long)(t)*KVBLK*PQ,(unsigned)__builtin_amdgcn_readfirstlane(vdst+2*(slot))); glds16(vsrc+(long)(t)*KVBLK*PQ+64,(unsigned)__builtin_amdgcn_readfirstlane(vdst+2*(slot)+8192)); }while(0)
  const int vb0=(int)(lds0+LDS_V)+((lane>>4)&1)*32+(lane&3)*8+(4*hi+((lane&15)>>2))*64;
  const char*Kbase=shm+LDS_K; bf16x8 kf[8];
  const lds_cptr shm3=(lds_cptr)shm; const lds_cptr kp0=shm3+LDS_K+hi*1024+r32*16; const lds_cptr vp0=shm3+LDS_V+((lane>>4)&1)*32+(lane&3)*8+(4*hi+((lane&15)>>2))*64;
  const int NT=(q0+QB)/KVBLK;
  DMA_K(0,0);DMA_V(0,0);DMA_K(1,SLOTB);
  bf16x8 qr[4];
  #pragma unroll
  for(int d0=0;d0<4;++d0)qr[d0]=*reinterpret_cast<const bf16x8*>(&Qw[(long)r32*PQ+d0*16+hi*8]);
  float z0_=0.f; asm volatile("":"+v"(z0_));
  f32x16 zv_; _Pragma("unroll") for(int r=0;r<16;++r)zv_[r]=z0_;
  float mhat=0.f,l_reg=0.f;f32x16 o[4];o[0]=zv_;o[1]=zv_;o[2]=zv_;o[3]=zv_;f32x16 negm=zv_;asm volatile("":"+v"(negm));
  const int qrel=wid*QBLK+r32;
  #define CMASK(P0,P1,t) do{int jb_=(t)-(NT-4); if(jb_>=0)cmask(P0,P1,jb_,qrel,hi);}while(0)
  bool resc=false;
  #define START(P0,P1) do{ const float rm=rowmax(P0,P1); resc=false; \
    { const float dl=rm; mhat=fadd_s(mhat,dl); \
      _Pragma("unroll") for(int r=0;r<16;++r){P0[r]=fsub_s(P0[r],dl);P1[r]=fsub_s(P1[r],dl);} \
      _Pragma("unroll") for(int r=0;r<16;++r)negm[r]=-mhat; asm volatile("":"+v"(negm)); } \
    _Pragma("unroll") for(int r=0;r<16;++r)P0[r]=__builtin_amdgcn_exp2f(P0[r]); }while(0)
  #define RESC() do{ if(resc){ asm volatile("s_waitcnt lgkmcnt(0)":::"memory"); \
      _Pragma("unroll") for(int d_=0;d_<4;++d_) _Pragma("unroll") for(int r=0;r<16;++r)o[d_][r]*=wsf[crow(r,hi)]; } }while(0)
  f32x16 pA0,pA1,pB0,pB1;
  int sl_prev=0,sl_cur=0,sl_next=SLOTB;
  #define ROT() do{sl_prev=sl_cur;sl_cur=sl_next;sl_next=(sl_next==(NSLOT-1)*SLOTB)?0:sl_next+SLOTB;}while(0)
  DMA_K(2,2*SLOTB);
  WAIT_BAR(4);
  qkt(pA0,pA1,Kbase,qr,negm,r32,hi);asm volatile("s_nop 15\n\ts_nop 7":"+v"(pA0),"+v"(pA1));CMASK(pA0,pA1,0);
  START(pA0,pA1);
  _Pragma("unroll") for(int r=0;r<16;++r)pA1[r]=__builtin_amdgcn_exp2f(pA1[r]);
  WAIT_BAR(0);
  DMA_K(3,0);DMA_V(1,SLOTB);
  ROT();
  kload8(kf,kp0+sl_cur);
  WAIT_BAR(3);
  s16x4 vlo[8],vhi[8]; u32x4 pw0,pw1,pw2,pw3;
  #define PKW(P,B) cvtpk_s(P[B],P[B+1])
  #define PAF(k) __builtin_bit_cast(bf16x8,pw##k)
  #define VFR(i) (bf16x8){vlo[i][0],vlo[i][1],vlo[i][2],vlo[i][3],vhi[i][0],vhi[i][1],vhi[i][2],vhi[i][3]}
  #define PIN(x) asm volatile("":"+v"(x))
  #define MX3(a,b,c) __builtin_fmaxf(__builtin_fmaxf((a),(b)),(c))
  #define GAPA(MF,A0,A1,A2,A3,W0,W1,PW) do{ MF; sacc+=A0; sacc+=A1; sacc+=A2; sacc+=A3; PIN(sacc); W0; W1; PIN(PW); SBAR(); }while(0)
  #define EX(v) __builtin_amdgcn_exp2f(v)
  #define GAPB2(MF,X,B) do{ MF; X[B]=EX(X[B]); X[B+1]=EX(X[B+1]); PIN(X); SBAR(); }while(0)
  #define VRD2(i) do{ vlo[i]=vtr(vp_+(8192+((i)>>2)*4096+((i)&3)*1024)); vhi[i]=vtr(vp_+(8192+((i)>>2)*4096+((i)&3)*1024+512)); SBAR(); }while(0)
  #define VRD(i) do{ vlo[i]=vtr(vp_+(((i)>>2)*4096+((i)&3)*1024)); vhi[i]=vtr(vp_+(((i)>>2)*4096+((i)&3)*1024+512)); }while(0)
  #define KRD(G,j) do{ if(G){ kload2(kf,kp0+sl_next,j); SBAR(); } }while(0)
  #define STEP(C0,C1,P0,P1,t,GK,GV,GL) do{ SBAR(); \
    const lds_cptr vp_=vp0+2*sl_prev; \
    VRD(0); SBAR(); float sacc=(P0[0]+P0[1]); \
    GAPA(C0=__builtin_amdgcn_mfma_f32_32x32x16_bf16(kf[0],qr[0],negm,0,0,0), P0[2],P0[3],P0[4],P0[5],     pw0[0]=PKW(P0,0), pw0[1]=PKW(P0,2), pw0); \
    VRD(4); SBAR(); GAPA(C1=__builtin_amdgcn_mfma_f32_32x32x16_bf16(kf[1],qr[0],negm,0,0,0), P0[6],P0[7],P0[8],P0[9],     pw0[2]=PKW(P0,4), pw0[3]=PKW(P0,6), pw0); \
    VRD(1); SBAR(); GAPA(C0=__builtin_amdgcn_mfma_f32_32x32x16_bf16(kf[2],qr[1],C0,0,0,0),   P0[10],P0[11],P0[12],P0[13], pw1[0]=PKW(P0,8), pw1[1]=PKW(P0,10), pw1); \
    VRD(5); SBAR(); GAPA(C1=__builtin_amdgcn_mfma_f32_32x32x16_bf16(kf[3],qr[1],C1,0,0,0),   P0[14],P0[15],P1[0],P1[1],   pw1[2]=PKW(P0,12),pw1[3]=PKW(P0,14), pw1); \
    VRD(2); SBAR(); GAPA(C0=__builtin_amdgcn_mfma_f32_32x32x16_bf16(kf[4],qr[2],C0,0,0,0),   P1[2],P1[3],P1[4],P1[5],     pw2[0]=PKW(P1,0), pw2[1]=PKW(P1,2), pw2); \
    VRD(6); SBAR(); GAPA(C1=__builtin_amdgcn_mfma_f32_32x32x16_bf16(kf[5],qr[2],C1,0,0,0),   P1[6],P1[7],P1[8],P1[9],     pw2[2]=PKW(P1,4), pw2[3]=PKW(P1,6), pw2); \
    VRD(3); SBAR(); GAPA(C0=__builtin_amdgcn_mfma_f32_32x32x16_bf16(kf[6],qr[3],C0,0,0,0),   P1[10],P1[11],P1[12],P1[13], pw3[0]=PKW(P1,8), pw3[1]=PKW(P1,10), pw3); \
    VRD(7); SBAR(); GAPA(C1=__builtin_amdgcn_mfma_f32_32x32x16_bf16(kf[7],qr[3],C1,0,0,0),   P1[14],P1[15],0.f,0.f,       pw3[2]=PKW(P1,12),pw3[3]=PKW(P1,14), pw3); \
    l_reg+=sacc; \
    if(GK){DMA_K((t)+3,sl_cur);} if(GV){DMA_V((t)+1,sl_next);} \
    CMASK(C0,C1,t); \
    { float a=MX3(C0[0],C0[1],C1[0]),b=MX3(C0[2],C0[3],C1[1]); a=MX3(a,C1[2],C1[3]); \
      _Pragma("unroll") for(int r=4;r<16;r+=4){a=MX3(a,C0[r],C0[r+1]);b=MX3(b,C0[r+2],C0[r+3]);a=MX3(a,C1[r],C1[r+1]);b=MX3(b,C1[r+2],C1[r+3]);} \
      float rm=__builtin_fmaxf(a,b); { auto rr=__builtin_amdgcn_permlane32_swap(__float_as_uint(rm),__float_as_uint(rm),false,false); rm=__builtin_fmaxf(__uint_as_float(rr[0]),__uint_as_float(rr[1])); } \
      resc=false; \
      if(__builtin_expect(__any(rm>(float)THRL),0)){ const float dl=__builtin_fmaxf(rm,0.f); mhat+=dl; \
        _Pragma("unroll") for(int r=0;r<16;++r){C0[r]-=dl;C1[r]-=dl;} \
        _Pragma("unroll") for(int r=0;r<16;++r)negm[r]=-mhat; asm volatile("":"+v"(negm)); \
        const float f=__builtin_amdgcn_exp2f(-dl); l_reg*=f; if(hi==0)wsf[r32]=f; resc=true; } } \
    SBAR(); \
    GAPB2(o[0]=__builtin_amdgcn_mfma_f32_32x32x16_bf16(PAF(0),VFR(0),o[0],0,0,0), C0,0);  VRD2(0); \
    GAPB2(o[1]=__builtin_amdgcn_mfma_f32_32x32x16_bf16(PAF(0),VFR(4),o[1],0,0,0), C0,2);  VRD2(4); \
    GAPB2(o[0]=__builtin_amdgcn_mfma_f32_32x32x16_bf16(PAF(1),VFR(1),o[0],0,0,0), C0,4);  VRD2(1); \
    GAPB2(o[1]=__builtin_amdgcn_mfma_f32_32x32x16_bf16(PAF(1),VFR(5),o[1],0,0,0), C0,6);  VRD2(5); \
    GAPB2(o[0]=__builtin_amdgcn_mfma_f32_32x32x16_bf16(PAF(2),VFR(2),o[0],0,0,0), C0,8);  VRD2(2); \
    GAPB2(o[1]=__builtin_amdgcn_mfma_f32_32x32x16_bf16(PAF(2),VFR(6),o[1],0,0,0), C0,10); VRD2(6); \
    GAPB2(o[0]=__builtin_amdgcn_mfma_f32_32x32x16_bf16(PAF(3),VFR(3),o[0],0,0,0), C0,12); VRD2(3); \
    GAPB2(o[1]=__builtin_amdgcn_mfma_f32_32x32x16_bf16(PAF(3),VFR(7),o[1],0,0,0), C0,14); VRD2(7); \
    GAPB2(o[2]=__builtin_amdgcn_mfma_f32_32x32x16_bf16(PAF(0),VFR(0),o[2],0,0,0), C1,0); \
    GAPB2(o[3]=__builtin_amdgcn_mfma_f32_32x32x16_bf16(PAF(0),VFR(4),o[3],0,0,0), C1,2); \
    KRD(GL,0); GAPB2(o[2]=__builtin_amdgcn_mfma_f32_32x32x16_bf16(PAF(1),VFR(1),o[2],0,0,0), C1,4); \
    KRD(GL,1); GAPB2(o[3]=__builtin_amdgcn_mfma_f32_32x32x16_bf16(PAF(1),VFR(5),o[3],0,0,0), C1,6); \
    KRD(GL,2); GAPB2(o[2]=__builtin_amdgcn_mfma_f32_32x32x16_bf16(PAF(2),VFR(2),o[2],0,0,0), C1,8); \
    KRD(GL,3); GAPB2(o[3]=__builtin_amdgcn_mfma_f32_32x32x16_bf16(PAF(2),VFR(6),o[3],0,0,0), C1,10); \
    GAPB2(o[2]=__builtin_amdgcn_mfma_f32_32x32x16_bf16(PAF(3),VFR(3),o[2],0,0,0), C1,12); \
    GAPB2(o[3]=__builtin_amdgcn_mfma_f32_32x32x16_bf16(PAF(3),VFR(7),o[3],0,0,0), C1,14); \
    }while(0)
  int t=1;
  #undef CMASK
  #define CMASK(P0,P1,t) do{}while(0)
  for(;t+5<NT;t+=2){
    STEP(pB0,pB1,pA0,pA1,t,true,true,true);     WAIT_BAR(3); RESC(); ROT();
    STEP(pA0,pA1,pB0,pB1,t+1,true,true,true);   WAIT_BAR(3); RESC(); ROT();
  }
  #undef CMASK
  #define CMASK(P0,P1,t) do{int jb_=(t)-(NT-4); if(jb_>=0)cmask(P0,P1,jb_,qrel,hi);}while(0)
  #define ENDW(tt) do{ if((tt)+3<NT){WAIT_BAR(3);} else if((tt)+2<NT){WAIT_BAR(2);} else {WAIT_BAR(0);} }while(0)
  for(;t+1<NT;t+=2){
    STEP(pB0,pB1,pA0,pA1,t,(t+3<NT),(t+1<NT),(t+1<NT));       ENDW(t);   RESC(); ROT();
    STEP(pA0,pA1,pB0,pB1,t+1,(t+4<NT),(t+2<NT),(t+2<NT));     ENDW(t+1); RESC(); ROT();
  }
  STEP(pB0,pB1,pA0,pA1,NT-1,false,false,false); RESC();
  { float sacc=pB0[0]+pB0[1]; _Pragma("unroll") for(int r=2;r<16;++r)sacc+=pB0[r]; _Pragma("unroll") for(int r=0;r<16;++r)sacc+=pB1[r]; l_reg+=sacc;
    pw0=(u32x4){PKW(pB0,0),PKW(pB0,2),PKW(pB0,4),PKW(pB0,6)};pw1=(u32x4){PKW(pB0,8),PKW(pB0,10),PKW(pB0,12),PKW(pB0,14)};pw2=(u32x4){PKW(pB1,0),PKW(pB1,2),PKW(pB1,4),PKW(pB1,6)};pw3=(u32x4){PKW(pB1,8),PKW(pB1,10),PKW(pB1,12),PKW(pB1,14)};
    SBAR(); pv(o,vb0+2*sl_cur,PAF(0),PAF(1),PAF(2),PAF(3)); }
  #undef PKW
  #undef PAF
  #undef VFR
  #undef PIN
  #undef MX3
  #undef GAPA
  #undef GAPB2
  #undef VRD2
  #undef EX
  #undef VRD
  #undef KRD
  #undef STEP
  #undef ENDW
  {auto rr=__builtin_amdgcn_permlane32_swap(__float_as_uint(l_reg),__float_as_uint(l_reg),false,false);l_reg=__uint_as_float(rr[0])+__uint_as_float(rr[1]);}
  if(hi==0)wsf[32+r32]=l_reg;asm volatile("s_waitcnt lgkmcnt(0)":::"memory");
  float rli[16];
  #pragma unroll
  for(int r=0;r<16;++r)rli[r]=__builtin_amdgcn_rcpf(wsf[32+crow(r,hi)]);
  bf16*Ow=Oh+(rowbase+q0+wid*QBLK)*PO;
  { bf16*stg=(bf16*)(shm+LDS_OST)+wid*2048;
    if(!fuse){
    #pragma unroll
    for(int hf=0;hf<2;++hf){
      #pragma unroll
      for(int r=0;r<16;++r){const int orow=crow(r,hi);
        #pragma unroll
        for(int d0=0;d0<2;++d0)stg[orow*64+d0*32+r32]=__float2bfloat16(o[2*hf+d0][r]*rli[r]);}
      asm volatile("s_waitcnt lgkmcnt(0)":::"memory");
      #pragma unroll
      for(int i=0;i<4;++i){const int row=i*8+(lane>>3),ch=lane&7; const u32x4 v=*(const u32x4*)(stg+row*64+ch*8); ATTN_STORE16(Ow+(long)row*PO+hf*64+ch*8,v);}
      asm volatile("s_waitcnt lgkmcnt(0)":::"memory");
    } }
    else{
      bf16*Cw=Ch+(rowbase+q0+wid*QBLK)*PO;
      u32x4 dp[2][4]; float ss[4]={0.f,0.f,0.f,0.f};
      #pragma unroll
      for(int hf=0;hf<2;++hf){
        u32x4 v0[4];
        #pragma unroll
        for(int i=0;i<4;++i){const int row=i*8+(lane>>3),ch=lane&7; v0[i]=*(const u32x4*)(Ow+(long)row*PO+hf*64+ch*8);}
        #pragma unroll
        for(int r=0;r<16;++r){const int orow=crow(r,hi);
          #pragma unroll
          for(int d0=0;d0<2;++d0)stg[orow*64+d0*32+r32]=__float2bfloat16(o[2*hf+d0][r]*rli[r]);}
        asm volatile("s_waitcnt lgkmcnt(0)":::"memory");
        #pragma unroll
        for(int i=0;i<4;++i){const int row=i*8+(lane>>3),ch=lane&7; const u32x4 v1=*(const u32x4*)(stg+row*64+ch*8);
          float d[8];
          #pragma unroll
          for(int j=0;j<4;++j){d[2*j]=bf2f(v0[i][j]&0xffffu)-lam*bf2f(v1[j]&0xffffu);d[2*j+1]=bf2f(v0[i][j]>>16)-lam*bf2f(v1[j]>>16);}
          #pragma unroll
          for(int j=0;j<8;++j)ss[i]+=d[j]*d[j];
          dp[hf][i]=(u32x4){pk2(d[0],d[1]),pk2(d[2],d[3]),pk2(d[4],d[5]),pk2(d[6],d[7])};}
        asm volatile("s_waitcnt lgkmcnt(0)":::"memory");
      }
      float rsn[4];
      #pragma unroll
      for(int i=0;i<4;++i){float sv=ss[i];sv+=__shfl_xor(sv,1);sv+=__shfl_xor(sv,2);sv+=__shfl_xor(sv,4);rsn[i]=0.8f*rsq_(sv*(1.f/128.f)+EPS);}
      #pragma unroll
      for(int hf=0;hf<2;++hf){const int ch=lane&7; const f32x4 g0=*(const f32x4*)(gh+hf*64+ch*8),g1=*(const f32x4*)(gh+hf*64+ch*8+4);
        #pragma unroll
        for(int i=0;i<4;++i){const int row=i*8+(lane>>3); const u32x4 q=dp[hf][i]; const float rs=rsn[i];
          const u32x4 w={pk2(bf2f(q[0]&0xffffu)*rs*g0.x,bf2f(q[0]>>16)*rs*g0.y),pk2(bf2f(q[1]&0xffffu)*rs*g0.z,bf2f(q[1]>>16)*rs*g0.w),pk2(bf2f(q[2]&0xffffu)*rs*g1.x,bf2f(q[2]>>16)*rs*g1.y),pk2(bf2f(q[3]&0xffffu)*rs*g1.z,bf2f(q[3]>>16)*rs*g1.w)};
          ATTN_STORE16(Cw+(long)row*PO+hf*64+ch*8,w);} }
    } }
  asm volatile("s_waitcnt lgkmcnt(0)\n\ts_barrier":::"memory");
  #undef DMA_K
  #undef DMA_V
  #undef CMASK
  #undef START
  #undef RESC
  #undef ROT
}
constexpr int ATTN_LDS_BYTES=LDS_BYTES;
template<int THRL=8> __device__ __forceinline__ void attn_pair(char*lds,const bf16*P,bf16*O,bf16*cat,const float*dng,float lam,int item){
  const int qd=item&3, h=(item>>2)&3, b=item>>4;
  const bf16*Vh=P+2560+h*128; bf16*Oh=O+(h*2)*128; bf16*Ch=cat+512+h*128; const float*gh=dng+h*128;
  for(int i=0;i<8;++i){ long rowbase=(long)b*SEQ; asm volatile("":"+s"(rowbase));
    const int map=i&1, k=i>>1, qb=(k==0)?15-qd:(k==1)?8+qd:(k==2)?7-qd:qd;
    const bf16*Qh=P+1536+(h*2+map)*64, *Kh=P+2048+(h*2+map)*64;
    attn_unit<THRL>(rowbase,qb,Qh,Kh,Vh,Oh,lds,map,Ch,gh,lam); }
}
#undef SBAR
#undef WAIT_BAR
}

#ifndef MK_N_LAUNCHES
#define MK_N_LAUNCHES 1
#endif
#ifndef RPT_MASK
#define RPT_MASK 0
#endif
#ifndef RPT_SUB
#define RPT_SUB 0
#endif
constexpr int NPHASE = 12;
constexpr int N_LAUNCHES = MK_N_LAUNCHES;
static_assert(N_LAUNCHES == 1 || N_LAUNCHES == NPHASE, "MK_N_LAUNCHES is 1 or 12");

#define XB_TMO      128
#define XB_XCNT(j)  (256  + 64 * (j))
#define XB_XSUB(j)  (1280 + 64 * (j))
#define XB_XGEN(j)  (2304 + 64 * (j))
#define XB_TOP      3328
#define XB_TOPGEN   3392
#define XCD_BAR_WORDS 3456
#define XB_SPIN_CAP (1u << 18)

__device__ __forceinline__ unsigned xb_ld(unsigned* p)              { return __hip_atomic_load(p, __ATOMIC_RELAXED, __HIP_MEMORY_SCOPE_AGENT); }
__device__ __forceinline__ unsigned xb_add(unsigned* p, unsigned v) { return __hip_atomic_fetch_add(p, v, __ATOMIC_RELAXED, __HIP_MEMORY_SCOPE_AGENT); }
__device__ __forceinline__ unsigned xb_xcc_id() { return (unsigned)__builtin_amdgcn_s_getreg((3 << 11) | 20) & 0xFu; }
#define XB_SPIN(cond, bar) do { unsigned _sp = 0; while (cond) { __builtin_amdgcn_s_sleep(1); \
    if ((++_sp & 255u) == 0u) { if (xb_ld(&(bar)[XB_TMO])) break; if (_sp > XB_SPIN_CAP) { atomicAdd(&(bar)[XB_TMO], 1u); break; } } } } while (0)

struct XcdBarrier {
    unsigned* bar; unsigned x;
    volatile LAS unsigned* st;
};

__device__ __forceinline__ XcdBarrier xcd_barrier_post(unsigned* bar, volatile LAS unsigned* st) {
    XcdBarrier b; b.bar = bar; b.x = xb_xcc_id(); b.st = st;
    if (threadIdx.x == 0) (void)xb_add(&bar[XB_XCNT(b.x)], 1u);
    return b;
}
__device__ __forceinline__ void xcd_barrier_complete(unsigned* bar, unsigned x, unsigned& nloc, unsigned& nx) {
    const unsigned G = gridDim.x * gridDim.y * gridDim.z;
    unsigned sum, cnt, mine, sp = 0u;
    for (;;) {
        sum = 0u; cnt = 0u; mine = 0u;
#pragma unroll
        for (unsigned j = 0; j < 16; ++j) { const unsigned c = xb_ld(&bar[XB_XCNT(j)]); sum += c; cnt += (c > 0u) ? 1u : 0u; mine = (j == x) ? c : mine; }
        if (sum == G) break;
        __builtin_amdgcn_s_sleep(1);
        if ((++sp & 255u) == 0u) { if (xb_ld(&bar[XB_TMO])) break; if (sp > XB_SPIN_CAP) { atomicAdd(&bar[XB_TMO], 1u); break; } }
    }
    nloc = mine > 0u ? mine : 1u; nx = cnt > 0u ? cnt : 1u;
}

__device__ __forceinline__ void xcd_barrier(const XcdBarrier& b) {
    asm volatile("s_waitcnt vmcnt(0)" ::: "memory");
    __syncthreads();
    if (threadIdx.x == 0) {
        unsigned* bar = b.bar;
        __builtin_amdgcn_s_waitcnt(0);
        unsigned nloc = b.st[0], nx = b.st[1];
        if (nloc == 0u) { xcd_barrier_complete(bar, b.x, nloc, nx); b.st[0] = nloc; b.st[1] = nx; }
        const unsigned old = xb_add(&bar[XB_XSUB(b.x)], 1u);
        const unsigned gen = old / nloc;
        if (old + 1u == (gen + 1u) * nloc) {
            __builtin_amdgcn_fence(__ATOMIC_RELEASE, "agent");
            asm volatile("s_waitcnt vmcnt(0)" ::: "memory");
            const unsigned og = xb_add(&bar[XB_TOP], 1u);
            const unsigned tg = og / nx;
            if (og + 1u == (tg + 1u) * nx) xb_add(&bar[XB_TOPGEN], 1u);
            else XB_SPIN(xb_ld(&bar[XB_TOPGEN]) == tg, bar);
            __builtin_amdgcn_fence(__ATOMIC_ACQUIRE, "agent");
            xb_add(&bar[XB_XGEN(b.x)], 1u);
            asm volatile("s_waitcnt vmcnt(0)" ::: "memory");
        } else {
            XB_SPIN(xb_ld(&bar[XB_XGEN(b.x)]) == gen, bar);
            __builtin_amdgcn_fence(__ATOMIC_ACQUIRE, "agent");
            asm volatile("s_waitcnt vmcnt(0)" ::: "memory");
        }
    }
    __syncthreads();
}

struct Args { const float* in[26]; float* out; unsigned char* ws; int ph_lo, ph_hi, sub, pad; };
struct Frame {
    LAS unsigned char* lds;
    volatile LAS unsigned* MISC;
    unsigned* ctl;
    int tid, lane, wave, bx, vcu, G;
};
enum { I_X = 0, I_C, I_WADA, I_BADA, I_N1G, I_WIN, I_CONVW, I_CONVB, I_BI, I_BF, I_MNG, I_QNG, I_KNG, I_LQ1, I_LK1, I_LQ2, I_LK2, I_DNG, I_WOUT, I_N2G, I_WR, I_BR, I_WGU, I_BGU, I_WD, I_BD };

__device__ __forceinline__ void transpose_item(const float* W, int ldw, int col0, int cstride, bf16* WT, int K, int drow0, int k0, LAS float* scr, int lane) {
#pragma unroll 8
    for (int i = 0; i < 32; ++i) { const int kk = 2 * i + (lane >> 5); scr[kk * 33 + (lane & 31)] = W[(size_t)(k0 + kk) * ldw + col0 + cstride * (lane & 31)]; }
    LDS_WAIT();
    const int c = lane & 7;
#pragma unroll
    for (int j = 0; j < 4; ++j) { const int n = (lane >> 3) + 8 * j; const LAS float* s = scr + (8 * c) * 33 + n;
        u32x4 o; o.x = pk2(s[0 * 33], s[1 * 33]); o.y = pk2(s[2 * 33], s[3 * 33]); o.z = pk2(s[4 * 33], s[5 * 33]); o.w = pk2(s[6 * 33], s[7 * 33]);
        *(u32x4*)(WT + (size_t)(drow0 + n) * K + k0 + 8 * c) = o; }
    LDS_WAIT();
}

__device__ __forceinline__ void transpose_item_fp8(const float* W, int ldw, int col0, int cstride, unsigned char* WT, int K, int drow0, int k0, float scale, LAS float* scr, int lane) {
#pragma unroll 8
    for (int i = 0; i < 32; ++i) { const int kk = 2 * i + (lane >> 5); scr[kk * 33 + (lane & 31)] = W[(size_t)(k0 + kk) * ldw + col0 + cstride * (lane & 31)]; }
    LDS_WAIT();
    const int c = lane & 7;
#pragma unroll
    for (int j = 0; j < 4; ++j) { const int n = (lane >> 3) + 8 * j; const LAS float* s = scr + (8 * c) * 33 + n;
        const u32x2 o = {pk4_fp8(s[0 * 33] * scale, s[1 * 33] * scale, s[2 * 33] * scale, s[3 * 33] * scale), pk4_fp8(s[4 * 33] * scale, s[5 * 33] * scale, s[6 * 33] * scale, s[7 * 33] * scale)};
        *(u32x2*)(WT + (size_t)(drow0 + n) * K + k0 + 8 * c) = o; }
    LDS_WAIT();
}
constexpr float WQ_SCALE = 32.f;

__device__ __forceinline__ void phase0(const Args& a, Frame& F) {
    const int tid = F.tid, lane = F.lane, wave = F.wave;
    {
        LAS float* cond = (LAS float*)(F.lds);
        LAS float* part = (LAS float*)(F.lds + 65536);
        const float* c = a.in[I_C]; const float* w_ada = a.in[I_WADA]; const float* b_ada = a.in[I_BADA];
        float* mod = (float*)(a.ws + WS_MOD);
        bool have = false;
        for (int task = F.bx; task < 96; task += F.G) {
            if (!have) { for (int idx = tid; idx < 16384; idx += 512) { const int b = idx >> 10, k = idx & 1023; const float cv = c[idx]; cond[k * 16 + b] = cv / (1.f + expf(-cv)); } __syncthreads(); have = true; }
            const int col = task * 64 + lane;
            float acc[16];
#pragma unroll
            for (int b = 0; b < 16; ++b) acc[b] = 0.f;
            const float* wp = w_ada + (size_t)(128 * wave) * 6144 + col;
#pragma unroll 32
            for (int k = 0; k < 128; ++k) {
                const float wv = wp[(size_t)k * 6144];
                const LAS f32x4* c4 = (const LAS f32x4*)(cond + (128 * wave + k) * 16);
#pragma unroll
                for (int q = 0; q < 4; ++q) { const f32x4 cc = c4[q]; acc[4 * q + 0] += cc.x * wv; acc[4 * q + 1] += cc.y * wv; acc[4 * q + 2] += cc.z * wv; acc[4 * q + 3] += cc.w * wv; }
            }
#pragma unroll
            for (int b = 0; b < 16; ++b) part[(wave * 16 + b) * 64 + lane] = acc[b];
            __syncthreads();
            for (int o = tid; o < 1024; o += 512) { const int b = o >> 6, l = o & 63; float s = 0.f;
#pragma unroll
                for (int w = 0; w < 8; ++w) s += part[(w * 16 + b) * 64 + l];
                mod[b * 6144 + task * 64 + l] = s + b_ada[task * 64 + l]; }
            __syncthreads();
        }
    }
    {
        const int gtid = F.bx * 512 + tid, NT = F.G * 512;
        const float* w_in = a.in[I_WIN]; const float* w_r = a.in[I_WR]; const float* b_gu = a.in[I_BGU];
        float* Wg = (float*)(a.ws + WS_WG); float* wrT = (float*)(a.ws + WS_WRT); float* bgu = (float*)(a.ws + WS_BGU); f32x2* rope = (f32x2*)(a.ws + WS_ROPE);
        for (int idx = gtid; idx < 8192; idx += NT) { const int g = idx >> 10, k = idx & 1023; Wg[idx] = w_in[(size_t)k * IN_W + 1536 + g]; }
        { int* ident = (int*)(a.ws + WS_IDENT); for (int i = gtid; i < MAXTILES * 256; i += NT) ident[i] = i; }
        for (int idx = gtid; idx < 32768; idx += NT) { const int k = idx >> 5, e = idx & 31; wrT[(k >> 2) * 128 + e * 4 + (k & 3)] = w_r[idx]; }
        for (int idx = gtid; idx < 65536; idx += NT) { const int e = idx >> 11, r = idx & 2047, pn = r >> 8, half = (r >> 3) & 1, j = 8 * ((r & 255) >> 4) + (r & 7); bgu[idx] = b_gu[e * 2048 + 2 * (128 * pn + j) + half]; }
        for (int idx = gtid; idx < 131072; idx += NT) { const int pos = idx >> 5, j = idx & 31;
            const float invf = (float)pow(10000.0, -(double)(2 * j) / 64.0); const float ang = (float)pos * invf;
            rope[idx] = (f32x2){(float)cos((double)ang), (float)sin((double)ang)}; }
    }
    {
        LAS float* scr = (LAS float*)(F.lds + wave * 16384);
        const int gw = F.vcu * NWAVES + wave, NGW = F.G * NWAVES;
        constexpr int I_IN = 16 * 96, I_OUT = 16 * 32, I_DN = 32 * 16 * 32;
        for (int it = gw; it < I_IN + I_OUT + I_DN; it += NGW) {
            int r = it;
            if (r < I_IN) { const int kb = r / 96, nb = r % 96, d0 = 32 * nb; transpose_item(a.in[I_WIN], IN_W, d0 < 1536 ? d0 : d0 + 8, 1, (bf16*)(a.ws + WS_WINT), D, d0, 64 * kb, scr, lane); continue; } r -= I_IN;
            if (r < I_OUT) { const int kb = r / 32, nb = r % 32; transpose_item(a.in[I_WOUT], D, 32 * nb, 1, (bf16*)(a.ws + WS_WOUTT), D, 32 * nb, 64 * kb, scr, lane); continue; } r -= I_OUT;
            { const int e = r >> 9, q = r & 511, kb = q >> 5, nb = q & 31;
              transpose_item_fp8(a.in[I_WD] + (size_t)e * DFF * D, D, 32 * nb, 1, a.ws + WS_WDT + (size_t)e * D * DFF, DFF, 32 * nb, 64 * kb, WQ_SCALE, scr, lane); }
        }
    }
}
__device__ __forceinline__ void wgu_copy(const Args& a, Frame& F) {
    LAS float* scr = (LAS float*)(F.lds + F.wave * 16384);
    const int lane = F.lane;
    const int gw = F.vcu * NWAVES + F.wave, NGW = F.G * NWAVES;
    for (int it = gw; it < 32 * 16 * 32; it += NGW) {
        const int e = it >> 9, q = it & 511, kb = q >> 5, jb = q & 31, pn = jb >> 2, j0 = (jb & 3) * 32, k0 = 64 * kb;
        const float* W = a.in[I_WGU] + (size_t)e * D * 2048 + (size_t)k0 * 2048 + 2 * (128 * pn + j0);
        f32x2 gu[32];
#pragma unroll
        for (int i = 0; i < 32; ++i) gu[i] = *(const f32x2*)(W + (size_t)(2 * i + (lane >> 5)) * 2048 + 2 * (lane & 31));
        unsigned char* WT = a.ws + WS_WGUT + (size_t)e * 2048 * D;
#pragma unroll
        for (int half = 0; half < 2; ++half) {
#pragma unroll
            for (int i = 0; i < 32; ++i) scr[(2 * i + (lane >> 5)) * 33 + (lane & 31)] = half ? gu[i].y : gu[i].x;
            LDS_WAIT();
            const int c = lane & 7;
#pragma unroll
            for (int j = 0; j < 4; ++j) { const int n = (lane >> 3) + 8 * j; const LAS float* sp = scr + (8 * c) * 33 + n;
                const u32x2 o = {pk4_fp8(sp[0 * 33] * WQ_SCALE, sp[1 * 33] * WQ_SCALE, sp[2 * 33] * WQ_SCALE, sp[3 * 33] * WQ_SCALE), pk4_fp8(sp[4 * 33] * WQ_SCALE, sp[5 * 33] * WQ_SCALE, sp[6 * 33] * WQ_SCALE, sp[7 * 33] * WQ_SCALE)};
                *(u32x2*)(WT + (size_t)(pn * 256 + 16 * ((j0 + n) >> 3) + 8 * half + ((j0 + n) & 7)) * D + k0 + 8 * c) = o; }
            LDS_WAIT();
        }
    }
}

__device__ __forceinline__ void phase1(const Args& a, Frame& F) {
    const int tid = F.tid, lane = F.lane;
    LAS float* wg = (LAS float*)F.lds;
    { const float* Wg = (const float*)(a.ws + WS_WG); for (int i = tid; i < 8192; i += 512) wg[i] = Wg[i]; }
    __syncthreads();
    const float* x = a.in[I_X]; const float* g1 = a.in[I_N1G]; const float* mod = (const float*)(a.ws + WS_MOD);
    const float* bi = a.in[I_BI]; const float* bfg = a.in[I_BF];
    bf16* h = (bf16*)(a.ws + WS_H); float* gates = (float*)(a.ws + WS_GATES);
    const int gw = F.vcu * NWAVES + F.wave, NGW = F.G * NWAVES;
#define P1_LOAD(buf, r0) do { _Pragma("unroll") for (int k = 0; k < 2; ++k) { const f32x4* xr = (const f32x4*)(x + (size_t)((r0) + k * NGW) * D) + lane; \
        _Pragma("unroll") for (int j = 0; j < 4; ++j) buf[k][j] = xr[64 * j]; } } while (0)
#define P1_COMP(buf, r0) do { _Pragma("unroll") for (int k = 0; k < 2; ++k) { \
        float ss = 0.f; \
        _Pragma("unroll") for (int j = 0; j < 4; ++j) ss += (buf[k][j].x * buf[k][j].x + buf[k][j].y * buf[k][j].y) + (buf[k][j].z * buf[k][j].z + buf[k][j].w * buf[k][j].w); \
        const float rs = rsq_(wave_sum(ss) * (1.f / D) + EPS); \
        const int row = (r0) + k * NGW, b = row >> 12; \
        float ga[8]; \
        _Pragma("unroll") for (int g = 0; g < 8; ++g) ga[g] = 0.f; \
        _Pragma("unroll") for (int j = 0; j < 4; ++j) { \
            const int col = 256 * j + 4 * lane; \
            const f32x4 gg = *(const f32x4*)(g1 + col), sc = *(const f32x4*)(mod + b * 6144 + 1024 + col), sh = *(const f32x4*)(mod + b * 6144 + col); \
            const f32x4 hv = buf[k][j] * rs * gg * (sc + 1.f) + sh; \
            *(u32x2*)(h + (size_t)row * D + col) = (u32x2){pk2(hv.x, hv.y), pk2(hv.z, hv.w)}; \
            _Pragma("unroll") for (int g = 0; g < 8; ++g) { const f32x4 w4 = *(const LAS f32x4*)(wg + g * 1024 + col); ga[g] += (hv.x * w4.x + hv.y * w4.y) + (hv.z * w4.z + hv.w * w4.w); } } \
        _Pragma("unroll") for (int g = 0; g < 8; ++g) ga[g] = wave_sum(ga[g]); \
          \
        float pre = ga[0]; \
        _Pragma("unroll") for (int g = 1; g < 8; ++g) pre = (lane == g) ? ga[g] : pre; \
        const float z = pre + ((lane < 4) ? bi[lane & 3] : bfg[lane & 3]); \
        const float lsg = fminf(z, 0.f) - __logf(1.f + __expf(-fabsf(z))); \
        if (lane < 8) gates[(size_t)row * 8 + lane] = (lane < 4) ? z : lsg; \
        asm volatile("" ::: "memory");     \
    } } while (0)
    f32x4 va[2][4], vb[2][4], vc[2][4];
    const int lastp = gw + (NTOK / NGW - 2) * NGW;
    P1_LOAD(va, gw); P1_LOAD(vb, gw + 2 * NGW);
    for (int row0 = gw; row0 < NTOK; row0 += 6 * NGW) {
        const int r2 = row0 + 4 * NGW, r3 = row0 + 6 * NGW, r4 = row0 + 8 * NGW;
        P1_LOAD(vc, r2 < NTOK ? r2 : lastp);
        P1_COMP(va, row0);
        P1_LOAD(va, r3 < NTOK ? r3 : lastp);
        if (row0 + 2 * NGW < NTOK) P1_COMP(vb, row0 + 2 * NGW);
        P1_LOAD(vb, r4 < NTOK ? r4 : lastp);
        if (r2 < NTOK) P1_COMP(vc, r2);
    }
#undef P1_LOAD
#undef P1_COMP
}

__device__ __forceinline__ void rope_rows4(const Args& a, int row0, int rstride, int lane) {
    const int seg = lane >> 2, q = lane & 3;
    const float* gp = (seg < 8) ? a.in[I_QNG] : a.in[I_KNG];
    const float sc = (seg < 8) ? attn_body::C2 : 1.f;
    const f32x4 ga = *(const f32x4*)(gp + q * 8), gb = *(const f32x4*)(gp + q * 8 + 4), gc = *(const f32x4*)(gp + 32 + q * 8), gd = *(const f32x4*)(gp + 32 + q * 8 + 4);
    const float g1[8] = {ga.x, ga.y, ga.z, ga.w, gb.x, gb.y, gb.z, gb.w}, g2[8] = {gc.x, gc.y, gc.z, gc.w, gd.x, gd.y, gd.z, gd.w};
    u32x4 lo[4], hi[4]; f32x4 cs[4][4];
#pragma unroll
    for (int k = 0; k < 4; ++k) { const int row = row0 + k * rstride;
        const bf16* pr = (const bf16*)(a.ws + WS_P) + (size_t)row * NP + P_AQ;
        lo[k] = *(const u32x4*)(pr + seg * 64 + q * 8); hi[k] = *(const u32x4*)(pr + seg * 64 + 32 + q * 8);
        const f32x4* tab = (const f32x4*)((const float*)(a.ws + WS_ROPE) + ((size_t)(row & (SEQ - 1)) * 32 + q * 8) * 2);
#pragma unroll
        for (int i = 0; i < 4; ++i) cs[k][i] = tab[i]; }
#pragma unroll
    for (int k = 0; k < 4; ++k) {
        bf16* pr = (bf16*)(a.ws + WS_P) + (size_t)(row0 + k * rstride) * NP + P_AQ;
        float x1[8], x2[8]; float ss = 0.f;
#pragma unroll
        for (int i = 0; i < 4; ++i) { x1[2 * i] = bf2f(lo[k][i] & 0xffffu); x1[2 * i + 1] = bf2f(lo[k][i] >> 16); x2[2 * i] = bf2f(hi[k][i] & 0xffffu); x2[2 * i + 1] = bf2f(hi[k][i] >> 16); }
#pragma unroll
        for (int i = 0; i < 8; ++i) ss += x1[i] * x1[i] + x2[i] * x2[i];
        ss += __shfl_xor(ss, 1); ss += __shfl_xor(ss, 2);
        const float rs = rsq_(ss * (1.f / 64.f) + EPS);
        float o1[8], o2[8];
#pragma unroll
        for (int i = 0; i < 4; ++i) {
#pragma unroll
            for (int e = 0; e < 2; ++e) { const int kk = 2 * i + e; const float c = e ? cs[k][i].z : cs[k][i].x, sn = e ? cs[k][i].w : cs[k][i].y;
                const float y1 = x1[kk] * rs * g1[kk], y2 = x2[kk] * rs * g2[kk];
                o1[kk] = (y1 * c - y2 * sn) * sc; o2[kk] = (y2 * c + y1 * sn) * sc; } }
        *(u32x4*)(pr + seg * 64 + q * 8) = (u32x4){pk2(o1[0], o1[1]), pk2(o1[2], o1[3]), pk2(o1[4], o1[5]), pk2(o1[6], o1[7])};
        *(u32x4*)(pr + seg * 64 + 32 + q * 8) = (u32x4){pk2(o2[0], o2[1]), pk2(o2[2], o2[3]), pk2(o2[4], o2[5]), pk2(o2[6], o2[7])};
    }
}
__device__ __forceinline__ float wave_scan_add(float v, int lane) {
#pragma unroll
    for (int o = 1; o < 64; o <<= 1) { const float t = __shfl_up(v, o); if (lane >= o) v += t; }
    return v;
}
__device__ __forceinline__ float wave_scan_max(float v, int lane) {
#pragma unroll
    for (int o = 1; o < 64; o <<= 1) { const float t = __shfl_up(v, o); if (lane >= o) v = fmaxf(v, t); }
    return v;
}
__device__ __forceinline__ float silu_(float y) { return y * rcp_(1.f + __expf(-y)); }
__device__ __forceinline__ bf16x8 gather8(const LAS bf16* t, int pitch, int s0, int c) {
    bf16x8 f;
#pragma unroll
    for (int j = 0; j < 8; ++j) f[j] = (short)t[(s0 + j) * pitch + c];
    return f;
}
__device__ __forceinline__ int crow(int i, int hh) { return (i & 3) + 8 * (i >> 2) + 4 * hh; }

struct MPref { u32x4 tq, tk, tv0, tv1, th; float ip, lf, mp; float cq[5], ck[5]; f32x4 npv; };
template <bool WITH_Q>
__device__ __forceinline__ void mlstm_prefetch(const Args& a, int u, int tid, MPref& p) {
    const int b = u >> 8, h = (u >> 6) & 3, n = u & 63;
    const long r0 = (long)b * SEQ + (long)n * 64;
    const bf16* P = (const bf16*)(a.ws + WS_P);
    const int row = tid >> 3, c8 = tid & 7;
    if (WITH_Q) p.tq = *(const u32x4*)(P + (size_t)(r0 + row) * NP + P_MQ + h * 64 + c8 * 8);
    p.tk = *(const u32x4*)(P + (size_t)(r0 + row) * NP + P_MK + h * 64 + c8 * 8);
    p.tv0 = *(const u32x4*)(P + (size_t)(r0 + (tid >> 4)) * NP + P_MV + h * 128 + (tid & 15) * 8);
    p.tv1 = *(const u32x4*)(P + (size_t)(r0 + 32 + (tid >> 4)) * NP + P_MV + h * 128 + (tid & 15) * 8);
    p.th = (u32x4){0u, 0u, 0u, 0u};
    if (n > 0 && tid < 48) { const int hk = tid >= 24, t2 = tid - 24 * hk;
        if (WITH_Q || hk) p.th = *(const u32x4*)(P + (size_t)(r0 - 3 + (t2 >> 3)) * NP + (hk ? P_MK : P_MQ) + h * 64 + (t2 & 7) * 8); }
    if (tid < 64) { const float* gates = (const float*)(a.ws + WS_GATES); p.ip = gates[(r0 + tid) * 8 + h]; p.lf = gates[(r0 + tid) * 8 + 4 + h]; }
    if (WITH_Q) p.mp = ((const float*)(a.ws + WS_MPREV))[u];
    { const float* cw = a.in[I_CONVW]; const float* cb = a.in[I_CONVB]; const int c = tid & 63;
#pragma unroll
      for (int j = 0; j < 4; ++j) { if (WITH_Q) p.cq[j] = cw[512 * j + h * 64 + c]; p.ck[j] = cw[512 * j + 256 + h * 64 + c]; }
      if (WITH_Q) p.cq[4] = cb[h * 64 + c]; p.ck[4] = cb[256 + h * 64 + c]; }
    if (WITH_Q && tid < 16) p.npv = *(const f32x4*)((const float*)(a.ws + WS_NPREV) + (size_t)u * 64 + 4 * tid);
}
template <bool WITH_Q>
__device__ __forceinline__ void mlstm_pref_to_lds(const MPref& p, LAS bf16* rawq, LAS bf16* rawk, LAS bf16* Vt, int tid) {
    if (WITH_Q) *(LAS u32x4*)(rawq + (3 + (tid >> 3)) * 64 + (tid & 7) * 8) = p.tq;
    *(LAS u32x4*)(rawk + (3 + (tid >> 3)) * 64 + (tid & 7) * 8) = p.tk;
    *(LAS u32x4*)(Vt + (tid >> 4) * 128 + (tid & 15) * 8) = p.tv0;
    *(LAS u32x4*)(Vt + (32 + (tid >> 4)) * 128 + (tid & 15) * 8) = p.tv1;
    if (tid < 48) { const int hk = tid >= 24, t2 = tid - 24 * hk; if (WITH_Q || hk) *(LAS u32x4*)((hk ? rawk : rawq) + (t2 >> 3) * 64 + (t2 & 7) * 8) = p.th; }
}
__device__ __forceinline__ float conv_tile(LAS bf16* out, const LAS bf16* raw, const float (&cf)[5], float scale, const LAS float* ws, int tid) {
    const int c = tid & 63, rg = tid >> 6;
    const float cw0 = cf[0], cw1 = cf[1], cw2 = cf[2], cw3 = cf[3], cb = cf[4];
    float u0 = bf2f(raw[(rg * 8 + 0) * 64 + c]), u1 = bf2f(raw[(rg * 8 + 1) * 64 + c]), u2 = bf2f(raw[(rg * 8 + 2) * 64 + c]);
    float nsum = 0.f;
#pragma unroll
    for (int i = 0; i < 8; ++i) { const int sI = rg * 8 + i;
        const float cur = bf2f(raw[(sI + 3) * 64 + c]);
        const float y = cb + cw0 * u0 + cw1 * u1 + cw2 * u2 + cw3 * cur;
        const bf16 o = f2bf(silu_(y) * scale * (ws ? ws[sI] : 1.f));
        out[sI * 72 + c] = o; nsum += bf2f(o);
        u0 = u1; u1 = u2; u2 = cur; }
    return nsum;
}
__device__ __forceinline__ void mlstm_A_phase(const Args& a, Frame& F) {
    const int tid = F.tid, lane = F.lane, wave = F.wave, r = lane & 31, hh = lane >> 5;
    LAS bf16* rawk = (LAS bf16*)(F.lds);
    LAS bf16* Vt = (LAS bf16*)(F.lds + 8704);
    LAS bf16* kw = (LAS bf16*)(F.lds + 25088);
    LAS float* wS = (LAS float*)(F.lds + 34304);
    LAS float* nsum = (LAS float*)(F.lds + 34560);
    MPref p; p.ip = 0.f; p.lf = 0.f;
    if (F.vcu < NUNIT) mlstm_prefetch<false>(a, F.vcu, tid, p);
    for (int u = F.vcu; u < NUNIT; u += F.G) {
        mlstm_pref_to_lds<false>(p, rawk, rawk, Vt, tid);
        if (wave == 0) {
            const float bc = wave_scan_add(p.lf, lane);
            const float blast = __shfl(bc, 63);
            const float av = blast - bc + p.ip;
            const float mloc = wave_max(av);
            wS[lane] = __expf(av - mloc);
            if (lane == 0) { ((float*)(a.ws + WS_ML))[u] = mloc; ((float*)(a.ws + WS_BL))[u] = blast; }
        }
        __syncthreads();
        float ckc[5];
#pragma unroll
        for (int j = 0; j < 5; ++j) ckc[j] = p.ck[j];
        mlstm_prefetch<false>(a, (u + F.G < NUNIT) ? u + F.G : u, tid, p);
        nsum[(tid >> 6) * 64 + (tid & 63)] = conv_tile(kw, rawk, ckc, 0.125f, wS, tid);
        __syncthreads();
        {
            const int vt = wave & 3, kt = wave >> 2;
            f32x16 acc = {};
#pragma unroll
            for (int st = 0; st < 4; ++st) acc = __builtin_amdgcn_mfma_f32_32x32x16_bf16(gather8(Vt, 128, 16 * st + 8 * hh, 32 * vt + r), gather8(kw, 72, 16 * st + 8 * hh, 32 * kt + r), acc, 0, 0, 0);
            bf16* Cl = (bf16*)(a.ws + WS_CL) + (size_t)u * 8192;
            int rs_ = r, hs_ = hh; asm volatile("" : "+v"(rs_), "+v"(hs_));
#pragma unroll
            for (int i = 0; i < 16; ++i) Cl[(32 * vt + crow(i, hs_)) * 64 + 32 * kt + rs_] = f2bf(acc[i]);
            if (tid < 64) { float sN = 0.f;
#pragma unroll
                for (int g = 0; g < 8; ++g) sN += nsum[g * 64 + tid];
                ((float*)(a.ws + WS_NL))[(size_t)u * 64 + tid] = sN; }
        }
        __syncthreads();
    }
}

__device__ __forceinline__ void phase4_scan(const Args& a, Frame& F) {
    const int tid = F.tid;
    LAS float* sd = (LAS float*)F.lds;
    const float* ml = (const float*)(a.ws + WS_ML); const float* bl = (const float*)(a.ws + WS_BL);
    for (int item = F.bx; item < 256; item += F.G) {
        const int bh = item >> 2, qtr = item & 3;
        const int e4 = qtr * 512 + tid;
        const bf16* Cl = (const bf16*)(a.ws + WS_CL) + (size_t)bh * 64 * 8192 + 4 * e4;
        bf16* Cp = (bf16*)(a.ws + WS_CPREV) + (size_t)bh * 64 * 8192 + 4 * e4;
        u32x2 clv[64];
#pragma unroll
        for (int n = 0; n < 64; ++n) clv[n] = *(const u32x2*)(Cl + (size_t)n * 8192);
        if (tid < 64) { sd[192 + tid] = ml[bh * 64 + tid]; sd[256 + tid] = bl[bh * 64 + tid]; }
        __syncthreads();
        if (tid == 0) { float m = 0.f;
            for (int n = 0; n < 64; ++n) { const float mlv = sd[192 + n], blv = sd[256 + n]; sd[128 + n] = m; const float mn = fmaxf(blv + m, mlv); sd[n] = __expf(blv + m - mn); sd[64 + n] = __expf(mlv - mn); m = mn; } }
        __syncthreads();
        float c0 = 0.f, c1 = 0.f, c2 = 0.f, c3 = 0.f;
#pragma unroll
        for (int n = 0; n < 64; ++n) {
            *(u32x2*)(Cp + (size_t)n * 8192) = (u32x2){pk2(c0, c1), pk2(c2, c3)};
            const u32x2 cl = clv[n];
            const float d = sd[n], f = sd[64 + n];
            c0 = d * c0 + f * bf2f(cl.x & 0xffffu); c1 = d * c1 + f * bf2f(cl.x >> 16); c2 = d * c2 + f * bf2f(cl.y & 0xffffu); c3 = d * c3 + f * bf2f(cl.y >> 16);
        }
        if (qtr == 0 && tid < 16) {
            const float* nl = (const float*)(a.ws + WS_NL) + (size_t)bh * 64 * 64 + 4 * tid; float* np = (float*)(a.ws + WS_NPREV) + (size_t)bh * 64 * 64 + 4 * tid;
            f32x4 nn = {0.f, 0.f, 0.f, 0.f};
            for (int n = 0; n < 64; ++n) { *(f32x4*)(np + n * 64) = nn; const f32x4 l4 = *(const f32x4*)(nl + n * 64); nn = nn * sd[n] + l4 * sd[64 + n]; }
        }
        if (qtr == 0 && tid >= 64 && tid < 128) ((float*)(a.ws + WS_MPREV))[bh * 64 + tid - 64] = sd[128 + tid - 64];
        __syncthreads();
    }
}

__device__ __forceinline__ void mlstm_C_phase(const Args& a, Frame& F) {
    const int tid = F.tid, lane = F.lane, wave = F.wave, r = lane & 31, hh = lane >> 5;
    const bf16* P = (const bf16*)(a.ws + WS_P);
    LAS bf16* rawq = (LAS bf16*)(F.lds);
    LAS bf16* rawk = (LAS bf16*)(F.lds + 8704);
    LAS bf16* Vt = (LAS bf16*)(F.lds + 17408);
    LAS bf16* qc = (LAS bf16*)(F.lds + 33792);
    LAS bf16* kc = (LAS bf16*)(F.lds + 43008);
    LAS bf16* Sb = (LAS bf16*)(F.lds + 52224);
    LAS float* gS = (LAS float*)(F.lds + 61440);
    LAS float* Ms = (LAS float*)(F.lds + 61696);
    LAS float* bs = (LAS float*)(F.lds + 61952);
    LAS float* ssum = (LAS float*)(F.lds + 62208);
    LAS float* npl = (LAS float*)(F.lds + 63232);
    const int tt = wave >> 2, vt = wave & 3;
    MPref p; p.ip = 0.f; p.lf = 0.f; p.mp = 0.f;
    if (F.vcu < NUNIT) mlstm_prefetch<true>(a, F.vcu, tid, p);
    for (int u = F.vcu; u < NUNIT; u += F.G) {
        const int b = u >> 8, h = (u >> 6) & 3, n = u & 63;
        const long r0 = (long)b * SEQ + (long)n * 64;
        const float mp = p.mp;
        int rg_ = r, hg_ = hh; asm volatile("" : "+v"(rg_), "+v"(hg_));
        mlstm_pref_to_lds<true>(p, rawq, rawk, Vt, tid);
        if (tid < 16) *(LAS f32x4*)(npl + 4 * tid) = p.npv;
        if (wave == 0) {
            const float bc = wave_scan_add(p.lf, lane);
            const float g = p.ip - bc;
            const float cm = wave_scan_max(g, lane);
            gS[lane] = g; Ms[lane] = fmaxf(mp, cm); bs[lane] = bc;
        }
        const bf16* Cp = (const bf16*)(a.ws + WS_CPREV) + (size_t)u * 8192;
        bf16x8 cfr[4];
#pragma unroll
        for (int st = 0; st < 4; ++st) cfr[st] = *(const bf16x8*)(Cp + (32 * vt + rg_) * 64 + 16 * st + 8 * hg_);
        u32x2 mo2[4]; f32x4 gv4[4];
#pragma unroll
        for (int g = 0; g < 4; ++g) { mo2[g] = *(const u32x2*)(P + (size_t)(r0 + 32 * tt + rg_) * NP + P_MO + h * 128 + 32 * vt + 8 * g + 4 * hg_);
            gv4[g] = *(const f32x4*)(a.in[I_MNG] + h * 128 + 32 * vt + 8 * g + 4 * hg_); }
        __syncthreads();
        float cqc[5], ckc[5];
#pragma unroll
        for (int j = 0; j < 5; ++j) { cqc[j] = p.cq[j]; ckc[j] = p.ck[j]; }
        mlstm_prefetch<true>(a, (u + F.G < NUNIT) ? u + F.G : u, tid, p);
        (void)conv_tile(qc, rawq, cqc, 1.f, nullptr, tid);
        (void)conv_tile(kc, rawk, ckc, 0.125f, nullptr, tid);
        __syncthreads();
        if (wave < 3) {
            const int ts = wave > 0, st = wave > 1;
            f32x16 acc = {};
#pragma unroll
            for (int kk = 0; kk < 4; ++kk) acc = __builtin_amdgcn_mfma_f32_32x32x16_bf16(*(const LAS bf16x8*)(qc + (32 * ts + r) * 72 + 16 * kk + 8 * hh), *(const LAS bf16x8*)(kc + (32 * st + r) * 72 + 16 * kk + 8 * hh), acc, 0, 0, 0);
            const int sabs = 32 * st + r; const float gs = gS[sabs];
#pragma unroll
            for (int i = 0; i < 16; ++i) { const int tabs = 32 * ts + crow(i, hh);
                const float val = (sabs <= tabs) ? acc[i] * __expf(gs - Ms[tabs]) : 0.f;
                Sb[tabs * 72 + sabs] = f2bf(val); }
        }
        __syncthreads();
        f32x16 outv;
        {
            bf16x8 qa[4], sa[4];
#pragma unroll
            for (int st = 0; st < 4; ++st) { qa[st] = *(const LAS bf16x8*)(qc + (32 * tt + r) * 72 + 16 * st + 8 * hh);
                sa[st] = (st < 2 * (tt + 1)) ? *(const LAS bf16x8*)(Sb + (32 * tt + r) * 72 + 16 * st + 8 * hh) : (bf16x8){0, 0, 0, 0, 0, 0, 0, 0}; }
            f32x16 d1 = {}, d2 = {}, a1 = {}, a2 = {};
            const short one = (r == 0) ? (short)0x3F80 : (short)0;
            const bf16x8 ones = {one, one, one, one, one, one, one, one};
#pragma unroll
            for (int st = 0; st < 4; ++st) {
                d1 = __builtin_amdgcn_mfma_f32_32x32x16_bf16(ones, sa[st], d1, 0, 0, 0);
                { const f32x4 n0 = *(const LAS f32x4*)(npl + 16 * st + 8 * hh), n1 = *(const LAS f32x4*)(npl + 16 * st + 8 * hh + 4);
                  const u32x4 pk = {pk2(n0.x, n0.y), pk2(n0.z, n0.w), pk2(n1.x, n1.y), pk2(n1.z, n1.w)}; const u32x4 zz = {0u, 0u, 0u, 0u};
                  d2 = __builtin_amdgcn_mfma_f32_32x32x16_bf16(__builtin_bit_cast(bf16x8, (r == 0) ? pk : zz), qa[st], d2, 0, 0, 0); }
                a1 = __builtin_amdgcn_mfma_f32_32x32x16_bf16(gather8(Vt, 128, 16 * st + 8 * hh, 32 * vt + r), sa[st], a1, 0, 0, 0);
                a2 = __builtin_amdgcn_mfma_f32_32x32x16_bf16(cfr[st], qa[st], a2, 0, 0, 0);
            }
            const int tabs = 32 * tt + r;
            const float Mt = Ms[tabs], iw = __expf(mp - Mt);
            float den = d1[0] + iw * d2[0];
            den += __shfl_xor(den, 32);
            const float inv = rcp_(fmaxf(fabsf(den), __expf(-(bs[tabs] + Mt))));
            float sq = 0.f;
#pragma unroll
            for (int i = 0; i < 16; ++i) { const float o = (a1[i] + iw * a2[i]) * inv; outv[i] = o; sq += o * o; }
            sq += __shfl_xor(sq, 32);
            if (hh == 0) ssum[tabs * 4 + vt] = sq;
        }
        __syncthreads();
        {
            bf16* cat = (bf16*)(a.ws + WS_H);
            int rs_ = r, hs_ = hh; asm volatile("" : "+v"(rs_), "+v"(hs_));
            const f32x4 s4 = *(const LAS f32x4*)(ssum + (32 * tt + r) * 4);
            const float rsn = rsq_(((s4.x + s4.y) + (s4.z + s4.w)) * (1.f / 128.f) + EPS);
#pragma unroll
            for (int g = 0; g < 4; ++g) {
                const float m0 = bf2f(mo2[g].x & 0xffffu), m1 = bf2f(mo2[g].x >> 16), m2 = bf2f(mo2[g].y & 0xffffu), m3 = bf2f(mo2[g].y >> 16);
                const float o0 = outv[4 * g] * rsn * gv4[g].x * sigmoidf_(m0), o1 = outv[4 * g + 1] * rsn * gv4[g].y * sigmoidf_(m1);
                const float o2 = outv[4 * g + 2] * rsn * gv4[g].z * sigmoidf_(m2), o3 = outv[4 * g + 3] * rsn * gv4[g].w * sigmoidf_(m3);
                *(u32x2*)(cat + (size_t)(r0 + 32 * tt + rs_) * D + h * 128 + 32 * vt + 8 * g + 4 * hs_) = (u32x2){pk2(o0, o1), pk2(o2, o3)};
            }
        }
        __syncthreads();
    }
}
__device__ __forceinline__ void pa_rows4(const Args& a, int row, int rstride, int lane, float lam) {
    const int head = lane >> 4, v0 = (lane & 15) * 8;
    u32x4 o0[4], o1[4];
#pragma unroll
    for (int k = 0; k < 4; ++k) { const bf16* O = (const bf16*)(a.ws + WS_O) + (size_t)(row + k * rstride) * D;
        o0[k] = *(const u32x4*)(O + (head * 2 + 0) * 128 + v0); o1[k] = *(const u32x4*)(O + (head * 2 + 1) * 128 + v0); }
    const float* g = a.in[I_DNG] + head * 128 + v0;
    const f32x4 g0 = *(const f32x4*)g, g1 = *(const f32x4*)(g + 4);
#pragma unroll
    for (int k = 0; k < 4; ++k) {
        float d[8]; float ss = 0.f;
#pragma unroll
        for (int i = 0; i < 4; ++i) { d[2 * i] = bf2f(o0[k][i] & 0xffffu) - lam * bf2f(o1[k][i] & 0xffffu); d[2 * i + 1] = bf2f(o0[k][i] >> 16) - lam * bf2f(o1[k][i] >> 16); }
#pragma unroll
        for (int i = 0; i < 8; ++i) ss += d[i] * d[i];
        ss += __shfl_xor(ss, 1); ss += __shfl_xor(ss, 2); ss += __shfl_xor(ss, 4); ss += __shfl_xor(ss, 8);
        const float rs = 0.8f * rsq_(ss * (1.f / 128.f) + EPS);
        *(u32x4*)((bf16*)(a.ws + WS_H) + (size_t)(row + k * rstride) * D + 512 + head * 128 + v0) =
            (u32x4){pk2(d[0] * rs * g0.x, d[1] * rs * g0.y), pk2(d[2] * rs * g0.z, d[3] * rs * g0.w), pk2(d[4] * rs * g1.x, d[5] * rs * g1.y), pk2(d[6] * rs * g1.z, d[7] * rs * g1.w)};
    }
}

__device__ __forceinline__ bool rt_better(float av, int ae, float bv, int be) { return av > bv || (av == bv && ae < be); }
__device__ __forceinline__ void phase7(const Args& a, Frame& F) {
    const int wave = F.wave;
    LAS float* gsl = (LAS float*)(F.lds + LDSCTL_OFF + 4096);
    LAS float* shl = (LAS float*)(F.lds + LDSCTL_OFF + 8192);
    LAS float* rsl = (LAS float*)(F.lds + LDSCTL_OFF + 12288);
    LAS float* cbl = (LAS float*)(F.lds + LDSCTL_OFF + 2048);
    LAS float* region = (LAS float*)F.lds;
    LAS float* fin = (LAS float*)(F.lds + 73728);
    LAS float* ssp = (LAS float*)(F.lds + 106496);
    LAS float* cbp = (LAS float*)(F.lds + 108544);
    const float* Wt = (const float*)(a.ws + WS_WRT);
    LAS int* lcount = (LAS int*)(F.lds + TAB_OFF + 160);
    if (F.tid < 32) lcount[F.tid] = 0;
    const float* x = a.in[I_X]; const float* g2 = a.in[I_N2G]; const float* mod = (const float*)(a.ws + WS_MOD); const float* brt = a.in[I_BR];
    const bf16* mixg = (const bf16*)(a.ws + WS_MIXG); unsigned char* h2 = a.ws + WS_H;
    unsigned* meta = (unsigned*)(a.ws + WS_META); float* gatew = (float*)(a.ws + WS_GATEW);
    unsigned* gcnt = F.ctl + CW_GCNT; int* wgbase = (int*)(a.ws + WS_WGBASE);
    for (int rb = F.bx; rb < NTOK / 256; rb += F.G) {
        int tid_ = F.tid; asm volatile("" : "+v"(tid_));
        const int tid = tid_, lane = tid & 63;
        const int b = rb >> 4;
        __syncthreads();
        for (int k = tid; k < 1024; k += 512) { gsl[k] = g2[k] * (1.f + mod[b * 6144 + 4096 + k]); shl[k] = mod[b * 6144 + 3072 + k]; }
        __syncthreads();
        {
            const int e = tid & 31, part = tid >> 5; float sacc = 0.f;
#pragma unroll 4
            for (int q = 0; q < 16; ++q) { const f32x4 w4 = *(const f32x4*)(Wt + (size_t)(16 * part + q) * 128 + e * 4); const f32x4 s4 = *(const LAS f32x4*)(shl + 64 * part + 4 * q);
                sacc += (w4.x * s4.x + w4.y * s4.y) + (w4.z * s4.z + w4.w * s4.w); }
            cbp[part * 32 + e] = sacc;
        }
        __syncthreads();
        if (tid < 32) { float sacc = brt[tid];
#pragma unroll
            for (int q = 0; q < 16; ++q) sacc += cbp[q * 32 + tid];
            cbl[tid] = sacc; }
        const int wrow0 = rb * 256 + wave * 32;
        {
            const int lr = lane >> 3, pc = lane & 7, rl = lane & 31, kk = lane >> 5, kbase = wave * 128;
            const unsigned lo_h = (unsigned)(lr * D + 4 * pc), lo_m = 2u * lo_h, lo_x = 4u * lo_h, lo_w = (unsigned)((4 * kk * 128 + rl * 4) * 4);
            const char* xu = (const char*)(x + (size_t)(rb * 256) * D + kbase); const char* mu = (const char*)(mixg + (size_t)(rb * 256) * D + kbase);
            unsigned char* hu = h2 + (size_t)(rb * 256) * D + kbase; const char* wu = (const char*)(Wt + (size_t)(kbase / 4) * 128);
            f32x4 xa[4], xb[4], xc[4], xd[4], wv[4]; u32x2 ma[4], mb[4], mc[4], md[4];
            u32x2 hb[4][4]; f32x16 acc; float ss4[4];
#define P7_LOAD(xv, mv, T, S) do { _Pragma("unroll") for (int i = 0; i < 4; ++i) { const size_t ro_ = (size_t)(32 * (T) + 8 * i) * D + 32 * (S); \
                xv[i] = *(const f32x4*)(xu + ro_ * 4 + ox); mv[i] = *(const u32x2*)(mu + ro_ * 2 + om); } } while (0)
#define P7_LOADW(wv, S) do { _Pragma("unroll") for (int q = 0; q < 4; ++q) wv[q] = *(const f32x4*)(wu + (size_t)((8 * (S) + q) * 512) + ow); } while (0)
#define P7_COMP(xv, mv, S, SN) do { const f32x4 g4 = *(const LAS f32x4*)(gsl + kbase + 32 * (S) + 4 * pc); \
                _Pragma("unroll") for (int i = 0; i < 4; ++i) { f32x4 v = xv[i]; \
                    v.x += bf2f(mv[i].x & 0xffffu); v.y += bf2f(mv[i].x >> 16); v.z += bf2f(mv[i].y & 0xffffu); v.w += bf2f(mv[i].y >> 16); \
                    ss4[i] += (v.x * v.x + v.y * v.y) + (v.z * v.z + v.w * v.w); \
                    const f32x4 h = v * g4; \
                    *(LAS f32x4*)(slab + (8 * i + lr) * 36 + 4 * pc) = h; hb[S][i] = (u32x2){pk2(h.x, h.y), pk2(h.z, h.w)}; } \
                LDS_WAIT(); \
                f32x4 hq[4]; \
                _Pragma("unroll") for (int q = 0; q < 4; ++q) hq[q] = *(const LAS f32x4*)(slab + rl * 36 + 16 * kk + 4 * q); \
                LDS_WAIT(); \
                _Pragma("unroll") for (int q = 0; q < 4; ++q) { \
                    acc = __builtin_amdgcn_mfma_f32_32x32x2f32(wv[q].x, hq[q].x, acc, 0, 0, 0); acc = __builtin_amdgcn_mfma_f32_32x32x2f32(wv[q].y, hq[q].y, acc, 0, 0, 0); \
                    acc = __builtin_amdgcn_mfma_f32_32x32x2f32(wv[q].z, hq[q].z, acc, 0, 0, 0); acc = __builtin_amdgcn_mfma_f32_32x32x2f32(wv[q].w, hq[q].w, acc, 0, 0, 0); \
                    wv[q] = *(const f32x4*)(wu + (size_t)((8 * (SN) + q) * 512) + ow); } } while (0)
            unsigned ox = lo_x, om = lo_m, oh = lo_h, ow = lo_w;
            P7_LOAD(xa, ma, 0, 0); P7_LOAD(xb, mb, 0, 1); P7_LOADW(wv, 0);
#pragma unroll 1
            for (int t = 0; t < 8; ++t) {
                asm volatile("" : "+v"(ox), "+v"(om), "+v"(oh), "+v"(ow));
                const int tn = (t + 1 < 8) ? t + 1 : 7;
                LAS float* slab = region + ((t & 1) * 8 + wave) * 1152;
                LAS float* sspb = ssp + (t & 1) * 256;
#pragma unroll
                for (int i = 0; i < 16; ++i) acc[i] = 0.f;
#pragma unroll
                for (int i = 0; i < 4; ++i) ss4[i] = 0.f;
#define P7_SB __builtin_amdgcn_sched_barrier(0)
                P7_SB; P7_LOAD(xc, mc, t, 2);  P7_SB; P7_COMP(xa, ma, 0, 1);
                P7_SB; P7_LOAD(xd, md, t, 3);  P7_SB; P7_COMP(xb, mb, 1, 2);
                P7_SB; P7_LOAD(xa, ma, tn, 0); P7_SB; P7_COMP(xc, mc, 2, 3);
                P7_SB; P7_LOAD(xb, mb, tn, 1); P7_SB; P7_COMP(xd, md, 3, 0); P7_SB;
#undef P7_SB
#pragma unroll
                for (int i = 0; i < 4; ++i) { float sv = ss4[i]; sv += __shfl_xor(sv, 1); sv += __shfl_xor(sv, 2); sv += __shfl_xor(sv, 4); ss4[i] = sv; }
                if (pc == 0) {
#pragma unroll
                    for (int i = 0; i < 4; ++i) sspb[wave * 32 + 8 * i + lr] = ss4[i]; }
#pragma unroll
                for (int i = 0; i < 16; ++i) slab[i * 64 + lane] = acc[i];
                LDS_WAIT(); asm volatile("" ::: "memory"); __builtin_amdgcn_s_barrier(); asm volatile("" ::: "memory");
                float rs4[4];
#pragma unroll
                for (int i = 0; i < 4; ++i) { float sv = 0.f;
#pragma unroll
                    for (int w = 0; w < 8; ++w) sv += sspb[w * 32 + 8 * i + lr];
                    rs4[i] = rsq_(sv * (1.f / D) + EPS); }
                if (wave == 0 && pc == 0) {
#pragma unroll
                    for (int i = 0; i < 4; ++i) rsl[t * 32 + 8 * i + lr] = rs4[i]; }
                {
                    const LAS float* rt = region + (t & 1) * 8 * 1152;
#pragma unroll
                    for (int o = 0; o < 2; ++o) { float sv = 0.f;
#pragma unroll
                        for (int w = 0; w < 8; ++w) sv += rt[w * 1152 + o * 512 + tid];
                        fin[t * 1024 + o * 512 + tid] = sv; } }
#pragma unroll
                for (int S = 0; S < 4; ++S) { const f32x4 s4 = *(const LAS f32x4*)(shl + kbase + 32 * S + 4 * pc);
#pragma unroll
                    for (int i = 0; i < 4; ++i) { const u32x2 hv = hb[S][i];
                        *(unsigned*)(hu + (size_t)(32 * t + 8 * i) * D + 32 * S + oh) = pk4_fp8(bf2f(hv.x & 0xffffu) * rs4[i] + s4.x, bf2f(hv.x >> 16) * rs4[i] + s4.y, bf2f(hv.y & 0xffffu) * rs4[i] + s4.z, bf2f(hv.y >> 16) * rs4[i] + s4.w); } }
            }
#undef P7_LOAD
#undef P7_LOADW
#undef P7_COMP
        }
        __syncthreads();
        f32x16 acc;
        { const float rsr = rsl[wave * 32 + (lane & 31)];
#pragma unroll
          for (int i = 0; i < 16; ++i) acc[i] = fin[wave * 1024 + i * 64 + lane] * rsr; }
        {
            const int hh = lane >> 5;
            float v[16];
#pragma unroll
            for (int i = 0; i < 16; ++i) v[i] = acc[i] + cbl[crow(i, hh)];
            float cv[8]; int ce[8];
#pragma unroll
            for (int k = 0; k < 4; ++k) { float bv = v[0]; int bi_ = 0;
#pragma unroll
                for (int i = 1; i < 16; ++i) { if (v[i] > bv) { bv = v[i]; bi_ = i; } }
                cv[k] = bv; ce[k] = crow(bi_, hh);
#pragma unroll
                for (int i = 0; i < 16; ++i) v[i] = (i == bi_) ? -INFINITY : v[i]; }
#pragma unroll
            for (int k = 0; k < 4; ++k) { cv[4 + k] = __shfl_xor(cv[k], 32); ce[4 + k] = __shfl_xor(ce[k], 32); }
            float tv[4]; int te[4];
#pragma unroll
            for (int k = 0; k < 4; ++k) { float bv = cv[0]; int be = ce[0], bj = 0;
#pragma unroll
                for (int j = 1; j < 8; ++j) { if (rt_better(cv[j], ce[j], bv, be)) { bv = cv[j]; be = ce[j]; bj = j; } }
                tv[k] = bv; te[k] = be;
#pragma unroll
                for (int j = 0; j < 8; ++j) cv[j] = (j == bj) ? -INFINITY : cv[j]; }
            const float p1 = __expf(tv[1] - tv[0]), p2 = __expf(tv[2] - tv[0]), p3 = __expf(tv[3] - tv[0]); const float isum = rcp_(1.f + p1 + p2 + p3);
            if (hh == 0) {
                const int row = wrow0 + lane;
                u32x4 m4; const f32x4 g4 = {isum, p1 * isum, p2 * isum, p3 * isum};
#pragma unroll
                for (int k = 0; k < 4; ++k) { const int lr = __hip_atomic_fetch_add(lcount + (te[k] & 31), 1, __ATOMIC_RELAXED, __HIP_MEMORY_SCOPE_WORKGROUP); m4[k] = (unsigned)(te[k] & 31) | ((unsigned)lr << 8); }
                *(u32x4*)(meta + (size_t)row * 4) = m4; *(f32x4*)(gatew + (size_t)row * 4) = g4;
            }
        }
        __syncthreads();
        if (tid < 32) { const int c = lcount[tid]; const unsigned base = __hip_atomic_fetch_add(gcnt + tid, (unsigned)c, __ATOMIC_RELAXED, __HIP_MEMORY_SCOPE_AGENT); wgbase[rb * 32 + tid] = (int)base; lcount[tid] = 0; }
    }
    __syncthreads();
}

__device__ __forceinline__ void phase8(const Args& a, Frame& F) {
    const int tid = F.tid;
    LAS int* pstart = (LAS int*)(F.lds + TAB_OFF + 320);
    LAS int* cntl = (LAS int*)(F.lds + TAB_OFF + 480);
    const unsigned* gcnt = F.ctl + CW_GCNT;
    if (tid < 64) {
        const int c = (tid < 32) ? (int)gcnt[tid] : 0; const int pad = ((c + 255) >> 8) << 8;
        int inc = pad;
#pragma unroll
        for (int o = 1; o < 32; o <<= 1) { const int t = __shfl_up(inc, o); if ((tid & 63) >= o) inc += t; }
        if (tid < 32) { cntl[tid] = c; pstart[tid] = inc - pad; }
        if (tid == 31) pstart[32] = inc;
    }
    __syncthreads();
    const unsigned* meta = (const unsigned*)(a.ws + WS_META); const int* wgbase = (const int*)(a.ws + WS_WGBASE);
    int* pos = (int*)(a.ws + WS_POS); int* rowtok = (int*)(a.ws + WS_ROWTOK);
    for (int slot = F.bx * 512 + tid; slot < NSLOT; slot += F.G * 512) {
        const unsigned m = meta[slot]; const int e = m & 255, lr = m >> 8, row = slot >> 2, rb = row >> 8;
        const int dest = pstart[e] + wgbase[rb * 32 + e] + lr;
        pos[slot] = dest; rowtok[dest] = row;
    }
    for (int e = F.bx; e < 32; e += F.G) for (int d = pstart[e] + cntl[e] + tid; d < pstart[e + 1]; d += 512) rowtok[d] = 0;
}
__device__ __forceinline__ const LAS int* moe_tiles(Frame& F) {
    LAS int* ptile = (LAS int*)(F.lds + TAB_OFF);
    const unsigned* gcnt = F.ctl + CW_GCNT;
    if (F.tid < 64) {
        const int nt_ = (F.tid < 32) ? (((int)gcnt[F.tid] + 255) >> 8) : 0;
        int inc = nt_;
#pragma unroll
        for (int o = 1; o < 32; o <<= 1) { const int t = __shfl_up(inc, o); if ((F.tid & 63) >= o) inc += t; }
        if (F.tid < 32) ptile[F.tid] = inc - nt_;
        if (F.tid == 31) ptile[32] = inc;
    }
    __syncthreads();
    return ptile;
}

__device__ __forceinline__ void phase11(const Args& a, Frame& F) {
    const int lane = F.lane;
    const float* x = a.in[I_X]; const float* mod = (const float*)(a.ws + WS_MOD);
    const bf16* mixg = (const bf16*)(a.ws + WS_MIXG); const unsigned char* orow = a.ws + WS_OUTROWS;
    const int* pos = (const int*)(a.ws + WS_POS); const float* gatew = (const float*)(a.ws + WS_GATEW);
    const int gw = F.vcu * NWAVES + F.wave, NGW = F.G * NWAVES;
    for (int row = gw; row < NTOK; row += NGW) {
        const int b = row >> 12;
        const int p0 = pos[row * 4], p1 = pos[row * 4 + 1], p2 = pos[row * 4 + 2], p3 = pos[row * 4 + 3];
        const f32x4 gk = *(const f32x4*)(gatew + (size_t)row * 4);
#pragma unroll
        for (int j = 0; j < 4; ++j) {
            const int col = 256 * j + 4 * lane; const size_t off = (size_t)row * D + col;
            const f32x4 xv = *(const f32x4*)(x + off); const u32x2 mg = *(const u32x2*)(mixg + off);
            const f32x4 g2 = *(const f32x4*)(mod + b * 6144 + 5120 + col);
            const unsigned e0 = *(const unsigned*)(orow + (size_t)p0 * D + col), e1 = *(const unsigned*)(orow + (size_t)p1 * D + col), e2 = *(const unsigned*)(orow + (size_t)p2 * D + col), e3 = *(const unsigned*)(orow + (size_t)p3 * D + col);
            const f32x2 a0 = __builtin_amdgcn_cvt_pk_f32_fp8((int)e0, false), b0 = __builtin_amdgcn_cvt_pk_f32_fp8((int)e0, true), a1 = __builtin_amdgcn_cvt_pk_f32_fp8((int)e1, false), b1 = __builtin_amdgcn_cvt_pk_f32_fp8((int)e1, true);
            const f32x2 a2 = __builtin_amdgcn_cvt_pk_f32_fp8((int)e2, false), b2 = __builtin_amdgcn_cvt_pk_f32_fp8((int)e2, true), a3 = __builtin_amdgcn_cvt_pk_f32_fp8((int)e3, false), b3 = __builtin_amdgcn_cvt_pk_f32_fp8((int)e3, true);
            f32x4 m;
            m.x = gk.x * a0.x + gk.y * a1.x + gk.z * a2.x + gk.w * a3.x; m.y = gk.x * a0.y + gk.y * a1.y + gk.z * a2.y + gk.w * a3.y;
            m.z = gk.x * b0.x + gk.y * b1.x + gk.z * b2.x + gk.w * b3.x; m.w = gk.x * b0.y + gk.y * b1.y + gk.z * b2.y + gk.w * b3.y;
            f32x4 o; o.x = xv.x + bf2f(mg.x & 0xffffu) + g2.x * m.x; o.y = xv.y + bf2f(mg.x >> 16) + g2.y * m.y; o.z = xv.z + bf2f(mg.y & 0xffffu) + g2.z * m.z; o.w = xv.w + bf2f(mg.y >> 16) + g2.w * m.w;
            *(f32x4*)(a.out + off) = o;
        }
    }
}

__global__ void __launch_bounds__(NWAVES * 64, 2) hybrid_fwd(Args args) {
    extern __shared__ __attribute__((aligned(16))) unsigned char lds[];
    Frame F;
    F.lds = (LAS unsigned char*)lds;
    F.MISC = (volatile LAS unsigned*)(F.lds + MISC_OFF);
    F.tid = threadIdx.x; F.lane = F.tid & 63; F.wave = __builtin_amdgcn_readfirstlane(F.tid >> 6);
    F.G = gridDim.x; F.bx = blockIdx.x; F.vcu = (F.G % 8 == 0) ? (F.bx % 8) * (F.G / 8) + F.bx / 8 : F.bx;
    F.ctl = (unsigned*)(args.ws + WS_CTL);
    for (int u = F.tid; u < (LDS_BYTES - LDSCTL_OFF) / 4; u += NWAVES * 64) ((LAS unsigned*)(F.lds + LDSCTL_OFF))[u] = 0u;
    __syncthreads();
    XcdBarrier bar; bar.bar = F.ctl + CW_BAR; bar.x = 0; bar.st = nullptr;
    if (N_LAUNCHES == 1) bar = xcd_barrier_post(F.ctl + CW_BAR, F.MISC + 8);
    const int lo = args.ph_lo, hi = args.ph_hi;
#ifndef PH_MASK
#define PH_MASK 0xFFF
#endif
#define IN(k) (((PH_MASK >> (k)) & 1) && lo <= (k) && (k) < hi)
#define REFRESH() do { int t_ = threadIdx.x; asm volatile("" : "+v"(t_)); F.tid = t_; F.lane = t_ & 63; F.wave = __builtin_amdgcn_readfirstlane(t_ >> 6); } while (0)
#define SEAM(k) do { if (IN(k) && IN((k) + 1)) { if (N_LAUNCHES == 1) xcd_barrier(bar); } } while (0)
    unsigned char* ws = args.ws;

    if (IN(0)) { REFRESH(); phase0(args, F); } SEAM(0);
    if (IN(1)) { REFRESH(); phase1(args, F); } SEAM(1);
    if (IN(2)) { REFRESH();
        pg8::PlainOrder S; S.init(NTOK, NP, D, F.G, F.bx, ws + WS_H, ws + WS_WINT);
        pg8::EpiBf16 E{(bf16*)(ws + WS_P), NP, nullptr, 0, 1.f};
        pg8::gemm_phase<pg8::EpiBf16, pg8::PlainOrder, false>(F.lds + RING_OFF, D, S, E, nullptr);
    } SEAM(2);
    if (IN(3)) { REFRESH();
        if (args.sub != 1) for (int row = F.vcu * NWAVES + F.wave; row < NTOK; row += 4 * F.G * NWAVES) rope_rows4(args, row, F.G * NWAVES, F.lane);
        if (args.sub != 2) mlstm_A_phase(args, F);
    } SEAM(3);
    if (IN(4)) { REFRESH();
        if (args.sub != 1) phase4_scan(args, F);
        if (args.sub != 2) {
            const float s1 = wave_sum(args.in[I_LQ1][F.lane] * args.in[I_LK1][F.lane]), s2 = wave_sum(args.in[I_LQ2][F.lane] * args.in[I_LK2][F.lane]);
            const float lam = expf(s1) - expf(s2) + 0.2f;
            for (int item = F.vcu; item < 256; item += F.G) attn_body::attn_pair<8>((char*)lds + RING_OFF, (const attn_body::bf16*)(ws + WS_P), (attn_body::bf16*)(ws + WS_O), (attn_body::bf16*)(ws + WS_H), args.in[I_DNG], lam, item);
        }
    } SEAM(4);
    if (IN(5)) { REFRESH();
        if (args.sub != 2) mlstm_C_phase(args, F);
    } SEAM(5);
    if (IN(6)) { REFRESH();
        pg8::PlainOrder S; S.init(NTOK, D, D, F.G, F.bx, ws + WS_H, ws + WS_WOUTT);
        pg8::EpiScaleBf16 E{(bf16*)(ws + WS_MIXG), D, (const float*)(ws + WS_MOD) + 2048, 6144};
        pg8::gemm_phase<pg8::EpiScaleBf16, pg8::PlainOrder, false>(F.lds + RING_OFF, D, S, E, nullptr);
        if (args.sub != 2) wgu_copy(args, F);
    } SEAM(6);
    if (IN(7)) { REFRESH(); phase7(args, F); } SEAM(7);
    if (IN(8)) { REFRESH(); phase8(args, F); } SEAM(8);
    if (IN(9)) { REFRESH();
        const LAS int* ptile = moe_tiles(F);
        pg8::MoeOrder S{ptile[32], 8, F.G, F.bx, (const char*)(ws + WS_H), (const char*)(ws + WS_WGUT), (size_t)256 * D, (size_t)2048 * D, ptile, true};
        pg8::EpiSwiglu E{ws + WS_ACT, (const float*)(ws + WS_BGU), 1.f / WQ_SCALE};
        pg8::gemm_phase<pg8::EpiSwiglu, pg8::MoeOrder, true, true>(F.lds + RING_OFF, D, S, E, (const int*)(ws + WS_ROWTOK));
    } SEAM(9);
    if (IN(10)) { REFRESH();
        const LAS int* ptile = moe_tiles(F);
        pg8::MoeOrder S{ptile[32], 4, F.G, F.bx, (const char*)(ws + WS_ACT), (const char*)(ws + WS_WDT), (size_t)256 * DFF, (size_t)D * DFF, ptile, true};
        pg8::EpiOut<true, true> E{(bf16*)(ws + WS_OUTROWS), D, args.in[I_BD], D, 1.f / WQ_SCALE};
        pg8::gemm_phase<pg8::EpiOut<true, true>, pg8::MoeOrder, true, true>(F.lds + RING_OFF, DFF, S, E, (const int*)(ws + WS_IDENT));
    } SEAM(10);
    if (IN(11)) { REFRESH(); phase11(args, F); }
#undef IN
#undef SEAM
}

extern "C" void kernel_launch(void* const* d_in, const int* in_sizes, int n_in, void* d_out, int out_size, void* d_ws, size_t ws_size, hipStream_t stream) {
    static int grid = 0;
    if (grid == 0) {
        if (n_in != 26 || in_sizes[0] != NTOK * D || out_size != NTOK * D || ws_size < WS_END) { fprintf(stderr, "kernel_launch: unexpected shapes (n_in %d, ws %zu); nothing launched\n", n_in, ws_size); grid = -1; return; }
        int dev = 0, cus = 0, per_cu = 0;
        if (hipGetDevice(&dev) != hipSuccess || hipDeviceGetAttribute(&cus, hipDeviceAttributeMultiprocessorCount, dev) != hipSuccess) { grid = -1; return; }
        if (hipFuncSetAttribute((const void*)hybrid_fwd, hipFuncAttributeMaxDynamicSharedMemorySize, LDS_BYTES) != hipSuccess) { grid = -1; return; }
        if (hipOccupancyMaxActiveBlocksPerMultiprocessor(&per_cu, (const void*)hybrid_fwd, NWAVES * 64, LDS_BYTES) != hipSuccess || per_cu < 1) { fprintf(stderr, "kernel_launch: occupancy query says %d\n", per_cu); }
        (void)hipGetLastError();
        grid = cus;
        if (NTOK % (4 * grid * NWAVES) != 0 || grid % 8 != 0) { fprintf(stderr, "kernel_launch: grid %d does not divide the row batches; nothing launched\n", grid); grid = -1; return; }
    }
    if (grid < 0) return;
    if (hipMemsetAsync((char*)d_ws + WS_CTL, 0, CTL_ZERO_BYTES, stream) != hipSuccess) return;
    Args a{};
    for (int i = 0; i < 26; ++i) a.in[i] = (const float*)d_in[i];
    a.out = (float*)d_out; a.ws = (unsigned char*)d_ws;
    for (int li = 0; li < N_LAUNCHES; ++li) {
        a.ph_lo = (N_LAUNCHES == 1) ? 0 : li; a.ph_hi = (N_LAUNCHES == 1) ? NPHASE : li + 1;
        for (int rep = 0; rep < 1 + ((N_LAUNCHES == 1) ? 0 : ((RPT_MASK >> li) & 1)); ++rep) {
            a.sub = rep ? RPT_SUB : 0;
            hipLaunchKernelGGL(hybrid_fwd, dim3(grid), dim3(NWAVES * 64), LDS_BYTES, stream, a); }
    }
}
```

```cpp
#include <hip/hip_runtime.h>
#include <cstdio>
#include <cstdint>
#include <cmath>

#define LAS __attribute__((address_space(3)))
#define GAS __attribute__((address_space(1)))
typedef unsigned short bf16;
typedef short bf16x8 __attribute__((ext_vector_type(8)));
typedef short s16x4 __attribute__((ext_vector_type(4)));
typedef float f32x2 __attribute__((ext_vector_type(2)));
typedef float f32x4 __attribute__((ext_vector_type(4)));
typedef float f32x16 __attribute__((ext_vector_type(16)));
typedef unsigned u32x2 __attribute__((ext_vector_type(2)));
typedef unsigned u32x4 __attribute__((ext_vector_type(4)));
typedef __bf16 bf16x2_t __attribute__((ext_vector_type(2)));
typedef int i32x4 __attribute__((ext_vector_type(4)));
typedef int i32x8 __attribute__((ext_vector_type(8)));

constexpr int D = 1024, BATCH = 16, SEQ = 4096, NTOK = BATCH * SEQ;
constexpr int NP = 3072;
constexpr int P_MQ = 0, P_MK = 256, P_MV = 512, P_MO = 1024, P_AQ = 1536, P_AK = 2048, P_AV = 2560;
constexpr int IN_W = 3080;
constexpr int NE = 32, DFF = 1024, NSLOT = NTOK * 4;
constexpr int CHUNK = 64, NCH = SEQ / CHUNK, NUNIT = BATCH * 4 * NCH;
constexpr float EPS = 1e-6f;
constexpr int MAXTILES = 1056;

constexpr size_t MiB = 1u << 20;
constexpr size_t WS_CTL = 0, CTL_ZERO_BYTES = 65536;
constexpr size_t WS_MOD = 1 * MiB, WS_ROPE = 2 * MiB, WS_WG = 3 * MiB, WS_WRT = 3 * MiB + 65536, WS_BGU = 3 * MiB + 262144, WS_GTAB = 3 * MiB + 524288;
constexpr size_t WS_GATES = 4 * MiB, WS_WINT = 6 * MiB, WS_WOUTT = 12 * MiB;
constexpr size_t WS_ML = 14 * MiB, WS_BL = 14 * MiB + 65536, WS_MPREV = 14 * MiB + 131072, WS_NL = 15 * MiB, WS_NPREV = 16 * MiB;
constexpr size_t WS_META = 17 * MiB, WS_GATEW = 18 * MiB, WS_POS = 19 * MiB, WS_ROWTOK = 20 * MiB, WS_WGBASE = 22 * MiB, WS_IDENT = 22 * MiB + 65536;
constexpr size_t WS_H = 24 * MiB;
constexpr size_t WS_P = 152 * MiB;
constexpr size_t WS_CL = 536 * MiB, WS_CPREV = 600 * MiB, WS_O = 664 * MiB;
constexpr size_t WS_WGUT = 832 * MiB;
constexpr size_t WS_ACT = 288 * MiB;
constexpr size_t WS_OUTROWS = 24 * MiB;
constexpr size_t WS_WDT = 792 * MiB;
constexpr size_t WS_MIXG = 896 * MiB;
constexpr size_t WS_P8 = 896 * MiB;
constexpr size_t WS_ROWTOKS = 560 * MiB;
constexpr float MIX_SCALE = 16.f;
constexpr size_t WS_END = 1024 * MiB;
static_assert(WS_OUTROWS + (size_t)MAXTILES * 256 * 1024 <= WS_ACT && WS_ACT + (size_t)MAXTILES * 256 * 1024 <= WS_WDT && WS_O + (size_t)65536 * 2048 <= WS_WDT && WS_WDT + 32 * MiB <= WS_WGUT && WS_WGUT + 64 * MiB <= WS_MIXG, "ws map");
constexpr int CW_TMO = 0, CW_BAR = 4096, CW_GCNT = 8192;
static_assert((CW_GCNT + 64) * 4 <= (int)CTL_ZERO_BYTES && (CW_BAR + 3456) <= CW_GCNT, "control words inside the per-call memset");

constexpr int RING_OFF = 0, RING_BYTES = 131072;
constexpr int LDSCTL_OFF = RING_BYTES;
constexpr int MISC_OFF = LDSCTL_OFF + 320;
constexpr int TAB_OFF = LDSCTL_OFF + 1024;
constexpr int LDS_BYTES = 147456;
constexpr int NWAVES = 8;

__device__ __forceinline__ float bf2f(unsigned h) { return __uint_as_float(h << 16); }
__device__ __forceinline__ unsigned pk2(float lo, float hi) { f32x2 v = {lo, hi}; bf16x2_t b = __builtin_convertvector(v, bf16x2_t); return __builtin_bit_cast(unsigned, b); }
__device__ __forceinline__ bf16 f2bf(float f) { return (bf16)(pk2(f, 0.f) & 0xffffu); }
__device__ __forceinline__ unsigned pk4_fp8(float a, float b, float c, float d) { int p = __builtin_amdgcn_cvt_pk_fp8_f32(a, b, 0, false); return (unsigned)__builtin_amdgcn_cvt_pk_fp8_f32(c, d, p, true); }
#define DPP_STEP(T2I, I2T, OP, x, idn, ctrl, rmask) OP(x, I2T(__builtin_amdgcn_update_dpp(T2I(idn), T2I(x), ctrl, rmask, 0xF, false)))
#define DPP_REDUCE(T2I, I2T, OP, x, idn) do { x = DPP_STEP(T2I, I2T, OP, x, idn, 0x111, 0xF); x = DPP_STEP(T2I, I2T, OP, x, idn, 0x112, 0xF); x = DPP_STEP(T2I, I2T, OP, x, idn, 0x114, 0xF); \
    x = DPP_STEP(T2I, I2T, OP, x, idn, 0x118, 0xF); x = DPP_STEP(T2I, I2T, OP, x, idn, 0x142, 0xA); x = DPP_STEP(T2I, I2T, OP, x, idn, 0x143, 0xC); } while (0)
#define OP_ADDF(a, b) ((a) + (b))
#define OP_MAXF(a, b) fmaxf((a), (b))
#define OP_MINI(a, b) ((b) < (a) ? (b) : (a))
#define ID_I(x) (x)
__device__ __forceinline__ float wave_sum(float v) { DPP_REDUCE(__float_as_int, __int_as_float, OP_ADDF, v, 0.f); return __int_as_float(__builtin_amdgcn_readlane(__float_as_int(v), 63)); }
__device__ __forceinline__ float wave_max(float v) {
#pragma unroll
    for (int o = 1; o < 64; o <<= 1) v = fmaxf(v, __shfl_xor(v, o));
    return v;
}
__device__ __forceinline__ int wave_min_i(int v) {
#pragma unroll
    for (int o = 1; o < 64; o <<= 1) { int t = __shfl_xor(v, o); v = t < v ? t : v; }
    return v;
}
__device__ __forceinline__ float half_sum32(float v) {
#pragma unroll
    for (int o = 1; o < 32; o <<= 1) v += __shfl_xor(v, o);
    return v;
}
__device__ __forceinline__ float rcp_(float x) { return __builtin_amdgcn_rcpf(x); }
__device__ __forceinline__ float rsq_(float x) { return __builtin_amdgcn_rsqf(x); }
__device__ __forceinline__ float sigmoidf_(float z) { return rcp_(1.f + __expf(-z)); }
#define LDS_WAIT() asm volatile("s_waitcnt lgkmcnt(0)" ::: "memory")
#define VM_WAIT() asm volatile("s_waitcnt vmcnt(0)" ::: "memory")

namespace pg8 {
#define PG8_LAS __attribute__((address_space(3)))
constexpr int BM = 256, BK = 64, HALF = 128, HTB = HALF * BK * 2, STAGE_BYTES = 8 * HTB, NXCD = 8, WGM = 8;
__host__ __device__ __forceinline__ int lds_byte(int r, int c) { const int st = (r >> 4) * 2 + (c >> 5), rr = r & 15, cc = c & 31, ob = rr * 64 + cc * 2; return st * 1024 + (ob ^ (((ob >> 9) & 1) << 5)); }
__host__ __device__ __forceinline__ void stage_rc(int b, int& R, int& C) { const int st = b / 1024, sb = b % 1024, swz = sb ^ (((sb >> 9) & 1) << 5); R = (st >> 1) * 16 + swz / 64; C = (st & 1) * 32 + (swz % 64) / 2; }
__host__ __device__ __forceinline__ int perm32(int rho) { const int n = rho >> 4, i = rho & 15; return 8 * (i >> 2) + 4 * n + (i & 3); }

struct Unit { int pm, pn, e; const char* a; const char* b; };

__device__ __forceinline__ bool tile_of(long L, int nM, int nN, int& pm, int& pn) {
    const int nwg = nM * nN; if (L >= nwg) return false;
    int wgid = (int)L; { const int q = nwg / NXCD, r = nwg % NXCD, xcd = wgid % NXCD, off = wgid / NXCD; wgid = (xcd < r ? xcd * (q + 1) : r * (q + 1) + (xcd - r) * q) + off; }
    const int nig = WGM * nN, gid = (int)(((float)wgid + 0.5f) * __builtin_amdgcn_rcpf((float)nig)), t = wgid - gid * nig, fm = gid * WGM, gsz = (nM - fm) < WGM ? (nM - fm) : WGM;
    if (gsz == WGM) { pm = fm + (t & (WGM - 1)); pn = t / WGM; } else { pm = fm + (t % gsz); pn = t / gsz; }
    return true;
}
struct PlainOrder {
    int nM, nN, G, c; const char* A; const char* Bt; size_t tstep; bool gather;
    __device__ __forceinline__ void init(int M, int N, int K, int G_, int c_, const void* A_, const void* Bt_, int esz = 2, bool gather_ = false) { nM = M / BM; nN = N / BM; G = G_; c = c_; A = (const char*)A_; Bt = (const char*)Bt_; tstep = (size_t)BM * K * esz; gather = gather_; }
    __device__ __forceinline__ bool next(int i, Unit& u) const {
        if (!tile_of((long)i * G + c, nM, nN, u.pm, u.pn)) return false;
        u.e = 0; u.a = gather ? A : A + (size_t)u.pm * tstep; u.b = Bt + (size_t)u.pn * tstep; return true;
    }
    __device__ __forceinline__ int rowoff(const Unit& u) const { return u.pm * BM; }
    __device__ __forceinline__ int nvalid(const Unit&) const { return BM; }
};
struct MoeOrder {
    int nM, nN, G, c; const char* A0; const char* Bt; size_t tstep, estride; const LAS int* ptile; bool gather; const LAS int* cnt; bool sparse;
    __device__ __forceinline__ bool next(int i, Unit& u) const {
        if (!tile_of((long)i * G + c, nM, nN, u.pm, u.pn)) return false;
        const int e = (int)((const LAS unsigned char*)ptile)[640 + u.pm];
        u.e = e; u.b = Bt + (size_t)e * estride + (size_t)u.pn * tstep;
        u.a = gather ? A0 : A0 + (size_t)u.pm * tstep;
        return true;
    }
    __device__ __forceinline__ int rowoff(const Unit& u) const { return sparse ? u.e * 65536 + (u.pm - ptile[u.e]) * BM : u.pm * BM; }
    __device__ __forceinline__ int nvalid(const Unit& u) const { const int left = cnt[u.e] - (u.pm - ptile[u.e]) * BM; return sparse ? (left < BM ? left : BM) : BM; }
};

template <bool OUT8, bool HASB, int PN8LO = 0, int PN8HI = 0, long long O8OFF = 0>
struct EpiOut {
    static constexpr bool HAS_VEC = HASB, ACC_BIAS = false, HAS_BMODE = false;
    bf16* O; int ldc; const float* bias; int bstride; float ascale;
    __device__ __forceinline__ const float* vec_ptr(const Unit& u) const { return bias + (size_t)u.e * bstride + u.pn * BM; }
    __device__ __forceinline__ void operator()(const f32x4 (&acc)[2][2][4][2], const Unit& u, int wr, int wc, int fr, int fq, const PG8_LAS float* vl) const {
        asm volatile("" : "+v"(fr), "+v"(fq));
        const int row0 = u.pm * BM + wr * 64 + fr, col0 = u.pn * BM + wc * 64 + 16 * fq;
        f32x4 bv[2][2];
#pragma unroll
        for (int bj = 0; bj < 2; ++bj)
#pragma unroll
            for (int n = 0; n < 2; ++n) bv[bj][n] = HASB ? *(const PG8_LAS f32x4*)(vl + wc * 64 + 16 * fq + 8 * bj + 4 * n) : (f32x4){0.f, 0.f, 0.f, 0.f};
        const bool f8 = !OUT8 && u.pn >= PN8LO && u.pn < PN8HI;
        if (f8) {
            unsigned char* o8 = (unsigned char*)O + O8OFF + (size_t)row0 * 1024 + (u.pn - PN8LO) * BM + wc * 64 + 16 * fq;
#pragma unroll
            for (int ai = 0; ai < 2; ++ai)
#pragma unroll
                for (int m = 0; m < 4; ++m) {
                    const f32x4 v00 = acc[ai][0][m][0] * ascale, v01 = acc[ai][0][m][1] * ascale, v10 = acc[ai][1][m][0] * ascale, v11 = acc[ai][1][m][1] * ascale;
                    *(u32x4*)(o8 + (size_t)(ai * HALF + m * 16) * 1024) = (u32x4){pk4_fp8(v00[0], v00[1], v00[2], v00[3]), pk4_fp8(v01[0], v01[1], v01[2], v01[3]), pk4_fp8(v10[0], v10[1], v10[2], v10[3]), pk4_fp8(v11[0], v11[1], v11[2], v11[3])}; }
        } else {
#pragma unroll
        for (int ai = 0; ai < 2; ++ai)
#pragma unroll
            for (int m = 0; m < 4; ++m) { bf16* rowp = O + (size_t)(row0 + ai * HALF + m * 16) * ldc + col0;
                const f32x4 v00 = acc[ai][0][m][0] * ascale + bv[0][0], v01 = acc[ai][0][m][1] * ascale + bv[0][1], v10 = acc[ai][1][m][0] * ascale + bv[1][0], v11 = acc[ai][1][m][1] * ascale + bv[1][1];
                if constexpr (OUT8) { *(u32x4*)((unsigned char*)O + (size_t)(row0 + ai * HALF + m * 16) * ldc + col0) = (u32x4){pk4_fp8(v00[0], v00[1], v00[2], v00[3]), pk4_fp8(v01[0], v01[1], v01[2], v01[3]), pk4_fp8(v10[0], v10[1], v10[2], v10[3]), pk4_fp8(v11[0], v11[1], v11[2], v11[3])}; }
                else { *(u32x4*)rowp = (u32x4){pk2(v00[0], v00[1]), pk2(v00[2], v00[3]), pk2(v01[0], v01[1]), pk2(v01[2], v01[3])};
                    *(u32x4*)(rowp + 8) = (u32x4){pk2(v10[0], v10[1]), pk2(v10[2], v10[3]), pk2(v11[0], v11[1]), pk2(v11[2], v11[3])}; } }
        }
    }
};
typedef EpiOut<false, false> EpiBf16;

template <long long P8OFF, long long ROPEOFF, long long GTABOFF>
struct EpiInproj {
    static constexpr bool HAS_VEC = true, ACC_BIAS = false, HAS_BMODE = true;
    bf16* O; int ldc;
    __device__ __forceinline__ int bmode(const Unit& u) const { return (u.pn >= 6 && u.pn < 10) ? 1 : 0; }
    __device__ __forceinline__ const float* vec_ptr(const Unit& u) const { return (const float*)((const char*)O + GTABOFF) + u.pn * BM; }
    __device__ __forceinline__ void operator()(const f32x4 (&acc)[2][2][4][2], const Unit& u, int wr, int wc, int fr, int fq, const PG8_LAS float* vl) const {
        asm volatile("" : "+v"(fr), "+v"(fq));
        const int row0 = u.pm * BM + wr * 64 + fr;
        if (u.pn >= 2 && u.pn < 6) {
            unsigned char* o8 = (unsigned char*)O + P8OFF + (size_t)row0 * 1024 + (u.pn - 2) * BM + wc * 64 + 16 * fq;
#pragma unroll
            for (int ai = 0; ai < 2; ++ai)
#pragma unroll
                for (int m = 0; m < 4; ++m) {
                    const f32x4 v00 = acc[ai][0][m][0], v01 = acc[ai][0][m][1], v10 = acc[ai][1][m][0], v11 = acc[ai][1][m][1];
                    *(u32x4*)(o8 + (size_t)(ai * HALF + m * 16) * 1024) = (u32x4){pk4_fp8(v00[0], v00[1], v00[2], v00[3]), pk4_fp8(v01[0], v01[1], v01[2], v01[3]), pk4_fp8(v10[0], v10[1], v10[2], v10[3]), pk4_fp8(v11[0], v11[1], v11[2], v11[3])}; }
        } else if (u.pn >= 6 && u.pn < 10) {
            const PG8_LAS float* gl = vl + wc * 64 + 16 * fq;
            const f32x4 g1a = *(const PG8_LAS f32x4*)(gl), g1b = *(const PG8_LAS f32x4*)(gl + 4), g2a = *(const PG8_LAS f32x4*)(gl + 8), g2b = *(const PG8_LAS f32x4*)(gl + 12);
            const float g1[8] = {g1a.x, g1a.y, g1a.z, g1a.w, g1b.x, g1b.y, g1b.z, g1b.w}, g2[8] = {g2a.x, g2a.y, g2a.z, g2a.w, g2b.x, g2b.y, g2b.z, g2b.w};
            const float* tab0 = (const float*)((const char*)O + ROPEOFF) + ((size_t)(row0 & (SEQ - 1)) * 32 + 8 * fq) * 2;
            bf16* orow = O + (size_t)row0 * ldc + u.pn * BM + wc * 64 + 8 * fq;
            f32x4 ta[4], tb[4];
#define EI_LOAD(t, g) do { const float* tp = tab0 + (size_t)((((g) >> 2) * HALF + ((g) & 3) * 16)) * 64; _Pragma("unroll") for (int q = 0; q < 4; ++q) t[q] = *(const f32x4*)(tp + 4 * q); } while (0)
#define EI_COMP(t, g) do { const int ai = (g) >> 2, m = (g) & 3; \
                float x1[8], x2[8]; float ss = 0.f; \
                _Pragma("unroll") for (int j = 0; j < 8; ++j) { x1[j] = acc[ai][0][m][j >> 2][j & 3]; x2[j] = acc[ai][1][m][j >> 2][j & 3]; ss += x1[j] * x1[j] + x2[j] * x2[j]; } \
                ss += __shfl_xor(ss, 16); ss += __shfl_xor(ss, 32); \
                const float rs = rsq_(ss * (1.f / 64.f) + EPS); \
                float o1[8], o2[8]; \
                _Pragma("unroll") for (int q = 0; q < 4; ++q) { \
                    { const int j = 2 * q; const float c = t[q].x, sn = t[q].y, y1 = x1[j] * rs * g1[j], y2 = x2[j] * rs * g2[j]; o1[j] = y1 * c - y2 * sn; o2[j] = y2 * c + y1 * sn; } \
                    { const int j = 2 * q + 1; const float c = t[q].z, sn = t[q].w, y1 = x1[j] * rs * g1[j], y2 = x2[j] * rs * g2[j]; o1[j] = y1 * c - y2 * sn; o2[j] = y2 * c + y1 * sn; } } \
                bf16* op = orow + (size_t)(ai * HALF + m * 16) * ldc; \
                *(u32x4*)op = (u32x4){pk2(o1[0], o1[1]), pk2(o1[2], o1[3]), pk2(o1[4], o1[5]), pk2(o1[6], o1[7])}; \
                *(u32x4*)(op + 32) = (u32x4){pk2(o2[0], o2[1]), pk2(o2[2], o2[3]), pk2(o2[4], o2[5]), pk2(o2[6], o2[7])}; } while (0)
            EI_LOAD(ta, 0);
            EI_LOAD(tb, 1); EI_COMP(ta, 0);
            EI_LOAD(ta, 2); EI_COMP(tb, 1);
            EI_LOAD(tb, 3); EI_COMP(ta, 2);
            EI_LOAD(ta, 4); EI_COMP(tb, 3);
            EI_LOAD(tb, 5); EI_COMP(ta, 4);
            EI_LOAD(ta, 6); EI_COMP(tb, 5);
            EI_LOAD(tb, 7); EI_COMP(ta, 6);
            EI_COMP(tb, 7);
#undef EI_LOAD
#undef EI_COMP
        } else {
            bf16* orow = O + (size_t)row0 * ldc + u.pn * BM + wc * 64 + 16 * fq;
#pragma unroll
            for (int ai = 0; ai < 2; ++ai)
#pragma unroll
                for (int m = 0; m < 4; ++m) { bf16* rowp = orow + (size_t)(ai * HALF + m * 16) * ldc;
                    const f32x4 v00 = acc[ai][0][m][0], v01 = acc[ai][0][m][1], v10 = acc[ai][1][m][0], v11 = acc[ai][1][m][1];
                    *(u32x4*)rowp = (u32x4){pk2(v00[0], v00[1]), pk2(v00[2], v00[3]), pk2(v01[0], v01[1]), pk2(v01[2], v01[3])};
                    *(u32x4*)(rowp + 8) = (u32x4){pk2(v10[0], v10[1]), pk2(v10[2], v10[3]), pk2(v11[0], v11[1]), pk2(v11[2], v11[3])}; }
        }
    }
};
template <bool OUT8>
struct EpiScale {
    static constexpr bool HAS_VEC = true, ACC_BIAS = false, HAS_BMODE = false;
    bf16* O; int ldc; const float* scale; int spitch; float ascale;
    __device__ __forceinline__ const float* vec_ptr(const Unit& u) const { return scale + (size_t)((u.pm * BM) / SEQ) * spitch + u.pn * BM; }
    __device__ __forceinline__ void operator()(const f32x4 (&acc)[2][2][4][2], const Unit& u, int wr, int wc, int fr, int fq, const PG8_LAS float* vl) const {
        asm volatile("" : "+v"(fr), "+v"(fq));
        const int row0 = u.pm * BM + wr * 64 + fr, col0 = u.pn * BM + wc * 64 + 16 * fq;
        f32x4 sv[2][2];
#pragma unroll
        for (int bj = 0; bj < 2; ++bj)
#pragma unroll
            for (int n = 0; n < 2; ++n) sv[bj][n] = *(const PG8_LAS f32x4*)(vl + wc * 64 + 16 * fq + 8 * bj + 4 * n) * ascale;
#pragma unroll
        for (int ai = 0; ai < 2; ++ai)
#pragma unroll
            for (int m = 0; m < 4; ++m) { bf16* rowp = O + (size_t)(row0 + ai * HALF + m * 16) * ldc + col0;
                if constexpr (OUT8) { const f32x4 v00 = acc[ai][0][m][0] * sv[0][0], v01 = acc[ai][0][m][1] * sv[0][1], v10 = acc[ai][1][m][0] * sv[1][0], v11 = acc[ai][1][m][1] * sv[1][1];
                    *(u32x4*)((unsigned char*)O + (size_t)(row0 + ai * HALF + m * 16) * ldc + col0) = (u32x4){pk4_fp8(v00[0], v00[1], v00[2], v00[3]), pk4_fp8(v01[0], v01[1], v01[2], v01[3]), pk4_fp8(v10[0], v10[1], v10[2], v10[3]), pk4_fp8(v11[0], v11[1], v11[2], v11[3])}; }
                else {
#pragma unroll
                for (int bj = 0; bj < 2; ++bj) { const f32x4 v0 = acc[ai][bj][m][0] * sv[bj][0], v1 = acc[ai][bj][m][1] * sv[bj][1];
                    u32x4 w; w.x = pk2(v0[0], v0[1]); w.y = pk2(v0[2], v0[3]); w.z = pk2(v1[0], v1[1]); w.w = pk2(v1[2], v1[3]);
                    *(u32x4*)(rowp + 8 * bj) = w; } } }
    }
};
typedef EpiScale<false> EpiScaleBf16;
struct EpiSwiglu {
    static constexpr bool HAS_VEC = false, ACC_BIAS = true, HAS_BMODE = false;
    unsigned char* O; const float* bias; float ascale;
    __device__ __forceinline__ const float* vec_ptr(const Unit& u) const { return bias + (size_t)u.e * 2048 + u.pn * BM; }
    __device__ __forceinline__ void acc_init(f32x4 (&acc)[2][2][4][2], const PG8_LAS float* vl, int wc, int fq) const {
        int q_ = fq; asm volatile("" : "+v"(q_));
        const PG8_LAS float* bp = vl + wc * 64 + 16 * q_;
        const float inv = 1.f / ascale;
#pragma unroll
        for (int b = 0; b < 2; ++b)
#pragma unroll
            for (int n = 0; n < 2; ++n) { const f32x4 v = *(const PG8_LAS f32x4*)(bp + 8 * b + 4 * n) * inv;
#pragma unroll
                for (int a = 0; a < 2; ++a)
#pragma unroll
                    for (int m = 0; m < 4; ++m) acc[a][b][m][n] = v; }
    }
    __device__ __forceinline__ void operator()(const f32x4 (&acc)[2][2][4][2], const Unit& u, int wr, int wc, int fr, int fq, const PG8_LAS float* vl) const {
        (void)vl;
        asm volatile("" : "+v"(fr), "+v"(fq));
        unsigned char* base = O + (size_t)u.pm * BM * DFF;
        const int row0 = wr * 64 + fr, cin = wc * 32 + 8 * fq;
        const float sc = ascale, lim = 7.f / sc, glo = -50.f / sc, s2 = sc * sc, kk = sc * (-1.702f * 1.4426950408889634f);
#pragma unroll
        for (int ai = 0; ai < 2; ++ai)
#pragma unroll
            for (int m = 0; m < 4; ++m) {
                float o[8];
#pragma unroll
                for (int n = 0; n < 2; ++n) { const f32x4 g4 = acc[ai][0][m][n], u4 = acc[ai][1][m][n];
#pragma unroll
                    for (int p = 0; p < 2; ++p) {
                        f32x2 g, up; g.x = __builtin_amdgcn_fmed3f(g4[2 * p], glo, lim); g.y = __builtin_amdgcn_fmed3f(g4[2 * p + 1], glo, lim);
                        up.x = __builtin_amdgcn_fmed3f(u4[2 * p], -lim, lim); up.y = __builtin_amdgcn_fmed3f(u4[2 * p + 1], -lim, lim);
                        const f32x2 t = g * kk;
                        f32x2 e; e.x = __builtin_amdgcn_exp2f(t.x); e.y = __builtin_amdgcn_exp2f(t.y);
                        const f32x2 d = e + 1.f;
                        const float rp = __builtin_amdgcn_rcpf(d.x * d.y);
                        const f32x2 r = (f32x2){d.y, d.x} * rp;
                        const f32x2 a2 = (up * s2 + sc) * g * r;
                        o[4 * n + 2 * p] = a2.x; o[4 * n + 2 * p + 1] = a2.y; } }
                *(u32x2*)(base + (size_t)(row0 + ai * HALF + m * 16) * DFF + u.pn * HALF + cin) = (u32x2){pk4_fp8(o[0], o[1], o[2], o[3]), pk4_fp8(o[4], o[5], o[6], o[7])};
                __builtin_amdgcn_sched_barrier(0);
            }
    }
};

template <class Epi, class Sched, bool GATHER, bool FP8 = false>
__device__ __forceinline__ void gemm_phase(PG8_LAS unsigned char* lds, const int K, const Sched& S, const Epi& E, const int* rowtok) {
    int tid_ = threadIdx.x; asm volatile("" : "+v"(tid_));
    const int tid = tid_, wid = __builtin_amdgcn_readfirstlane(tid >> 6), lane = tid & 63, wr = wid >> 2, wc = wid & 3, fr = lane & 15, fq = lane >> 4;
    const int rowB = FP8 ? K : 2 * K;
    const int nt = rowB / (BK * 2);
    unsigned voffB[2];
#define PG8_SET_BPERM(mode) do { _Pragma("unroll") for (int i = 0; i < 2; ++i) { int R, C; stage_rc(tid * 16 + i * 8192, R, C); const int Rb = 64 * (R >> 5) + ((mode) ? 8 : 16) * ((R & 15) >> 2) + 4 * ((R >> 4) & 1) + (R & 3); voffB[i] = (unsigned)(Rb * rowB + C * 2); } \
        hstepB = (size_t)((mode) ? 32 : 8) * rowB; } while (0)
#pragma unroll
    for (int i = 0; i < 2; ++i) { int R, C; stage_rc(tid * 16 + i * 8192, R, C); const int Rb = 64 * (R >> 5) + 16 * ((R & 15) >> 2) + 4 * ((R >> 4) & 1) + (R & 3); voffB[i] = (unsigned)(Rb * rowB + C * 2); }
    const size_t kstep = (size_t)(BK * 2);
    const size_t hstep = (size_t)HALF * rowB; size_t hstepB = (size_t)8 * rowB;
    const unsigned ldsw = (unsigned)wid * 1024u;
    const int aoff = lds_byte(wr * 64 + fr, fq * 8), boff = lds_byte(wc * 32 + fr, fq * 8);
#define PG8_SA(b, h) (((b) * 2 + (h)) * HTB)
#define PG8_SB(b, h) ((4 + (b) * 2 + (h)) * HTB)
#define PG8_STAGE2(bufoff, gbase, o0, o1) do { \
        __builtin_amdgcn_global_load_lds((const unsigned*)((const char*)(gbase) + (o0)), (PG8_LAS unsigned*)(lds + (bufoff) + ldsw), 16, 0, 0); \
        __builtin_amdgcn_global_load_lds((const unsigned*)((const char*)(gbase) + (o1)), (PG8_LAS unsigned*)(lds + (bufoff) + ldsw + 8192), 16, 0, 0); } while (0)
#define PG8_STAGE_B(bufoff, gbase) PG8_STAGE2(bufoff, gbase, voffB[0], voffB[1])
#define PG8_CAT8(x0, x1) __builtin_shufflevector(x0, x1, 0, 1, 2, 3, 4, 5, 6, 7)
#define PG8_LDA(dst, b, h) do { _Pragma("unroll") for (int m = 0; m < 4; ++m) { \
        if constexpr (FP8) dst##8[m] = PG8_CAT8(*(const PG8_LAS i32x4*)(lds + PG8_SA(b, h) + aoff + m * 2048), *(const PG8_LAS i32x4*)(lds + PG8_SA(b, h) + aoff + m * 2048 + 1024)); \
        else { _Pragma("unroll") for (int k = 0; k < 2; ++k) dst[m][k] = *(const PG8_LAS bf16x8*)(lds + PG8_SA(b, h) + aoff + m * 2048 + k * 1024); } } } while (0)
#define PG8_LDB(dst, b, h) do { _Pragma("unroll") for (int n = 0; n < 2; ++n) { \
        if constexpr (FP8) dst##8[n] = PG8_CAT8(*(const PG8_LAS i32x4*)(lds + PG8_SB(b, h) + boff + n * 2048), *(const PG8_LAS i32x4*)(lds + PG8_SB(b, h) + boff + n * 2048 + 1024)); \
        else { _Pragma("unroll") for (int k = 0; k < 2; ++k) dst[n][k] = *(const PG8_LAS bf16x8*)(lds + PG8_SB(b, h) + boff + n * 2048 + k * 1024); } } } while (0)
#define PG8_MMA(ai, bj, At, Bt) do { __builtin_amdgcn_s_setprio(1); _Pragma("unroll") for (int m = 0; m < 4; ++m) _Pragma("unroll") for (int n = 0; n < 2; ++n) { \
        if constexpr (FP8) acc[ai][bj][m][n] = __builtin_amdgcn_mfma_scale_f32_16x16x128_f8f6f4(Bt##8[n], At##8[m], acc[ai][bj][m][n], 0, 0, 0, 0x7F7F7F7F, 0, 0x7F7F7F7F); \
        else { _Pragma("unroll") for (int k = 0; k < 2; ++k) acc[ai][bj][m][n] = __builtin_amdgcn_mfma_f32_16x16x32_bf16(Bt[n][k], At[m][k], acc[ai][bj][m][n], 0, 0, 0); } } \
        __builtin_amdgcn_s_setprio(0); } while (0)
#define PG8_WAIT_V(n) asm volatile("s_waitcnt vmcnt(" #n ")" ::: "memory")
#define PG8_WAIT_L(n) asm volatile("s_waitcnt lgkmcnt(" #n ")" ::: "memory")
#define PG8_BAR __builtin_amdgcn_s_barrier()
#define PG8_SCHED __builtin_amdgcn_sched_barrier(0)
#define PG8_SETOFF(v, u) do { _Pragma("unroll") for (int h_ = 0; h_ < 2; ++h_) _Pragma("unroll") for (int i_ = 0; i_ < 2; ++i_) { int R_, C_; stage_rc(tid * 16 + i_ * 8192, R_, C_); \
        if constexpr (GATHER) { unsigned tok_ = (unsigned)rowtok[S.rowoff(u) + h_ * HALF + R_]; tok_ = (h_ * HALF + R_ < S.nvalid(u)) ? tok_ : 0u; v[h_][i_] = tok_ * (unsigned)rowB + (unsigned)(C_ * 2); } \
        else v[h_][i_] = (unsigned)(R_ * rowB + C_ * 2) + (unsigned)(h_ * hstep); } } while (0)
    Unit cur, nxt; int ui = 0;
    if (!S.next(0, cur)) return;
    if constexpr (Epi::HAS_BMODE) PG8_SET_BPERM(E.bmode(cur));
    f32x4 acc[2][2][4][2];
#pragma unroll
    for (int a = 0; a < 2; ++a)
#pragma unroll
        for (int b = 0; b < 2; ++b)
#pragma unroll
            for (int m = 0; m < 4; ++m)
#pragma unroll
                for (int n = 0; n < 2; ++n) acc[a][b][m][n] = (f32x4){0.f, 0.f, 0.f, 0.f};
    bf16x8 At[4][2], B0[2][2], B1[2][2];
    i32x8 At8[4], B08[2], B18[2];
    unsigned vA[2][2];
    PG8_SETOFF(vA, cur);
    PG8_LAS float* vecbuf = (PG8_LAS float*)(lds + STAGE_BYTES + 4096 + 2048);
    PG8_LAS int* tokbuf = (PG8_LAS int*)(lds + STAGE_BYTES + 4096);
    const char* cA = cur.a; const char* cB = cur.b;
    if constexpr (Epi::ACC_BIAS) { if (wid == 0) __builtin_amdgcn_global_load_lds((const unsigned*)(E.vec_ptr(cur) + lane * 4), (PG8_LAS unsigned*)vecbuf, 16, 0, 0); }
    PG8_STAGE_B(PG8_SB(0, 0), cB); PG8_STAGE_B(PG8_SB(0, 1), cB + hstepB); PG8_STAGE2(PG8_SA(0, 0), cA, vA[0][0], vA[0][1]); PG8_STAGE2(PG8_SA(0, 1), cA, vA[1][0], vA[1][1]);
    if (wr == 1) PG8_BAR;
    PG8_WAIT_V(2); PG8_BAR;
    PG8_STAGE_B(PG8_SB(1, 0), cB + kstep); PG8_STAGE2(PG8_SA(1, 0), cA + kstep, vA[0][0], vA[0][1]); PG8_STAGE_B(PG8_SB(1, 1), cB + hstepB + kstep);
    PG8_WAIT_V(6); PG8_BAR;
    if constexpr (Epi::ACC_BIAS) E.acc_init(acc, vecbuf, wc, fq);
    for (;;) {
        const bool has_next = S.next(ui + 1, nxt);
        if constexpr (GATHER) { if (has_next && wid == 0) {
#pragma unroll
                for (int j_ = 0; j_ < 4; ++j_) __builtin_amdgcn_global_load_lds((const unsigned*)(rowtok + S.rowoff(nxt) + j_ * 64 + lane), (PG8_LAS unsigned*)(tokbuf + ((ui + 1) & 1) * 256 + j_ * 64), 4, 0, 0); } }
        if constexpr (Epi::HAS_VEC) { if (wid == 0) __builtin_amdgcn_global_load_lds((const unsigned*)(E.vec_ptr(cur) + lane * 4), (PG8_LAS unsigned*)(vecbuf + (ui & 1) * 256), 16, 0, 0); }
        if constexpr (Epi::ACC_BIAS) { if (has_next && wid == 0) __builtin_amdgcn_global_load_lds((const unsigned*)(E.vec_ptr(nxt) + lane * 4), (PG8_LAS unsigned*)(vecbuf + ((ui + 1) & 1) * 256), 16, 0, 0); }
        const char* nA = has_next ? nxt.a : cA; const char* nB = has_next ? nxt.b : cB;
        if constexpr (!GATHER) asm volatile("" : "+v"(vA[0][0]), "+v"(vA[0][1]), "+v"(vA[1][0]), "+v"(vA[1][1]));
#pragma unroll 1
        for (int t = 0; t < nt; t += 2) {
            const bool last = (t == nt - 2);
            const char* a1 = cA + (size_t)(t + 1) * kstep;
            const char* a2 = last ? nA : cA + (size_t)(t + 2) * kstep; const char* b2 = last ? nB : cB + (size_t)(t + 2) * kstep;
            const char* a3 = a2 + kstep; const char* b3 = b2 + kstep;
            PG8_LDB(B0, 0, 0); PG8_LDB(B1, 0, 1); PG8_SCHED; PG8_LDA(At, 0, 0); PG8_STAGE2(PG8_SA(1, 1), a1, vA[1][0], vA[1][1]);
            if constexpr (Epi::HAS_BMODE) { if (last && has_next) PG8_SET_BPERM(E.bmode(nxt)); }
            if constexpr (GATHER) { if (last && has_next) {
                const int nvn_ = S.nvalid(nxt);
#pragma unroll
                for (int h_ = 0; h_ < 2; ++h_)
#pragma unroll
                    for (int i_ = 0; i_ < 2; ++i_) { int R_, C_; stage_rc(tid * 16 + i_ * 8192, R_, C_); unsigned tok_ = (unsigned)tokbuf[((ui + 1) & 1) * 256 + h_ * HALF + R_]; tok_ = (h_ * HALF + R_ < nvn_) ? tok_ : 0u;
                        vA[h_][i_] = tok_ * (unsigned)rowB + (unsigned)(C_ * 2); } } }
            PG8_WAIT_V(8); PG8_WAIT_L(0); PG8_BAR; PG8_MMA(0, 0, At, B0); PG8_MMA(0, 1, At, B1); PG8_BAR; PG8_SCHED;
            PG8_LDA(At, 0, 1); PG8_STAGE_B(PG8_SB(0, 0), b2); PG8_STAGE_B(PG8_SB(0, 1), b2 + hstepB); PG8_STAGE2(PG8_SA(0, 0), a2, vA[0][0], vA[0][1]);
            PG8_WAIT_V(8); PG8_WAIT_L(0); PG8_BAR; PG8_MMA(1, 0, At, B0); PG8_MMA(1, 1, At, B1); PG8_BAR; PG8_SCHED;
            PG8_LDB(B0, 1, 0); PG8_LDB(B1, 1, 1); PG8_SCHED; PG8_LDA(At, 1, 0); PG8_STAGE2(PG8_SA(0, 1), a2, vA[1][0], vA[1][1]);
            PG8_WAIT_V(8); PG8_WAIT_L(0); PG8_BAR; PG8_MMA(0, 0, At, B0); PG8_MMA(0, 1, At, B1); PG8_BAR; PG8_SCHED;
            PG8_LDA(At, 1, 1); PG8_STAGE_B(PG8_SB(1, 0), b3); PG8_STAGE_B(PG8_SB(1, 1), b3 + hstepB); PG8_STAGE2(PG8_SA(1, 0), a3, vA[0][0], vA[0][1]);
            PG8_WAIT_V(8); PG8_WAIT_L(0); PG8_BAR; PG8_MMA(1, 0, At, B0); PG8_MMA(1, 1, At, B1); PG8_BAR; PG8_SCHED;
        }
        if (wr == 0) PG8_BAR;
        E(acc, cur, wr, wc, fr, fq, vecbuf + (ui & 1) * 256);
        if (!has_next) break;
        if constexpr (Epi::ACC_BIAS) E.acc_init(acc, vecbuf + ((ui + 1) & 1) * 256, wc, fq);
        else {
#pragma unroll
        for (int a = 0; a < 2; ++a)
#pragma unroll
            for (int b = 0; b < 2; ++b)
#pragma unroll
                for (int m = 0; m < 4; ++m)
#pragma unroll
                    for (int n = 0; n < 2; ++n) acc[a][b][m][n] = (f32x4){0.f, 0.f, 0.f, 0.f};
        }
        cur = nxt; cA = nA; cB = nB; ++ui;
        if (wr == 1) PG8_BAR;
    }
    PG8_WAIT_V(0);
    PG8_BAR;
#undef PG8_SA
#undef PG8_SB
#undef PG8_STAGE2
#undef PG8_STAGE_B
#undef PG8_LDA
#undef PG8_LDB
#undef PG8_MMA
#undef PG8_CAT8
#undef PG8_WAIT_V
#undef PG8_WAIT_L
#undef PG8_BAR
#undef PG8_SCHED
#undef PG8_SETOFF
#undef PG8_SET_BPERM
}
}

#include <hip/hip_bf16.h>
namespace attn_body {
using bf16=__hip_bfloat16;
using bf16x8=__attribute__((ext_vector_type(8)))short;
using s16x4=__attribute__((ext_vector_type(4)))short;
using f32x16=__attribute__((ext_vector_type(16)))float;
using u32x4=__attribute__((ext_vector_type(4)))unsigned;
constexpr int SEQ=4096,D=64,PQ=3072,PO=1024;
constexpr int NW=8,QBLK=32,QB=QBLK*NW,KVBLK=64,NQB=SEQ/QB;
constexpr int ATTN_UNIT_ROWS=QB;
__device__ __forceinline__ int crow(int r,int hi){return (r&3)+8*(r>>2)+4*hi;}
#define SBAR() __builtin_amdgcn_sched_barrier(0)
__device__ __forceinline__ void cmask(f32x16&p0,f32x16&p1,int jb,int qrel,int hi){
  (void)hi; if(jb>(qrel>>6)){ const float NEG=-INFINITY;
    #pragma unroll
    for(int r=0;r<16;++r){p0[r]=NEG;p1[r]=NEG;} }
}

constexpr int NSLOT=3, SLOTB=8192, VSLOTB=2*SLOTB;
constexpr int LDS_K=0, LDS_V=NSLOT*SLOTB, LDS_WS=LDS_V+NSLOT*VSLOTB, LDS_OST=LDS_WS+NW*64*4, LDS_BYTES=LDS_OST+NW*4096;
constexpr float C2=0.125f*1.4426950408889634f;
__device__ __forceinline__ void glds16(const void*gsrc,unsigned lds_dst){unsigned keep;
  asm volatile("s_mov_b32 %0, m0\n\ts_mov_b32 m0, %2\n\ts_nop 0\n\tglobal_load_lds_dwordx4 %1, off\n\ts_mov_b32 m0, %0":"=&s"(keep):"v"(gsrc),"s"(lds_dst):"memory");}
__device__ __forceinline__ float max3f(float a,float b,float c){float r;asm("v_max3_f32 %0, %1, %2, %3":"=v"(r):"v"(a),"v"(b),"v"(c));return r;}
__device__ __forceinline__ float max2f(float a,float b){float r;asm("v_max_f32_e32 %0, %1, %2":"=v"(r):"v"(a),"v"(b));return r;}
__device__ __forceinline__ float fadd_s(float a,float b){float r;asm("v_add_f32_e32 %0, %1, %2":"=v"(r):"v"(a),"v"(b));return r;}
__device__ __forceinline__ float fsub_s(float a,float b){float r;asm("v_sub_f32_e32 %0, %1, %2":"=v"(r):"v"(a),"v"(b));return r;}
typedef float f32x2_t __attribute__((ext_vector_type(2))); typedef __bf16 bf16x2_t __attribute__((ext_vector_type(2)));
typedef int i32x4 __attribute__((ext_vector_type(4)));
typedef int i32x8 __attribute__((ext_vector_type(8)));
__device__ __forceinline__ unsigned cvtpk_s(float lo,float hi){f32x2_t v={lo,hi};bf16x2_t b=__builtin_convertvector(v,bf16x2_t);return __builtin_bit_cast(unsigned,b);}
#define WAIT_BAR(N) asm volatile("s_waitcnt vmcnt(" #N ") lgkmcnt(0)\n\ts_barrier":::"memory")

__device__ __forceinline__ void qkt(f32x16&p0,f32x16&p1,const char*Kslot,const bf16x8*qr,const f32x16&negm,int r32,int hi){
  const char*kb=Kslot+hi*1024+r32*16;
  #pragma unroll
  for(int d0=0;d0<4;++d0){
    const bf16x8 b0=*reinterpret_cast<const bf16x8*>(kb+d0*2048);
    const bf16x8 b1=*reinterpret_cast<const bf16x8*>(kb+d0*2048+512);
    if(d0==0){p0=__builtin_amdgcn_mfma_f32_32x32x16_bf16(b0,qr[0],negm,0,0,0);p1=__builtin_amdgcn_mfma_f32_32x32x16_bf16(b1,qr[0],negm,0,0,0);}
    else{p0=__builtin_amdgcn_mfma_f32_32x32x16_bf16(b0,qr[d0],p0,0,0,0);p1=__builtin_amdgcn_mfma_f32_32x32x16_bf16(b1,qr[d0],p1,0,0,0);}}
}
typedef __attribute__((address_space(3))) const char* lds_cptr;
typedef short v4i16_t __attribute__((ext_vector_type(4)));
__device__ __forceinline__ void kload8(bf16x8*kf,lds_cptr kp){
  kf[0]=*(const __attribute__((address_space(3))) bf16x8*)(kp);      kf[1]=*(const __attribute__((address_space(3))) bf16x8*)(kp+512);
  kf[2]=*(const __attribute__((address_space(3))) bf16x8*)(kp+2048); kf[3]=*(const __attribute__((address_space(3))) bf16x8*)(kp+2560);
  kf[4]=*(const __attribute__((address_space(3))) bf16x8*)(kp+4096); kf[5]=*(const __attribute__((address_space(3))) bf16x8*)(kp+4608);
  kf[6]=*(const __attribute__((address_space(3))) bf16x8*)(kp+6144); kf[7]=*(const __attribute__((address_space(3))) bf16x8*)(kp+6656);
}
__device__ __forceinline__ void kload2(bf16x8*kf,lds_cptr kp,int j){ kf[2*j]=*(const __attribute__((address_space(3))) bf16x8*)(kp+j*2048); kf[2*j+1]=*(const __attribute__((address_space(3))) bf16x8*)(kp+j*2048+512); }
__device__ __forceinline__ s16x4 vtr(lds_cptr p){ return __builtin_bit_cast(s16x4,__builtin_amdgcn_ds_read_tr16_b64_v4i16((__attribute__((address_space(3))) v4i16_t*)p)); }
__device__ __forceinline__ float rowmax(const f32x16&p0,const f32x16&p1){
  float a=max3f(p0[0],p0[1],p1[0]),b=max3f(p0[2],p0[3],p1[1]);a=max3f(a,p1[2],p1[3]);
  #pragma unroll
  for(int r=4;r<16;r+=4){a=max3f(a,p0[r],p0[r+1]);b=max3f(b,p0[r+2],p0[r+3]);a=max3f(a,p1[r],p1[r+1]);b=max3f(b,p1[r+2],p1[r+3]);}
  const float m=max2f(a,b);
  auto rr=__builtin_amdgcn_permlane32_swap(__float_as_uint(m),__float_as_uint(m),false,false);
  return max2f(__uint_as_float(rr[0]),__uint_as_float(rr[1]));
}
__device__ __forceinline__ void pv(f32x16*o,int vb,bf16x8 pa0,bf16x8 pa1,bf16x8 pa2,bf16x8 pa3){
  #pragma unroll
  for(int d0=0;d0<4;++d0){s16x4 lo[4],hi[4];
    #pragma unroll
    for(int ks=0;ks<4;++ks){
      asm volatile("ds_read_b64_tr_b16 %0,%1 offset:%c2":"=&v"(lo[ks]):"v"(vb),"i"(d0*4096+ks*1024):"memory");
      asm volatile("ds_read_b64_tr_b16 %0,%1 offset:%c2":"=&v"(hi[ks]):"v"(vb),"i"(d0*4096+ks*1024+512):"memory");}
    asm volatile("s_waitcnt lgkmcnt(0)":::"memory");SBAR();
    #define PK(k) (bf16x8){lo[k][0],lo[k][1],lo[k][2],lo[k][3],hi[k][0],hi[k][1],hi[k][2],hi[k][3]}
    o[d0]=__builtin_amdgcn_mfma_f32_32x32x16_bf16(pa0,PK(0),o[d0],0,0,0);
    o[d0]=__builtin_amdgcn_mfma_f32_32x32x16_bf16(pa1,PK(1),o[d0],0,0,0);
    o[d0]=__builtin_amdgcn_mfma_f32_32x32x16_bf16(pa2,PK(2),o[d0],0,0,0);
    o[d0]=__builtin_amdgcn_mfma_f32_32x32x16_bf16(pa3,PK(3),o[d0],0,0,0);
    #undef PK
  }
}

#ifndef ATTN_STORE16
#define ATTN_STORE16(p,v) (*(u32x4*)(p)=(v))
#endif
template<int THRL> __device__ __forceinline__ void attn_unit(long rowbase,int qb,const bf16*Qh,const bf16*__restrict__ Kh_,const bf16*__restrict__ Vh_,bf16*Oh,char*shm,int fuse,unsigned char*Ch,const float*gh,float lam,int first,int has_next,const bf16*Kh_n){
  int tid_=threadIdx.x; asm volatile("":"+v"(tid_));
  const int tid=tid_,lane=tid&63,r32=lane&31,hi=lane>>5; const int wid=__builtin_amdgcn_readfirstlane(tid>>6);
  const int q0=qb*QB;
  const bf16*Qw=Qh+(rowbase+q0+wid*QBLK)*PQ;
  const bf16*Kh=Kh_+rowbase*PQ,*Vh=Vh_+rowbase*PQ;
  const unsigned lds0=(unsigned)(uintptr_t)shm;
  float*wsf=(float*)(shm+LDS_WS)+wid*64;
  const bf16*ksrc=Kh+(long)lane*PQ+wid*8;
  const bf16*vsrc=Vh+(long)(16*(wid&3)+(lane>>2))*PQ+(wid>>2)*32+(lane&3)*8;
  const unsigned kdst=lds0+LDS_K+wid*1024, vdst=lds0+LDS_V+wid*1024;
  #define DMA_K(t,slot) glds16(ksrc+(long)(t)*KVBLK*PQ,(unsigned)__builtin_amdgcn_readfirstlane(kdst+(slot)))
  #define DMA_V(t,slot) do{ glds16(vsrc+(long)(t)*KVBLK*PQ,(unsigned)__builtin_amdgcn_readfirstlane(vdst+2*(slot))); glds16(vsrc+(long)(t)*KVBLK*PQ+64,(unsigned)__builtin_amdgcn_readfirstlane(vdst+2*(slot)+8192)); }while(0)
  const int vb0=(int)(lds0+LDS_V)+((lane>>4)&1)*32+(lane&3)*8+(4*hi+((lane&15)>>2))*64;
  const char*Kbase=shm+LDS_K; bf16x8 kf[8];
  const lds_cptr shm3=(lds_cptr)shm; const lds_cptr kp0=shm3+LDS_K+hi*1024+r32*16; const lds_cptr vp0=shm3+LDS_V+((lane>>4)&1)*32+(lane&3)*8+(4*hi+((lane&15)>>2))*64;
  const int NT=(q0+QB)/KVBLK;
  if(first){ DMA_K(0,0);DMA_V(0,0);DMA_K(1,SLOTB); }
  bf16x8 qr[4];
  #pragma unroll
  for(int d0=0;d0<4;++d0)qr[d0]=*reinterpret_cast<const bf16x8*>(&Qw[(long)r32*PQ+d0*16+hi*8]);
  if(!first){ DMA_V(0,0); }
  float z0_=0.f; asm volatile("":"+v"(z0_));
  f32x16 zv_; _Pragma("unroll") for(int r=0;r<16;++r)zv_[r]=z0_;
  float mhat=0.f,l_reg=0.f;f32x16 o[4];o[0]=zv_;o[1]=zv_;o[2]=zv_;o[3]=zv_;f32x16 negm=zv_;asm volatile("":"+v"(negm));
  const int qrel=wid*QBLK+r32;
  #define CMASK(P0,P1,t) do{int jb_=(t)-(NT-4); if(jb_>=0)cmask(P0,P1,jb_,qrel,hi);}while(0)
  bool resc=false;
  #define START(P0,P1) do{ const float rm=rowmax(P0,P1); resc=false; \
    { const float dl=rm; mhat=fadd_s(mhat,dl); \
      _Pragma("unroll") for(int r=0;r<16;++r){P0[r]=fsub_s(P0[r],dl);P1[r]=fsub_s(P1[r],dl);} \
      _Pragma("unroll") for(int r=0;r<16;++r)negm[r]=-mhat; asm volatile("":"+v"(negm)); } \
    _Pragma("unroll") for(int r=0;r<16;++r)P0[r]=__builtin_amdgcn_exp2f(P0[r]); }while(0)
  #define RESC() do{ if(resc){ asm volatile("s_waitcnt lgkmcnt(0)":::"memory"); \
      _Pragma("unroll") for(int d_=0;d_<4;++d_) _Pragma("unroll") for(int r=0;r<16;++r)o[d_][r]*=wsf[crow(r,hi)]; } }while(0)
  f32x16 pA0,pA1,pB0,pB1;
  int sl_prev=0,sl_cur=0,sl_next=SLOTB;
  #define ROT() do{sl_prev=sl_cur;sl_cur=sl_next;sl_next=(sl_next==(NSLOT-1)*SLOTB)?0:sl_next+SLOTB;}while(0)
  if(first){ DMA_K(2,2*SLOTB);
    WAIT_BAR(4); }
  else { WAIT_BAR(2); }
  qkt(pA0,pA1,Kbase,qr,negm,r32,hi);asm volatile("s_nop 15\n\ts_nop 7":"+v"(pA0),"+v"(pA1));CMASK(pA0,pA1,0);
  START(pA0,pA1);
  _Pragma("unroll") for(int r=0;r<16;++r)pA1[r]=__builtin_amdgcn_exp2f(pA1[r]);
  WAIT_BAR(0);
  DMA_K(3,0);DMA_V(1,SLOTB);
  ROT();
  kload8(kf,kp0+sl_cur);
  WAIT_BAR(3);
  s16x4 vlo[8],vhi[8]; u32x4 pw0,pw1,pw2,pw3;
  #define PKW(P,B) cvtpk_s(P[B],P[B+1])
  #define PAF(k) __builtin_bit_cast(bf16x8,pw##k)
  #define VFR(i) (bf16x8){vlo[i][0],vlo[i][1],vlo[i][2],vlo[i][3],vhi[i][0],vhi[i][1],vhi[i][2],vhi[i][3]}
  #define PIN(x) asm volatile("":"+v"(x))
  #define MX3(a,b,c) __builtin_fmaxf(__builtin_fmaxf((a),(b)),(c))
  #define GAPA(MF,A0,A1,A2,A3,W0,W1,PW) do{ MF; sacc+=A0; sacc+=A1; sacc+=A2; sacc+=A3; PIN(sacc); W0; W1; PIN(PW); SBAR(); }while(0)
  #define EX(v) __builtin_amdgcn_exp2f(v)
  #define GAPB2(MF,X,B) do{ MF; X[B]=EX(X[B]); X[B+1]=EX(X[B+1]); PIN(X); SBAR(); }while(0)
  #define VRD2(i) do{ vlo[i]=vtr(vp_+(8192+((i)>>2)*4096+((i)&3)*1024)); vhi[i]=vtr(vp_+(8192+((i)>>2)*4096+((i)&3)*1024+512)); SBAR(); }while(0)
  #define VRD(i) do{ vlo[i]=vtr(vp_+(((i)>>2)*4096+((i)&3)*1024)); vhi[i]=vtr(vp_+(((i)>>2)*4096+((i)&3)*1024+512)); }while(0)
  #define KRD(G,j) do{ if(G){ kload2(kf,kp0+sl_next,j); SBAR(); } }while(0)
  #define STEP(C0,C1,P0,P1,t,GK,GV,GL) do{ SBAR(); \
    const lds_cptr vp_=vp0+2*sl_prev; \
    VRD(0); SBAR(); float sacc=(P0[0]+P0[1]); \
    GAPA(C0=__builtin_amdgcn_mfma_f32_32x32x16_bf16(kf[0],qr[0],negm,0,0,0), P0[2],P0[3],P0[4],P0[5],     pw0[0]=PKW(P0,0), pw0[1]=PKW(P0,2), pw0); \
    VRD(4); SBAR(); GAPA(C1=__builtin_amdgcn_mfma_f32_32x32x16_bf16(kf[1],qr[0],negm,0,0,0), P0[6],P0[7],P0[8],P0[9],     pw0[2]=PKW(P0,4), pw0[3]=PKW(P0,6), pw0); \
    VRD(1); SBAR(); GAPA(C0=__builtin_amdgcn_mfma_f32_32x32x16_bf16(kf[2],qr[1],C0,0,0,0),   P0[10],P0[11],P0[12],P0[13], pw1[0]=PKW(P0,8), pw1[1]=PKW(P0,10), pw1); \
    VRD(5); SBAR(); GAPA(C1=__builtin_amdgcn_mfma_f32_32x32x16_bf16(kf[3],qr[1],C1,0,0,0),   P0[14],P0[15],P1[0],P1[1],   pw1[2]=PKW(P0,12),pw1[3]=PKW(P0,14), pw1); \
    VRD(2); SBAR(); GAPA(C0=__builtin_amdgcn_mfma_f32_32x32x16_bf16(kf[4],qr[2],C0,0,0,0),   P1[2],P1[3],P1[4],P1[5],     pw2[0]=PKW(P1,0), pw2[1]=PKW(P1,2), pw2); \
    VRD(6); SBAR(); GAPA(C1=__builtin_amdgcn_mfma_f32_32x32x16_bf16(kf[5],qr[2],C1,0,0,0),   P1[6],P1[7],P1[8],P1[9],     pw2[2]=PKW(P1,4), pw2[3]=PKW(P1,6), pw2); \
    VRD(3); SBAR(); GAPA(C0=__builtin_amdgcn_mfma_f32_32x32x16_bf16(kf[6],qr[3],C0,0,0,0),   P1[10],P1[11],P1[12],P1[13], pw3[0]=PKW(P1,8), pw3[1]=PKW(P1,10), pw3); \
    VRD(7); SBAR(); GAPA(C1=__builtin_amdgcn_mfma_f32_32x32x16_bf16(kf[7],qr[3],C1,0,0,0),   P1[14],P1[15],0.f,0.f,       pw3[2]=PKW(P1,12),pw3[3]=PKW(P1,14), pw3); \
    l_reg+=sacc; \
    if(GK){DMA_K((t)+3,sl_cur);} if(GV){DMA_V((t)+1,sl_next);} \
    CMASK(C0,C1,t); \
    { float a=MX3(C0[0],C0[1],C1[0]),b=MX3(C0[2],C0[3],C1[1]); a=MX3(a,C1[2],C1[3]); \
      _Pragma("unroll") for(int r=4;r<16;r+=4){a=MX3(a,C0[r],C0[r+1]);b=MX3(b,C0[r+2],C0[r+3]);a=MX3(a,C1[r],C1[r+1]);b=MX3(b,C1[r+2],C1[r+3]);} \
      float rm=__builtin_fmaxf(a,b); { auto rr=__builtin_amdgcn_permlane32_swap(__float_as_uint(rm),__float_as_uint(rm),false,false); rm=__builtin_fmaxf(__uint_as_float(rr[0]),__uint_as_float(rr[1])); } \
      resc=false; \
      if(__builtin_expect(__any(rm>(float)THRL),0)){ const float dl=__builtin_fmaxf(rm,0.f); mhat+=dl; \
        _Pragma("unroll") for(int r=0;r<16;++r){C0[r]-=dl;C1[r]-=dl;} \
        _Pragma("unroll") for(int r=0;r<16;++r)negm[r]=-mhat; asm volatile("":"+v"(negm)); \
        const float f=__builtin_amdgcn_exp2f(-dl); l_reg*=f; if(hi==0)wsf[r32]=f; resc=true; } } \
    SBAR(); \
    GAPB2(o[0]=__builtin_amdgcn_mfma_f32_32x32x16_bf16(PAF(0),VFR(0),o[0],0,0,0), C0,0);  VRD2(0); \
    GAPB2(o[1]=__builtin_amdgcn_mfma_f32_32x32x16_bf16(PAF(0),VFR(4),o[1],0,0,0), C0,2);  VRD2(4); \
    GAPB2(o[0]=__builtin_amdgcn_mfma_f32_32x32x16_bf16(PAF(1),VFR(1),o[0],0,0,0), C0,4);  VRD2(1); \
    GAPB2(o[1]=__builtin_amdgcn_mfma_f32_32x32x16_bf16(PAF(1),VFR(5),o[1],0,0,0), C0,6);  VRD2(5); \
    GAPB2(o[0]=__builtin_amdgcn_mfma_f32_32x32x16_bf16(PAF(2),VFR(2),o[0],0,0,0), C0,8);  VRD2(2); \
    GAPB2(o[1]=__builtin_amdgcn_mfma_f32_32x32x16_bf16(PAF(2),VFR(6),o[1],0,0,0), C0,10); VRD2(6); \
    GAPB2(o[0]=__builtin_amdgcn_mfma_f32_32x32x16_bf16(PAF(3),VFR(3),o[0],0,0,0), C0,12); VRD2(3); \
    GAPB2(o[1]=__builtin_amdgcn_mfma_f32_32x32x16_bf16(PAF(3),VFR(7),o[1],0,0,0), C0,14); VRD2(7); \
    GAPB2(o[2]=__builtin_amdgcn_mfma_f32_32x32x16_bf16(PAF(0),VFR(0),o[2],0,0,0), C1,0); \
    GAPB2(o[3]=__builtin_amdgcn_mfma_f32_32x32x16_bf16(PAF(0),VFR(4),o[3],0,0,0), C1,2); \
    KRD(GL,0); GAPB2(o[2]=__builtin_amdgcn_mfma_f32_32x32x16_bf16(PAF(1),VFR(1),o[2],0,0,0), C1,4); \
    KRD(GL,1); GAPB2(o[3]=__builtin_amdgcn_mfma_f32_32x32x16_bf16(PAF(1),VFR(5),o[3],0,0,0), C1,6); \
    KRD(GL,2); GAPB2(o[2]=__builtin_amdgcn_mfma_f32_32x32x16_bf16(PAF(2),VFR(2),o[2],0,0,0), C1,8); \
    KRD(GL,3); GAPB2(o[3]=__builtin_amdgcn_mfma_f32_32x32x16_bf16(PAF(2),VFR(6),o[3],0,0,0), C1,10); \
    GAPB2(o[2]=__builtin_amdgcn_mfma_f32_32x32x16_bf16(PAF(3),VFR(3),o[2],0,0,0), C1,12); \
    GAPB2(o[3]=__builtin_amdgcn_mfma_f32_32x32x16_bf16(PAF(3),VFR(7),o[3],0,0,0), C1,14); \
    }while(0)
  int t=1;
  #undef CMASK
  #define CMASK(P0,P1,t) do{}while(0)
  for(;t+5<NT;t+=2){
    STEP(pB0,pB1,pA0,pA1,t,true,true,true);     WAIT_BAR(3); RESC(); ROT();
    STEP(pA0,pA1,pB0,pB1,t+1,true,true,true);   WAIT_BAR(3); RESC(); ROT();
  }
  #undef CMASK
  #define CMASK(P0,P1,t) do{int jb_=(t)-(NT-4); if(jb_>=0)cmask(P0,P1,jb_,qrel,hi);}while(0)
  #define ENDW(tt) do{ if((tt)+3<NT){WAIT_BAR(3);} else if((tt)+2<NT){WAIT_BAR(2);} else {WAIT_BAR(0);} }while(0)
  for(;t+1<NT;t+=2){
    STEP(pB0,pB1,pA0,pA1,t,(t+3<NT),(t+1<NT),(t+1<NT));       ENDW(t);   RESC(); ROT();
    STEP(pA0,pA1,pB0,pB1,t+1,(t+4<NT),(t+2<NT),(t+2<NT));     ENDW(t+1); RESC(); ROT();
  }
  STEP(pB0,pB1,pA0,pA1,NT-1,false,false,false); RESC();
  if(has_next){
    const bf16*ksn=Kh_n+rowbase*PQ+(long)lane*PQ+wid*8;
    glds16(ksn,(unsigned)__builtin_amdgcn_readfirstlane(kdst));
    glds16(ksn+(long)KVBLK*PQ,(unsigned)__builtin_amdgcn_readfirstlane(kdst+SLOTB));
    glds16(ksn+(long)2*KVBLK*PQ,(unsigned)__builtin_amdgcn_readfirstlane(kdst+2*SLOTB));
  }
  { float sacc=pB0[0]+pB0[1]; _Pragma("unroll") for(int r=2;r<16;++r)sacc+=pB0[r]; _Pragma("unroll") for(int r=0;r<16;++r)sacc+=pB1[r]; l_reg+=sacc;
    pw0=(u32x4){PKW(pB0,0),PKW(pB0,2),PKW(pB0,4),PKW(pB0,6)};pw1=(u32x4){PKW(pB0,8),PKW(pB0,10),PKW(pB0,12),PKW(pB0,14)};pw2=(u32x4){PKW(pB1,0),PKW(pB1,2),PKW(pB1,4),PKW(pB1,6)};pw3=(u32x4){PKW(pB1,8),PKW(pB1,10),PKW(pB1,12),PKW(pB1,14)};
    SBAR(); pv(o,vb0+2*sl_cur,PAF(0),PAF(1),PAF(2),PAF(3)); }
  #undef PKW
  #undef PAF
  #undef VFR
  #undef PIN
  #undef MX3
  #undef GAPA
  #undef GAPB2
  #undef VRD2
  #undef EX
  #undef VRD
  #undef KRD
  #undef STEP
  #undef ENDW
  {auto rr=__builtin_amdgcn_permlane32_swap(__float_as_uint(l_reg),__float_as_uint(l_reg),false,false);l_reg=__uint_as_float(rr[0])+__uint_as_float(rr[1]);}
  if(hi==0)wsf[32+r32]=l_reg;asm volatile("s_waitcnt lgkmcnt(0)":::"memory");
  float rli[16];
  #pragma unroll
  for(int r=0;r<16;++r)rli[r]=__builtin_amdgcn_rcpf(wsf[32+crow(r,hi)]);
  bf16*Ow=Oh+(rowbase+q0+wid*QBLK)*PO;
  { bf16*stg=(bf16*)(shm+LDS_OST)+wid*2048;
    if(!fuse){
    #pragma unroll
    for(int hf=0;hf<2;++hf){
      #pragma unroll
      for(int r=0;r<16;++r){const int orow=crow(r,hi);
        #pragma unroll
        for(int d0=0;d0<2;++d0)stg[orow*64+d0*32+r32]=__float2bfloat16(o[2*hf+d0][r]*rli[r]);}
      asm volatile("s_waitcnt lgkmcnt(0)":::"memory");
      #pragma unroll
      for(int i=0;i<4;++i){const int row=i*8+(lane>>3),ch=lane&7; const u32x4 v=*(const u32x4*)(stg+row*64+ch*8); ATTN_STORE16(Ow+(long)row*PO+hf*64+ch*8,v);}
      asm volatile("s_waitcnt lgkmcnt(0)":::"memory");
    } }
    else{
      unsigned char*Cw=Ch+(rowbase+q0+wid*QBLK)*PO;
      u32x4 dp[2][4]; float ss[4]={0.f,0.f,0.f,0.f};
      #pragma unroll
      for(int hf=0;hf<2;++hf){
        u32x4 v0[4];
        #pragma unroll
        for(int i=0;i<4;++i){const int row=i*8+(lane>>3),ch=lane&7; v0[i]=*(const u32x4*)(Ow+(long)row*PO+hf*64+ch*8);}
        #pragma unroll
        for(int r=0;r<16;++r){const int orow=crow(r,hi);
          #pragma unroll
          for(int d0=0;d0<2;++d0)stg[orow*64+d0*32+r32]=__float2bfloat16(o[2*hf+d0][r]*rli[r]);}
        asm volatile("s_waitcnt lgkmcnt(0)":::"memory");
        #pragma unroll
        for(int i=0;i<4;++i){const int row=i*8+(lane>>3),ch=lane&7; const u32x4 v1=*(const u32x4*)(stg+row*64+ch*8);
          float d[8];
          #pragma unroll
          for(int j=0;j<4;++j){d[2*j]=bf2f(v0[i][j]&0xffffu)-lam*bf2f(v1[j]&0xffffu);d[2*j+1]=bf2f(v0[i][j]>>16)-lam*bf2f(v1[j]>>16);}
          #pragma unroll
          for(int j=0;j<8;++j)ss[i]+=d[j]*d[j];
          dp[hf][i]=(u32x4){pk2(d[0],d[1]),pk2(d[2],d[3]),pk2(d[4],d[5]),pk2(d[6],d[7])};}
        asm volatile("s_waitcnt lgkmcnt(0)":::"memory");
      }
      float rsn[4];
      #pragma unroll
      for(int i=0;i<4;++i){float sv=ss[i];sv+=__shfl_xor(sv,1);sv+=__shfl_xor(sv,2);sv+=__shfl_xor(sv,4);rsn[i]=0.8f*rsq_(sv*(1.f/128.f)+EPS);}
      #pragma unroll
      for(int hf=0;hf<2;++hf){const int ch=lane&7; const f32x4 g0=*(const f32x4*)(gh+hf*64+ch*8),g1=*(const f32x4*)(gh+hf*64+ch*8+4);
        #pragma unroll
        for(int i=0;i<4;++i){const int row=i*8+(lane>>3); const u32x4 q=dp[hf][i]; const float rs=rsn[i];
          const u32x2 w={pk4_fp8(bf2f(q[0]&0xffffu)*rs*g0.x,bf2f(q[0]>>16)*rs*g0.y,bf2f(q[1]&0xffffu)*rs*g0.z,bf2f(q[1]>>16)*rs*g0.w),pk4_fp8(bf2f(q[2]&0xffffu)*rs*g1.x,bf2f(q[2]>>16)*rs*g1.y,bf2f(q[3]&0xffffu)*rs*g1.z,bf2f(q[3]>>16)*rs*g1.w)};
          *(u32x2*)(Cw+(long)row*PO+hf*64+ch*8)=w;} }
    } }
  asm volatile("s_waitcnt lgkmcnt(0)\n\ts_barrier":::"memory");
  #undef DMA_K
  #undef DMA_V
  #undef CMASK
  #undef START
  #undef RESC
  #undef ROT
}
constexpr int ATTN_LDS_BYTES=LDS_BYTES;
template<int THRL=8> __device__ __forceinline__ void attn_pair(char*lds,const bf16*P,bf16*O,unsigned char*cat,const float*dng,float lam,int item){
  const int qd=item&3, h=(item>>2)&3, b=item>>4;
  const bf16*Vh=P+2560+h*128; bf16*Oh=O+(h*2)*128; unsigned char*Ch=cat+512+h*128; const float*gh=dng+h*128;
  for(int i=0;i<8;++i){ long rowbase=(long)b*SEQ; asm volatile("":"+s"(rowbase));
    const int map=i&1, k=i>>1, qb=(k==0)?15-qd:(k==1)?8+qd:(k==2)?7-qd:qd;
    const bf16*Qh=P+1536+(h*2+map)*64, *Kh=P+2048+(h*2+map)*64, *Khn=P+2048+(h*2+((i+1)&1))*64;
    attn_unit<THRL>(rowbase,qb,Qh,Kh,Vh,Oh,lds,map,Ch,gh,lam,i==0,i<7,Khn); }
}
#undef SBAR
#undef WAIT_BAR
}

#ifndef MK_N_LAUNCHES
#define MK_N_LAUNCHES 1
#endif
#ifndef RPT_MASK
#define RPT_MASK 0
#endif
#ifndef RPT_SUB
#define RPT_SUB 0
#endif
constexpr int NPHASE = 12;
constexpr int N_LAUNCHES = MK_N_LAUNCHES;
static_assert(N_LAUNCHES == 1 || N_LAUNCHES == NPHASE, "MK_N_LAUNCHES is 1 or 12");

#define XB_TMO      128
#define XB_XCNT(j)  (256  + 64 * (j))
#define XB_XSUB(j)  (1280 + 64 * (j))
#define XB_XGEN(j)  (2304 + 64 * (j))
#define XB_TOP      3328
#define XB_TOPGEN   3392
#define XCD_BAR_WORDS 3456
#define XB_SPIN_CAP (1u << 18)

__device__ __forceinline__ unsigned xb_ld(unsigned* p)              { return __hip_atomic_load(p, __ATOMIC_RELAXED, __HIP_MEMORY_SCOPE_AGENT); }
__device__ __forceinline__ unsigned xb_add(unsigned* p, unsigned v) { return __hip_atomic_fetch_add(p, v, __ATOMIC_RELAXED, __HIP_MEMORY_SCOPE_AGENT); }
__device__ __forceinline__ unsigned xb_xcc_id() { return (unsigned)__builtin_amdgcn_s_getreg((3 << 11) | 20) & 0xFu; }
#define XB_SPIN(cond, bar) do { unsigned _sp = 0; while (cond) { __builtin_amdgcn_s_sleep(1); \
    if ((++_sp & 255u) == 0u) { if (xb_ld(&(bar)[XB_TMO])) break; if (_sp > XB_SPIN_CAP) { atomicAdd(&(bar)[XB_TMO], 1u); break; } } } } while (0)

struct XcdBarrier {
    unsigned* bar; unsigned x;
    volatile LAS unsigned* st;
};

__device__ __forceinline__ XcdBarrier xcd_barrier_post(unsigned* bar, volatile LAS unsigned* st) {
    XcdBarrier b; b.bar = bar; b.x = xb_xcc_id(); b.st = st;
    if (threadIdx.x == 0) (void)xb_add(&bar[XB_XCNT(b.x)], 1u);
    return b;
}
__device__ __forceinline__ void xcd_barrier_complete(unsigned* bar, unsigned x, unsigned& nloc, unsigned& nx) {
    const unsigned G = gridDim.x * gridDim.y * gridDim.z;
    unsigned sum, cnt, mine, sp = 0u;
    for (;;) {
        sum = 0u; cnt = 0u; mine = 0u;
#pragma unroll
        for (unsigned j = 0; j < 16; ++j) { const unsigned c = xb_ld(&bar[XB_XCNT(j)]); sum += c; cnt += (c > 0u) ? 1u : 0u; mine = (j == x) ? c : mine; }
        if (sum == G) break;
        __builtin_amdgcn_s_sleep(1);
        if ((++sp & 255u) == 0u) { if (xb_ld(&bar[XB_TMO])) break; if (sp > XB_SPIN_CAP) { atomicAdd(&bar[XB_TMO], 1u); break; } }
    }
    nloc = mine > 0u ? mine : 1u; nx = cnt > 0u ? cnt : 1u;
}

__device__ __forceinline__ void xcd_barrier(const XcdBarrier& b) {
    asm volatile("s_waitcnt vmcnt(0)" ::: "memory");
    __syncthreads();
    if (threadIdx.x == 0) {
        unsigned* bar = b.bar;
        __builtin_amdgcn_s_waitcnt(0);
        unsigned nloc = b.st[0], nx = b.st[1];
        if (nloc == 0u) { xcd_barrier_complete(bar, b.x, nloc, nx); b.st[0] = nloc; b.st[1] = nx; }
        const unsigned old = xb_add(&bar[XB_XSUB(b.x)], 1u);
        const unsigned gen = old / nloc;
        if (old + 1u == (gen + 1u) * nloc) {
            __builtin_amdgcn_fence(__ATOMIC_RELEASE, "agent");
            asm volatile("s_waitcnt vmcnt(0)" ::: "memory");
            const unsigned og = xb_add(&bar[XB_TOP], 1u);
            const unsigned tg = og / nx;
            if (og + 1u == (tg + 1u) * nx) xb_add(&bar[XB_TOPGEN], 1u);
            else XB_SPIN(xb_ld(&bar[XB_TOPGEN]) == tg, bar);
            __builtin_amdgcn_fence(__ATOMIC_ACQUIRE, "agent");
            xb_add(&bar[XB_XGEN(b.x)], 1u);
            asm volatile("s_waitcnt vmcnt(0)" ::: "memory");
        } else {
            XB_SPIN(xb_ld(&bar[XB_XGEN(b.x)]) == gen, bar);
            __builtin_amdgcn_fence(__ATOMIC_ACQUIRE, "agent");
            asm volatile("s_waitcnt vmcnt(0)" ::: "memory");
        }
    }
    __syncthreads();
}

struct Args { const float* in[26]; float* out; unsigned char* ws; int ph_lo, ph_hi, sub, pad; };
struct Frame {
    LAS unsigned char* lds;
    volatile LAS unsigned* MISC;
    unsigned* ctl;
    int tid, lane, wave, bx, vcu, G;
};
enum { I_X = 0, I_C, I_WADA, I_BADA, I_N1G, I_WIN, I_CONVW, I_CONVB, I_BI, I_BF, I_MNG, I_QNG, I_KNG, I_LQ1, I_LK1, I_LQ2, I_LK2, I_DNG, I_WOUT, I_N2G, I_WR, I_BR, I_WGU, I_BGU, I_WD, I_BD };

__device__ __forceinline__ void transpose_item(const float* W, int ldw, int col0, int cstride, bf16* WT, int K, int drow0, int k0, LAS float* scr, int lane) {
#pragma unroll 8
    for (int i = 0; i < 32; ++i) { const int kk = 2 * i + (lane >> 5); scr[kk * 33 + (lane & 31)] = __builtin_nontemporal_load(W + (size_t)(k0 + kk) * ldw + col0 + cstride * (lane & 31)); }
    LDS_WAIT();
    const int c = lane & 7;
#pragma unroll
    for (int j = 0; j < 4; ++j) { const int n = (lane >> 3) + 8 * j; const LAS float* s = scr + (8 * c) * 33 + n;
        u32x4 o; o.x = pk2(s[0 * 33], s[1 * 33]); o.y = pk2(s[2 * 33], s[3 * 33]); o.z = pk2(s[4 * 33], s[5 * 33]); o.w = pk2(s[6 * 33], s[7 * 33]);
        *(u32x4*)(WT + (size_t)(drow0 + n) * K + k0 + 8 * c) = o; }
    LDS_WAIT();
}

__device__ __forceinline__ void transpose_item_fp8(const float* W, int ldw, int col0, int cstride, unsigned char* WT, int K, int drow0, int k0, float scale, LAS float* scr, int lane) {
#pragma unroll 8
    for (int i = 0; i < 32; ++i) { const int kk = 2 * i + (lane >> 5); scr[kk * 33 + (lane & 31)] = __builtin_nontemporal_load(W + (size_t)(k0 + kk) * ldw + col0 + cstride * (lane & 31)); }
    LDS_WAIT();
    const int c = lane & 7;
#pragma unroll
    for (int j = 0; j < 4; ++j) { const int n = (lane >> 3) + 8 * j; const LAS float* s = scr + (8 * c) * 33 + n;
        const u32x2 o = {pk4_fp8(s[0 * 33] * scale, s[1 * 33] * scale, s[2 * 33] * scale, s[3 * 33] * scale), pk4_fp8(s[4 * 33] * scale, s[5 * 33] * scale, s[6 * 33] * scale, s[7 * 33] * scale)};
        *(u32x2*)(WT + (size_t)(drow0 + n) * K + k0 + 8 * c) = o; }
    LDS_WAIT();
}
constexpr float WQ_SCALE = 32.f;

__device__ __forceinline__ void phase0(const Args& a, Frame& F) {
    const int tid = F.tid, lane = F.lane, wave = F.wave;
    {
        LAS float* cond = (LAS float*)(F.lds);
        LAS float* part = (LAS float*)(F.lds + 65536);
        const float* c = a.in[I_C]; const float* w_ada = a.in[I_WADA]; const float* b_ada = a.in[I_BADA];
        float* mod = (float*)(a.ws + WS_MOD);
        bool have = false;
        for (int task = F.bx; task < 96; task += F.G) {
            if (!have) { for (int idx = tid; idx < 16384; idx += 512) { const int b = idx >> 10, k = idx & 1023; const float cv = c[idx]; cond[k * 16 + b] = cv / (1.f + expf(-cv)); } __syncthreads(); have = true; }
            const int col = task * 64 + lane;
            float acc[16];
#pragma unroll
            for (int b = 0; b < 16; ++b) acc[b] = 0.f;
            const float* wp = w_ada + (size_t)(128 * wave) * 6144 + col;
#pragma unroll 8
            for (int k = 0; k < 128; ++k) {
                const float wv = __builtin_nontemporal_load(wp + (size_t)k * 6144);
                const LAS f32x4* c4 = (const LAS f32x4*)(cond + (128 * wave + k) * 16);
#pragma unroll
                for (int q = 0; q < 4; ++q) { const f32x4 cc = c4[q]; acc[4 * q + 0] += cc.x * wv; acc[4 * q + 1] += cc.y * wv; acc[4 * q + 2] += cc.z * wv; acc[4 * q + 3] += cc.w * wv; }
            }
#pragma unroll
            for (int b = 0; b < 16; ++b) part[(wave * 16 + b) * 64 + lane] = acc[b];
            __syncthreads();
            for (int o = tid; o < 1024; o += 512) { const int b = o >> 6, l = o & 63; float s = 0.f;
#pragma unroll
                for (int w = 0; w < 8; ++w) s += part[(w * 16 + b) * 64 + l];
                mod[b * 6144 + task * 64 + l] = s + b_ada[task * 64 + l]; }
            __syncthreads();
        }
    }
    {
        const int gtid = F.bx * 512 + tid, NT = F.G * 512;
        const float* w_in = a.in[I_WIN]; const float* w_r = a.in[I_WR]; const float* b_gu = a.in[I_BGU];
        float* Wg = (float*)(a.ws + WS_WG); float* wrT = (float*)(a.ws + WS_WRT); float* bgu = (float*)(a.ws + WS_BGU); f32x2* rope = (f32x2*)(a.ws + WS_ROPE);
        for (int idx = gtid; idx < 8192; idx += NT) { const int g = idx >> 10, k = idx & 1023; Wg[idx] = w_in[(size_t)k * IN_W + 1536 + g]; }
        { int* ident = (int*)(a.ws + WS_IDENT); for (int i = gtid; i < MAXTILES * 256; i += NT) ident[i] = i; }
        for (int idx = gtid; idx < 32768; idx += NT) { const int k = idx >> 5, e = idx & 31; wrT[(k >> 2) * 128 + e * 4 + (k & 3)] = w_r[idx]; }
        for (int idx = gtid; idx < 65536; idx += NT) { const int e = idx >> 11, r = idx & 2047, pn = r >> 8, half = (r >> 3) & 1, j = 8 * ((r & 255) >> 4) + (r & 7); bgu[idx] = b_gu[e * 2048 + 2 * (128 * pn + j) + half]; }
        { float* gtab = (float*)(a.ws + WS_GTAB);
          for (int idx = gtid; idx < 12 * 256; idx += NT) { const int pn = idx >> 8, sl = idx & 255, fqx = (sl >> 4) & 3, j = sl & 15, dim = (j < 8) ? 8 * fqx + j : 32 + 8 * fqx + (j - 8);
              gtab[idx] = (pn == 6 || pn == 7) ? a.in[I_QNG][dim] * attn_body::C2 : (pn == 8 || pn == 9) ? a.in[I_KNG][dim] : 0.f; } }
        for (int idx = gtid; idx < 131072; idx += NT) { const int pos = idx >> 5, j = idx & 31;
            const float invf = (float)pow(10000.0, -(double)(2 * j) / 64.0); const float ang = (float)pos * invf;
            rope[idx] = (f32x2){(float)cos((double)ang), (float)sin((double)ang)}; }
    }
    {
        LAS float* scr = (LAS float*)(F.lds + wave * 16384);
        constexpr int I_IN = 16 * 96, I_OUT = 16 * 32, I_ALL = I_IN + I_OUT;
        constexpr int LOW_ITEMS = 0;
        const int nlow = (F.G < 96 ? F.G : 96) * NWAVES, nhigh = F.G * NWAVES - nlow, nlowit = nhigh > 0 ? nlow * LOW_ITEMS : I_ALL;
        const bool low = F.bx < 96; const int wv_ = low ? F.bx * NWAVES + wave : (F.bx - 96) * NWAVES + wave;
        const int it0 = low ? wv_ : nlowit + wv_, itstep = low ? nlow : nhigh, itend = low ? nlowit : I_ALL;
        for (int it = it0; it < itend; it += itstep) {
            int r = it;
            if (r < I_IN) { const int kb = r / 96, nb = r % 96, d0 = 32 * nb; transpose_item(a.in[I_WIN], IN_W, d0 < 1536 ? d0 : d0 + 8, 1, (bf16*)(a.ws + WS_WINT), D, d0, 64 * kb, scr, lane); continue; } r -= I_IN;
            { const int kb = r / 32, nb = r % 32; transpose_item_fp8(a.in[I_WOUT], D, 32 * nb, 1, a.ws + WS_WOUTT, D, 32 * nb, 64 * kb, WQ_SCALE, scr, lane); }
        }
    }
}
__device__ __forceinline__ void wgu_copy(const Args& a, Frame& F) {
    LAS float* scr = (LAS float*)(F.lds + F.wave * 16384);
    const int lane = F.lane;
    const int gw = F.vcu * NWAVES + F.wave, NGW = F.G * NWAVES;
    for (int it = gw; it < 32 * 16 * 32; it += NGW) {
        const int e = it >> 9, q = it & 511, kb = q >> 5, jb = q & 31, pn = jb >> 2, j0 = (jb & 3) * 32, k0 = 64 * kb;
        const float* W = a.in[I_WGU] + (size_t)e * D * 2048 + (size_t)k0 * 2048 + 2 * (128 * pn + j0);
        f32x2 gu[32];
#pragma unroll
        for (int i = 0; i < 32; ++i) gu[i] = *(const f32x2*)(W + (size_t)(2 * i + (lane >> 5)) * 2048 + 2 * (lane & 31));
        unsigned char* WT = a.ws + WS_WGUT + (size_t)e * 2048 * D;
#pragma unroll
        for (int half = 0; half < 2; ++half) {
#pragma unroll
            for (int i = 0; i < 32; ++i) scr[(2 * i + (lane >> 5)) * 33 + (lane & 31)] = half ? gu[i].y : gu[i].x;
            LDS_WAIT();
            const int c = lane & 7;
#pragma unroll
            for (int j = 0; j < 4; ++j) { const int n = (lane >> 3) + 8 * j; const LAS float* sp = scr + (8 * c) * 33 + n;
                const u32x2 o = {pk4_fp8(sp[0 * 33] * WQ_SCALE, sp[1 * 33] * WQ_SCALE, sp[2 * 33] * WQ_SCALE, sp[3 * 33] * WQ_SCALE), pk4_fp8(sp[4 * 33] * WQ_SCALE, sp[5 * 33] * WQ_SCALE, sp[6 * 33] * WQ_SCALE, sp[7 * 33] * WQ_SCALE)};
                *(u32x2*)(WT + (size_t)(pn * 256 + 16 * ((j0 + n) >> 3) + 8 * half + ((j0 + n) & 7)) * D + k0 + 8 * c) = o; }
            LDS_WAIT();
        }
    }
}

struct WguQ { f32x2 v[8]; };
__device__ __forceinline__ void wgu_q_load(const Args& a, int gwv, int NGWv, int sq, int lane_in, WguQ& w) {
    int lane = lane_in; asm volatile("" : "+v"(lane));
    const int it = gwv + (sq >> 2) * NGWv, q = sq & 3;
    const int e = it >> 9, qq = it & 511, kb = qq >> 5, jb = qq & 31, pn = jb >> 2, j0 = (jb & 3) * 32, k0 = 64 * kb + 16 * q;
    const float* W = a.in[I_WGU] + (size_t)e * D * 2048 + (size_t)k0 * 2048 + 2 * (128 * pn + j0);
#pragma unroll
    for (int i = 0; i < 8; ++i) w.v[i] = __builtin_nontemporal_load((const f32x2*)(W + (size_t)(2 * i + (lane >> 5)) * 2048 + 2 * (lane & 31)));
}
__device__ __forceinline__ void wgu_q_store(const Args& a, int gwv, int NGWv, int sq, int lane_in, const WguQ& w, LAS float* scr, LAS unsigned char* ib) {
    int lane = lane_in; asm volatile("" : "+v"(lane));
    const int it = gwv + (sq >> 2) * NGWv, q = sq & 3;
    const int e = it >> 9, qq = it & 511, kb = qq >> 5, jb = qq & 31, pn = jb >> 2, j0 = (jb & 3) * 32, k0 = 64 * kb + 16 * q;
    unsigned char* WT = a.ws + WS_WGUT + (size_t)e * 2048 * D;
#pragma unroll
    for (int half = 0; half < 2; ++half) {
#pragma unroll
        for (int i = 0; i < 8; ++i) scr[(2 * i + (lane >> 5)) * 33 + (lane & 31)] = half ? w.v[i].y : w.v[i].x;
        LDS_WAIT();
        const int c = lane & 1, n = lane >> 1; const LAS float* sp = scr + (8 * c) * 33 + n;
        const u32x2 o = {pk4_fp8(sp[0 * 33] * WQ_SCALE, sp[1 * 33] * WQ_SCALE, sp[2 * 33] * WQ_SCALE, sp[3 * 33] * WQ_SCALE), pk4_fp8(sp[4 * 33] * WQ_SCALE, sp[5 * 33] * WQ_SCALE, sp[6 * 33] * WQ_SCALE, sp[7 * 33] * WQ_SCALE)};
        *(LAS u32x2*)(ib + (half * 32 + n) * 64 + 16 * q + 8 * c) = o;
        LDS_WAIT();
    }
    if (q == 3) {
        const int kb0 = 64 * kb;
#pragma unroll
        for (int j = 0; j < 4; ++j) { const int row = 16 * j + (lane >> 2), pc = lane & 3, half = row >> 5, n = row & 31;
            const u32x4 v = *(const LAS u32x4*)(ib + row * 64 + pc * 16);
            *(u32x4*)(WT + (size_t)(pn * 256 + 16 * ((j0 + n) >> 3) + 8 * half + ((j0 + n) & 7)) * D + kb0 + pc * 16) = v; }
        LDS_WAIT();
    }
}

__device__ __forceinline__ void phase1(const Args& a, Frame& F) {
    const int tid = F.tid, lane = F.lane;
    LAS float* wg = (LAS float*)F.lds;
    float wgr_[16];
    { const float* Wg = (const float*)(a.ws + WS_WG);
#pragma unroll
      for (int j = 0; j < 16; ++j) wgr_[j] = Wg[tid + 512 * j]; }
    const float* x = a.in[I_X]; const float* g1 = a.in[I_N1G]; const float* mod = (const float*)(a.ws + WS_MOD);
    const float* bi = a.in[I_BI]; const float* bfg = a.in[I_BF];
    bf16* h = (bf16*)(a.ws + WS_H); float* gates = (float*)(a.ws + WS_GATES);
    const int gw = F.vcu * NWAVES + F.wave, NGW = F.G * NWAVES;
#define P1_LOAD(buf, r0) do { _Pragma("unroll") for (int k = 0; k < 2; ++k) { const f32x4* xr = (const f32x4*)(x + (size_t)((r0) + k * NGW) * D) + lane; \
        _Pragma("unroll") for (int j = 0; j < 4; ++j) buf[k][j] = __builtin_nontemporal_load(xr + 64 * j); } } while (0)
#define P1_COMP(buf, r0) do { _Pragma("unroll") for (int k = 0; k < 2; ++k) { \
        float ss = 0.f; \
        _Pragma("unroll") for (int j = 0; j < 4; ++j) ss += (buf[k][j].x * buf[k][j].x + buf[k][j].y * buf[k][j].y) + (buf[k][j].z * buf[k][j].z + buf[k][j].w * buf[k][j].w); \
        const float rs = rsq_(wave_sum(ss) * (1.f / D) + EPS); \
        const int row = (r0) + k * NGW, b = row >> 12; \
        float ga[8]; \
        _Pragma("unroll") for (int g = 0; g < 8; ++g) ga[g] = 0.f; \
        _Pragma("unroll") for (int j = 0; j < 4; ++j) { \
            const int col = 256 * j + 4 * lane; \
            const f32x4 gg = *(const f32x4*)(g1 + col), sc = *(const f32x4*)(mod + b * 6144 + 1024 + col), sh = *(const f32x4*)(mod + b * 6144 + col); \
            const f32x4 hv = buf[k][j] * rs * gg * (sc + 1.f) + sh; \
            *(u32x2*)(h + (size_t)row * D + col) = (u32x2){pk2(hv.x, hv.y), pk2(hv.z, hv.w)}; \
            _Pragma("unroll") for (int g = 0; g < 8; ++g) { const f32x4 w4 = *(const LAS f32x4*)(wg + g * 1024 + col); ga[g] += (hv.x * w4.x + hv.y * w4.y) + (hv.z * w4.z + hv.w * w4.w); } } \
        _Pragma("unroll") for (int g = 0; g < 8; ++g) ga[g] = wave_sum(ga[g]); \
          \
        float pre = ga[0]; \
        _Pragma("unroll") for (int g = 1; g < 8; ++g) pre = (lane == g) ? ga[g] : pre; \
        const float z = pre + ((lane < 4) ? bi[lane & 3] : bfg[lane & 3]); \
        const float lsg = fminf(z, 0.f) - __logf(1.f + __expf(-fabsf(z))); \
        if (lane < 8) gates[(size_t)row * 8 + lane] = (lane < 4) ? z : lsg; \
        asm volatile("" ::: "memory");     \
    } } while (0)
    f32x4 va[2][4], vb[2][4], vc[2][4];
    const int lastp = gw + (NTOK / NGW - 2) * NGW;
    P1_LOAD(va, gw); P1_LOAD(vb, gw + 2 * NGW);
#pragma unroll
    for (int j = 0; j < 16; ++j) wg[tid + 512 * j] = wgr_[j];
    __syncthreads();
    for (int row0 = gw; row0 < NTOK; row0 += 6 * NGW) {
        const int r2 = row0 + 4 * NGW, r3 = row0 + 6 * NGW, r4 = row0 + 8 * NGW;
        P1_LOAD(vc, r2 < NTOK ? r2 : lastp);
        P1_COMP(va, row0);
        P1_LOAD(va, r3 < NTOK ? r3 : lastp);
        if (row0 + 2 * NGW < NTOK) P1_COMP(vb, row0 + 2 * NGW);
        P1_LOAD(vb, r4 < NTOK ? r4 : lastp);
        if (r2 < NTOK) P1_COMP(vc, r2);
    }
#undef P1_LOAD
#undef P1_COMP
}

__device__ __forceinline__ void rope_rows4(const Args& a, int row0, int rstride, int lane) {
    const int seg = lane >> 2, q = lane & 3;
    const float* gp = (seg < 8) ? a.in[I_QNG] : a.in[I_KNG];
    const float sc = (seg < 8) ? attn_body::C2 : 1.f;
    const f32x4 ga = *(const f32x4*)(gp + q * 8), gb = *(const f32x4*)(gp + q * 8 + 4), gc = *(const f32x4*)(gp + 32 + q * 8), gd = *(const f32x4*)(gp + 32 + q * 8 + 4);
    const float g1[8] = {ga.x, ga.y, ga.z, ga.w, gb.x, gb.y, gb.z, gb.w}, g2[8] = {gc.x, gc.y, gc.z, gc.w, gd.x, gd.y, gd.z, gd.w};
    u32x4 lo[4], hi[4]; f32x4 cs[4][4];
#pragma unroll
    for (int k = 0; k < 4; ++k) { const int row = row0 + k * rstride;
        const bf16* pr = (const bf16*)(a.ws + WS_P) + (size_t)row * NP + P_AQ;
        lo[k] = *(const u32x4*)(pr + seg * 64 + q * 8); hi[k] = *(const u32x4*)(pr + seg * 64 + 32 + q * 8);
        const f32x4* tab = (const f32x4*)((const float*)(a.ws + WS_ROPE) + ((size_t)(row & (SEQ - 1)) * 32 + q * 8) * 2);
#pragma unroll
        for (int i = 0; i < 4; ++i) cs[k][i] = tab[i]; }
#pragma unroll
    for (int k = 0; k < 4; ++k) {
        bf16* pr = (bf16*)(a.ws + WS_P) + (size_t)(row0 + k * rstride) * NP + P_AQ;
        float x1[8], x2[8]; float ss = 0.f;
#pragma unroll
        for (int i = 0; i < 4; ++i) { x1[2 * i] = bf2f(lo[k][i] & 0xffffu); x1[2 * i + 1] = bf2f(lo[k][i] >> 16); x2[2 * i] = bf2f(hi[k][i] & 0xffffu); x2[2 * i + 1] = bf2f(hi[k][i] >> 16); }
#pragma unroll
        for (int i = 0; i < 8; ++i) ss += x1[i] * x1[i] + x2[i] * x2[i];
        ss += __shfl_xor(ss, 1); ss += __shfl_xor(ss, 2);
        const float rs = rsq_(ss * (1.f / 64.f) + EPS);
        float o1[8], o2[8];
#pragma unroll
        for (int i = 0; i < 4; ++i) {
#pragma unroll
            for (int e = 0; e < 2; ++e) { const int kk = 2 * i + e; const float c = e ? cs[k][i].z : cs[k][i].x, sn = e ? cs[k][i].w : cs[k][i].y;
                const float y1 = x1[kk] * rs * g1[kk], y2 = x2[kk] * rs * g2[kk];
                o1[kk] = (y1 * c - y2 * sn) * sc; o2[kk] = (y2 * c + y1 * sn) * sc; } }
        *(u32x4*)(pr + seg * 64 + q * 8) = (u32x4){pk2(o1[0], o1[1]), pk2(o1[2], o1[3]), pk2(o1[4], o1[5]), pk2(o1[6], o1[7])};
        *(u32x4*)(pr + seg * 64 + 32 + q * 8) = (u32x4){pk2(o2[0], o2[1]), pk2(o2[2], o2[3]), pk2(o2[4], o2[5]), pk2(o2[6], o2[7])};
    }
}
__device__ __forceinline__ float wave_scan_add(float v, int lane) {
#pragma unroll
    for (int o = 1; o < 64; o <<= 1) { const float t = __shfl_up(v, o); if (lane >= o) v += t; }
    return v;
}
__device__ __forceinline__ float wave_scan_max(float v, int lane) {
#pragma unroll
    for (int o = 1; o < 64; o <<= 1) { const float t = __shfl_up(v, o); if (lane >= o) v = fmaxf(v, t); }
    return v;
}
__device__ __forceinline__ float silu_(float y) { return y * rcp_(1.f + __expf(-y)); }
__device__ __forceinline__ bf16x8 gather8(const LAS bf16* t, int pitch, int s0, int c) {
    bf16x8 f;
#pragma unroll
    for (int j = 0; j < 8; ++j) f[j] = (short)t[(s0 + j) * pitch + c];
    return f;
}
__device__ __forceinline__ int crow(int i, int hh) { return (i & 3) + 8 * (i >> 2) + 4 * hh; }

__device__ __forceinline__ u32x4 fp8x8_to_bf16x8(u32x2 v) {
    const f32x2 a = __builtin_amdgcn_cvt_pk_f32_fp8((int)v.x, false), b = __builtin_amdgcn_cvt_pk_f32_fp8((int)v.x, true), c = __builtin_amdgcn_cvt_pk_f32_fp8((int)v.y, false), d = __builtin_amdgcn_cvt_pk_f32_fp8((int)v.y, true);
    return (u32x4){pk2(a.x, a.y), pk2(b.x, b.y), pk2(c.x, c.y), pk2(d.x, d.y)};
}
struct MPref { u32x4 tq, tk, th; u32x2 tv0, tv1; float ip, lf, mp; float cq[5], ck[5]; f32x4 npv; };
template <bool WITH_Q>
__device__ __forceinline__ void mlstm_prefetch(const Args& a, int u, int tid, MPref& p) {
    const int b = u >> 8, h = (u >> 6) & 3, n = u & 63;
    const long r0 = (long)b * SEQ + (long)n * 64;
    const bf16* P = (const bf16*)(a.ws + WS_P);
    const int row = tid >> 3, c8 = tid & 7;
    if (WITH_Q) p.tq = *(const u32x4*)(P + (size_t)(r0 + row) * NP + P_MQ + h * 64 + c8 * 8);
    p.tk = *(const u32x4*)(P + (size_t)(r0 + row) * NP + P_MK + h * 64 + c8 * 8);
    { const unsigned char* P8 = a.ws + WS_P8;
      p.tv0 = *(const u32x2*)(P8 + (size_t)(r0 + (tid >> 4)) * 1024 + h * 128 + (tid & 15) * 8);
      p.tv1 = *(const u32x2*)(P8 + (size_t)(r0 + 32 + (tid >> 4)) * 1024 + h * 128 + (tid & 15) * 8); }
    p.th = (u32x4){0u, 0u, 0u, 0u};
    if (n > 0 && tid < 48) { const int hk = tid >= 24, t2 = tid - 24 * hk;
        if (WITH_Q || hk) p.th = *(const u32x4*)(P + (size_t)(r0 - 3 + (t2 >> 3)) * NP + (hk ? P_MK : P_MQ) + h * 64 + (t2 & 7) * 8); }
    if (tid < 64) { const float* gates = (const float*)(a.ws + WS_GATES); p.ip = gates[(r0 + tid) * 8 + h]; p.lf = gates[(r0 + tid) * 8 + 4 + h]; }
    if (WITH_Q) p.mp = ((const float*)(a.ws + WS_MPREV))[u];
    { const float* cw = a.in[I_CONVW]; const float* cb = a.in[I_CONVB]; const int c = tid & 63;
#pragma unroll
      for (int j = 0; j < 4; ++j) { if (WITH_Q) p.cq[j] = cw[512 * j + h * 64 + c]; p.ck[j] = cw[512 * j + 256 + h * 64 + c]; }
      if (WITH_Q) p.cq[4] = cb[h * 64 + c]; p.ck[4] = cb[256 + h * 64 + c]; }
    if (WITH_Q && tid < 16) p.npv = *(const f32x4*)((const float*)(a.ws + WS_NPREV) + (size_t)u * 64 + 4 * tid);
}
template <bool WITH_Q>
__device__ __forceinline__ void mlstm_pref_to_lds(const MPref& p, LAS bf16* rawq, LAS bf16* rawk, LAS bf16* Vt, int tid) {
    if (WITH_Q) *(LAS u32x4*)(rawq + (3 + (tid >> 3)) * 64 + (tid & 7) * 8) = p.tq;
    *(LAS u32x4*)(rawk + (3 + (tid >> 3)) * 64 + (tid & 7) * 8) = p.tk;
    *(LAS u32x4*)(Vt + (tid >> 4) * 128 + (tid & 15) * 8) = fp8x8_to_bf16x8(p.tv0);
    *(LAS u32x4*)(Vt + (32 + (tid >> 4)) * 128 + (tid & 15) * 8) = fp8x8_to_bf16x8(p.tv1);
    if (tid < 48) { const int hk = tid >= 24, t2 = tid - 24 * hk; if (WITH_Q || hk) *(LAS u32x4*)((hk ? rawk : rawq) + (t2 >> 3) * 64 + (t2 & 7) * 8) = p.th; }
}
__device__ __forceinline__ float conv_tile(LAS bf16* out, const LAS bf16* raw, const float (&cf)[5], float scale, const LAS float* ws, int tid) {
    const int c = tid & 63, rg = tid >> 6;
    const float cw0 = cf[0], cw1 = cf[1], cw2 = cf[2], cw3 = cf[3], cb = cf[4];
    float u0 = bf2f(raw[(rg * 8 + 0) * 64 + c]), u1 = bf2f(raw[(rg * 8 + 1) * 64 + c]), u2 = bf2f(raw[(rg * 8 + 2) * 64 + c]);
    float nsum = 0.f;
#pragma unroll
    for (int i = 0; i < 8; ++i) { const int sI = rg * 8 + i;
        const float cur = bf2f(raw[(sI + 3) * 64 + c]);
        const float y = cb + cw0 * u0 + cw1 * u1 + cw2 * u2 + cw3 * cur;
        const bf16 o = f2bf(silu_(y) * scale * (ws ? ws[sI] : 1.f));
        out[sI * 72 + c] = o; nsum += bf2f(o);
        u0 = u1; u1 = u2; u2 = cur; }
    return nsum;
}
struct WdtH { float v[16]; };
__device__ __forceinline__ void wdt_h_load(const Args& a, int gwv, int NGWv, int sh, int lane_in, WdtH& w) {
    int lane = lane_in; asm volatile("" : "+v"(lane));
    const int it = gwv + (sh >> 1) * NGWv, h = sh & 1;
    const int e = it >> 9, q = it & 511, kb = q >> 5, nb = q & 31, k0 = 64 * kb + 32 * h;
    const float* W = a.in[I_WD] + (size_t)e * DFF * D + (size_t)k0 * D + 32 * nb + (lane & 31);
#pragma unroll
    for (int i = 0; i < 16; ++i) w.v[i] = __builtin_nontemporal_load(W + (size_t)(2 * i + (lane >> 5)) * D);
}
__device__ __forceinline__ void wdt_h_store(const Args& a, int gwv, int NGWv, int sh, int lane_in, const WdtH& w, LAS float* scr) {
    int lane = lane_in; asm volatile("" : "+v"(lane));
    const int it = gwv + (sh >> 1) * NGWv, h = sh & 1;
    const int e = it >> 9, q = it & 511, kb = q >> 5, nb = q & 31, k0 = 64 * kb + 32 * h;
    unsigned char* WT = a.ws + WS_WDT + (size_t)e * D * DFF;
#pragma unroll
    for (int i = 0; i < 16; ++i) scr[(2 * i + (lane >> 5)) * 33 + (lane & 31)] = w.v[i];
    LDS_WAIT();
    const int c = lane & 3;
#pragma unroll
    for (int j = 0; j < 2; ++j) { const int n = (lane >> 2) + 16 * j; const LAS float* sp = scr + (8 * c) * 33 + n;
        const u32x2 o = {pk4_fp8(sp[0 * 33] * WQ_SCALE, sp[1 * 33] * WQ_SCALE, sp[2 * 33] * WQ_SCALE, sp[3 * 33] * WQ_SCALE), pk4_fp8(sp[4 * 33] * WQ_SCALE, sp[5 * 33] * WQ_SCALE, sp[6 * 33] * WQ_SCALE, sp[7 * 33] * WQ_SCALE)};
        *(u32x2*)(WT + (size_t)(32 * nb + n) * DFF + k0 + 8 * c) = o; }
    LDS_WAIT();
}
__device__ __forceinline__ void mlstm_A_phase(const Args& a, Frame& F) {
    const int tid = F.tid, lane = F.lane, wave = F.wave, r = lane & 31, hh = lane >> 5;
    LAS bf16* rawk = (LAS bf16*)(F.lds);
    LAS bf16* Vt = (LAS bf16*)(F.lds + 8704);
    LAS bf16* kw = (LAS bf16*)(F.lds + 25088);
    LAS float* wS = (LAS float*)(F.lds + 34304);
    LAS float* nsum = (LAS float*)(F.lds + 34560);
    MPref p; p.ip = 0.f; p.lf = 0.f;
    if (F.vcu < NUNIT) mlstm_prefetch<false>(a, F.vcu, tid, p);
    const int gwv = F.vcu * NWAVES + wave, NGWv = F.G * NWAVES, nh = 2 * ((32 * 16 * 32 - gwv + NGWv - 1) / NGWv);
    LAS float* dscr = (LAS float*)(F.lds + 40960 + wave * 4352);
    WdtH wh; int sh = 0;
    for (int u = F.vcu; u < NUNIT; u += F.G) {
        mlstm_pref_to_lds<false>(p, rawk, rawk, Vt, tid);
        if (wave == 0) {
            const float bc = wave_scan_add(p.lf, lane);
            const float blast = __shfl(bc, 63);
            const float av = blast - bc + p.ip;
            const float mloc = wave_max(av);
            wS[lane] = __expf(av - mloc);
            if (lane == 0) { ((float*)(a.ws + WS_ML))[u] = mloc; ((float*)(a.ws + WS_BL))[u] = blast; }
        }
        __syncthreads();
        float ckc[5];
#pragma unroll
        for (int j = 0; j < 5; ++j) ckc[j] = p.ck[j];
        mlstm_prefetch<false>(a, (u + F.G < NUNIT) ? u + F.G : u, tid, p);
        const int shc = sh < nh ? sh : nh - 1; wdt_h_load(a, gwv, NGWv, shc, lane, wh);
        nsum[(tid >> 6) * 64 + (tid & 63)] = conv_tile(kw, rawk, ckc, 0.125f, wS, tid);
        __syncthreads();
        {
            const int vt = wave & 3, kt = wave >> 2;
            f32x16 acc = {};
#pragma unroll
            for (int st = 0; st < 4; ++st) acc = __builtin_amdgcn_mfma_f32_32x32x16_bf16(gather8(Vt, 128, 16 * st + 8 * hh, 32 * vt + r), gather8(kw, 72, 16 * st + 8 * hh, 32 * kt + r), acc, 0, 0, 0);
            bf16* Cl = (bf16*)(a.ws + WS_CL) + (size_t)u * 8192;
            int rs_ = r, hs_ = hh; asm volatile("" : "+v"(rs_), "+v"(hs_));
#pragma unroll
            for (int i = 0; i < 16; ++i) Cl[(32 * vt + crow(i, hs_)) * 64 + 32 * kt + rs_] = f2bf(acc[i]);
            if (tid < 64) { float sN = 0.f;
#pragma unroll
                for (int g = 0; g < 8; ++g) sN += nsum[g * 64 + tid];
                ((float*)(a.ws + WS_NL))[(size_t)u * 64 + tid] = sN; }
        }
        wdt_h_store(a, gwv, NGWv, shc, lane, wh, dscr); ++sh;
        __syncthreads();
    }
    for (; sh < nh; ++sh) { wdt_h_load(a, gwv, NGWv, sh, lane, wh); wdt_h_store(a, gwv, NGWv, sh, lane, wh, dscr); }
}

__device__ __forceinline__ void phase4_scan(const Args& a, Frame& F) {
    const int tid = F.tid;
    LAS float* sd = (LAS float*)F.lds;
    const float* ml = (const float*)(a.ws + WS_ML); const float* bl = (const float*)(a.ws + WS_BL);
    for (int item = F.bx; item < 256; item += F.G) {
        const int bh = item >> 2, qtr = item & 3;
        const int e4 = qtr * 512 + tid;
        const bf16* Cl = (const bf16*)(a.ws + WS_CL) + (size_t)bh * 64 * 8192 + 4 * e4;
        bf16* Cp = (bf16*)(a.ws + WS_CPREV) + (size_t)bh * 64 * 8192 + 4 * e4;
        u32x2 clv[64];
#pragma unroll
        for (int n = 0; n < 64; ++n) clv[n] = __builtin_nontemporal_load((const u32x2*)(Cl + (size_t)n * 8192));
        if (tid < 64) { sd[192 + tid] = ml[bh * 64 + tid]; sd[256 + tid] = bl[bh * 64 + tid]; }
        __syncthreads();
        if (tid == 0) { float m = 0.f;
            for (int n = 0; n < 64; ++n) { const float mlv = sd[192 + n], blv = sd[256 + n]; sd[128 + n] = m; const float mn = fmaxf(blv + m, mlv); sd[n] = __expf(blv + m - mn); sd[64 + n] = __expf(mlv - mn); m = mn; } }
        __syncthreads();
        float c0 = 0.f, c1 = 0.f, c2 = 0.f, c3 = 0.f;
#pragma unroll
        for (int n = 0; n < 64; ++n) {
            *(u32x2*)(Cp + (size_t)n * 8192) = (u32x2){pk2(c0, c1), pk2(c2, c3)};
            const u32x2 cl = clv[n];
            const float d = sd[n], f = sd[64 + n];
            c0 = d * c0 + f * bf2f(cl.x & 0xffffu); c1 = d * c1 + f * bf2f(cl.x >> 16); c2 = d * c2 + f * bf2f(cl.y & 0xffffu); c3 = d * c3 + f * bf2f(cl.y >> 16);
        }
        if (qtr == 0 && tid < 16) {
            const float* nl = (const float*)(a.ws + WS_NL) + (size_t)bh * 64 * 64 + 4 * tid; float* np = (float*)(a.ws + WS_NPREV) + (size_t)bh * 64 * 64 + 4 * tid;
            f32x4 nn = {0.f, 0.f, 0.f, 0.f};
            for (int n = 0; n < 64; ++n) { *(f32x4*)(np + n * 64) = nn; const f32x4 l4 = *(const f32x4*)(nl + n * 64); nn = nn * sd[n] + l4 * sd[64 + n]; }
        }
        if (qtr == 0 && tid >= 64 && tid < 128) ((float*)(a.ws + WS_MPREV))[bh * 64 + tid - 64] = sd[128 + tid - 64];
        __syncthreads();
    }
}

__device__ __forceinline__ void mlstm_C_phase(const Args& a, Frame& F) {
    const int tid = F.tid, lane = F.lane, wave = F.wave, r = lane & 31, hh = lane >> 5;
    const bf16* P = (const bf16*)(a.ws + WS_P);
    LAS bf16* rawq = (LAS bf16*)(F.lds);
    LAS bf16* rawk = (LAS bf16*)(F.lds + 8704);
    LAS bf16* Vt = (LAS bf16*)(F.lds + 17408);
    LAS bf16* qc = (LAS bf16*)(F.lds + 33792);
    LAS bf16* kc = (LAS bf16*)(F.lds + 43008);
    LAS bf16* Sb = (LAS bf16*)(F.lds + 52224);
    LAS float* gS = (LAS float*)(F.lds + 61440);
    LAS float* Ms = (LAS float*)(F.lds + 61696);
    LAS float* bs = (LAS float*)(F.lds + 61952);
    LAS float* ssum = (LAS float*)(F.lds + 62208);
    LAS float* npl = (LAS float*)(F.lds + 63232);
    const int tt = wave >> 2, vt = wave & 3;
    MPref p; p.ip = 0.f; p.lf = 0.f; p.mp = 0.f;
    if (F.vcu < NUNIT) mlstm_prefetch<true>(a, F.vcu, tid, p);
    const int gwv = F.vcu * NWAVES + wave, NGWv = F.G * NWAVES, nq = 4 * ((32 * 16 * 32 - gwv + NGWv - 1) / NGWv);
    LAS float* cscr = (LAS float*)(F.lds + 65536 + wave * 2304); LAS unsigned char* cib = F.lds + 65536 + 8 * 2304 + wave * 4096;
#define WQ_IDX(s_) ((s_) < nq ? (s_) : nq - 1)
    WguQ w1, w2; int sload = 0, s1 = 0, s2 = 0;
    s2 = WQ_IDX(sload); ++sload; wgu_q_load(a, gwv, NGWv, s2, lane, w2);
    for (int u = F.vcu; u < NUNIT; u += F.G) {
        const int b = u >> 8, h = (u >> 6) & 3, n = u & 63;
        const long r0 = (long)b * SEQ + (long)n * 64;
        const float mp = p.mp;
        int rg_ = r, hg_ = hh; asm volatile("" : "+v"(rg_), "+v"(hg_));
        mlstm_pref_to_lds<true>(p, rawq, rawk, Vt, tid);
        if (tid < 16) *(LAS f32x4*)(npl + 4 * tid) = p.npv;
        if (wave == 0) {
            const float bc = wave_scan_add(p.lf, lane);
            const float g = p.ip - bc;
            const float cm = wave_scan_max(g, lane);
            gS[lane] = g; Ms[lane] = fmaxf(mp, cm); bs[lane] = bc;
        }
        const bf16* Cp = (const bf16*)(a.ws + WS_CPREV) + (size_t)u * 8192;
        bf16x8 cfr[4];
#pragma unroll
        for (int st = 0; st < 4; ++st) cfr[st] = __builtin_nontemporal_load((const bf16x8*)(Cp + (32 * vt + rg_) * 64 + 16 * st + 8 * hg_));
        unsigned mo2[4]; f32x4 gv4[4];
#pragma unroll
        for (int g = 0; g < 4; ++g) { mo2[g] = *(const unsigned*)(a.ws + WS_P8 + (size_t)(r0 + 32 * tt + rg_) * 1024 + 512 + h * 128 + 32 * vt + 8 * g + 4 * hg_);
            gv4[g] = *(const f32x4*)(a.in[I_MNG] + h * 128 + 32 * vt + 8 * g + 4 * hg_); }
        wgu_q_store(a, gwv, NGWv, s2, lane, w2, cscr, cib);
        __syncthreads();
        float cqc[5], ckc[5];
#pragma unroll
        for (int j = 0; j < 5; ++j) { cqc[j] = p.cq[j]; ckc[j] = p.ck[j]; }
        mlstm_prefetch<true>(a, (u + F.G < NUNIT) ? u + F.G : u, tid, p);
        s1 = WQ_IDX(sload); ++sload; wgu_q_load(a, gwv, NGWv, s1, lane, w1);
        (void)conv_tile(qc, rawq, cqc, 1.f, nullptr, tid);
        (void)conv_tile(kc, rawk, ckc, 0.125f, nullptr, tid);
        __syncthreads();
        wgu_q_store(a, gwv, NGWv, s1, lane, w1, cscr, cib);
        if (wave < 3) {
            const int ts = wave > 0, st = wave > 1;
            f32x16 acc = {};
#pragma unroll
            for (int kk = 0; kk < 4; ++kk) acc = __builtin_amdgcn_mfma_f32_32x32x16_bf16(*(const LAS bf16x8*)(qc + (32 * ts + r) * 72 + 16 * kk + 8 * hh), *(const LAS bf16x8*)(kc + (32 * st + r) * 72 + 16 * kk + 8 * hh), acc, 0, 0, 0);
            const int sabs = 32 * st + r; const float gs = gS[sabs];
#pragma unroll
            for (int i = 0; i < 16; ++i) { const int tabs = 32 * ts + crow(i, hh);
                const float val = (sabs <= tabs) ? acc[i] * __expf(gs - Ms[tabs]) : 0.f;
                Sb[tabs * 72 + sabs] = f2bf(val); }
        }
        __syncthreads();
        f32x16 outv;
        {
            bf16x8 qa[4], sa[4];
#pragma unroll
            for (int st = 0; st < 4; ++st) { qa[st] = *(const LAS bf16x8*)(qc + (32 * tt + r) * 72 + 16 * st + 8 * hh);
                sa[st] = (st < 2 * (tt + 1)) ? *(const LAS bf16x8*)(Sb + (32 * tt + r) * 72 + 16 * st + 8 * hh) : (bf16x8){0, 0, 0, 0, 0, 0, 0, 0}; }
            f32x16 d1 = {}, d2 = {}, a1 = {}, a2 = {};
            const short one = (r == 0) ? (short)0x3F80 : (short)0;
            const bf16x8 ones = {one, one, one, one, one, one, one, one};
#pragma unroll
            for (int st = 0; st < 4; ++st) {
                d1 = __builtin_amdgcn_mfma_f32_32x32x16_bf16(ones, sa[st], d1, 0, 0, 0);
                { const f32x4 n0 = *(const LAS f32x4*)(npl + 16 * st + 8 * hh), n1 = *(const LAS f32x4*)(npl + 16 * st + 8 * hh + 4);
                  const u32x4 pk = {pk2(n0.x, n0.y), pk2(n0.z, n0.w), pk2(n1.x, n1.y), pk2(n1.z, n1.w)}; const u32x4 zz = {0u, 0u, 0u, 0u};
                  d2 = __builtin_amdgcn_mfma_f32_32x32x16_bf16(__builtin_bit_cast(bf16x8, (r == 0) ? pk : zz), qa[st], d2, 0, 0, 0); }
                a1 = __builtin_amdgcn_mfma_f32_32x32x16_bf16(gather8(Vt, 128, 16 * st + 8 * hh, 32 * vt + r), sa[st], a1, 0, 0, 0);
                a2 = __builtin_amdgcn_mfma_f32_32x32x16_bf16(cfr[st], qa[st], a2, 0, 0, 0);
            }
            const int tabs = 32 * tt + r;
            const float Mt = Ms[tabs], iw = __expf(mp - Mt);
            float den = d1[0] + iw * d2[0];
            den += __shfl_xor(den, 32);
            const float inv = rcp_(fmaxf(fabsf(den), __expf(-(bs[tabs] + Mt))));
            float sq = 0.f;
#pragma unroll
            for (int i = 0; i < 16; ++i) { const float o = (a1[i] + iw * a2[i]) * inv; outv[i] = o; sq += o * o; }
            sq += __shfl_xor(sq, 32);
            if (hh == 0) ssum[tabs * 4 + vt] = sq;
        }
        __syncthreads();
        s2 = WQ_IDX(sload); ++sload; wgu_q_load(a, gwv, NGWv, s2, lane, w2);
        {
            unsigned char* cat = a.ws + WS_H;
            int rs_ = r, hs_ = hh; asm volatile("" : "+v"(rs_), "+v"(hs_));
            const f32x4 s4 = *(const LAS f32x4*)(ssum + (32 * tt + r) * 4);
            const float rsn = rsq_(((s4.x + s4.y) + (s4.z + s4.w)) * (1.f / 128.f) + EPS);
#pragma unroll
            for (int g = 0; g < 4; ++g) {
                const f32x2 mq0 = __builtin_amdgcn_cvt_pk_f32_fp8((int)mo2[g], false), mq1 = __builtin_amdgcn_cvt_pk_f32_fp8((int)mo2[g], true); const float m0 = mq0.x, m1 = mq0.y, m2 = mq1.x, m3 = mq1.y;
                const float o0 = outv[4 * g] * rsn * gv4[g].x * sigmoidf_(m0), o1 = outv[4 * g + 1] * rsn * gv4[g].y * sigmoidf_(m1);
                const float o2 = outv[4 * g + 2] * rsn * gv4[g].z * sigmoidf_(m2), o3 = outv[4 * g + 3] * rsn * gv4[g].w * sigmoidf_(m3);
                *(unsigned*)(cat + (size_t)(r0 + 32 * tt + rs_) * D + h * 128 + 32 * vt + 8 * g + 4 * hs_) = pk4_fp8(o0, o1, o2, o3);
            }
        }
        __syncthreads();
    }
    wgu_q_store(a, gwv, NGWv, s2, lane, w2, cscr, cib);
    for (; sload < nq; ++sload) { wgu_q_load(a, gwv, NGWv, sload, lane, w1); wgu_q_store(a, gwv, NGWv, sload, lane, w1, cscr, cib); }
#undef WQ_IDX
}
__device__ __forceinline__ bool rt_better(float av, int ae, float bv, int be) { return av > bv || (av == bv && ae < be); }
__device__ __forceinline__ void phase7(const Args& a, Frame& F) {
    const int wave = F.wave;
    LAS float* gsl = (LAS float*)(F.lds + LDSCTL_OFF + 4096);
    LAS float* shl = (LAS float*)(F.lds + LDSCTL_OFF + 8192);
    LAS float* rsl = (LAS float*)(F.lds + LDSCTL_OFF + 12288);
    LAS float* cbl = (LAS float*)(F.lds + LDSCTL_OFF + 2048);
    LAS float* region = (LAS float*)F.lds;
    LAS float* fin = (LAS float*)(F.lds + 73728);
    LAS float* ssp = (LAS float*)(F.lds + 106496);
    LAS float* cbp = (LAS float*)(F.lds + 108544);
    const float* Wt = (const float*)(a.ws + WS_WRT);
    LAS int* lcount = (LAS int*)(F.lds + TAB_OFF + 160);
    LAS int* lbase = (LAS int*)(F.lds + TAB_OFF + 320);
    if (F.tid < 32) lcount[F.tid] = 0;
    const float* x = a.in[I_X]; const float* g2 = a.in[I_N2G]; const float* mod = (const float*)(a.ws + WS_MOD); const float* brt = a.in[I_BR];
    const unsigned char* mixg = a.ws + WS_MIXG; unsigned char* h2 = a.ws + WS_H;
    unsigned* meta = (unsigned*)(a.ws + WS_META); float* gatew = (float*)(a.ws + WS_GATEW);
    unsigned* gcnt = F.ctl + CW_GCNT; int* wgbase = (int*)(a.ws + WS_WGBASE);
    for (int rb = F.bx; rb < NTOK / 256; rb += F.G) {
        int tid_ = F.tid; asm volatile("" : "+v"(tid_));
        const int tid = tid_, lane = tid & 63;
        const int b = rb >> 4;
        f32x4 wq_[16];
        { const int e = tid & 31, part = tid >> 5;
#pragma unroll
          for (int q = 0; q < 16; ++q) wq_[q] = *(const f32x4*)(Wt + (size_t)(16 * part + q) * 128 + e * 4); }
        __syncthreads();
        for (int k = tid; k < 1024; k += 512) { gsl[k] = g2[k] * (1.f + mod[b * 6144 + 4096 + k]); shl[k] = mod[b * 6144 + 3072 + k]; }
        __syncthreads();
        {
            const int e = tid & 31, part = tid >> 5; float sacc = 0.f;
#pragma unroll
            for (int q = 0; q < 16; ++q) { const f32x4 w4 = wq_[q]; const f32x4 s4 = *(const LAS f32x4*)(shl + 64 * part + 4 * q);
                sacc += (w4.x * s4.x + w4.y * s4.y) + (w4.z * s4.z + w4.w * s4.w); }
            cbp[part * 32 + e] = sacc;
        }
        __syncthreads();
        if (tid < 32) { float sacc = brt[tid];
#pragma unroll
            for (int q = 0; q < 16; ++q) sacc += cbp[q * 32 + tid];
            cbl[tid] = sacc; }
        const int wrow0 = rb * 256 + wave * 32;
        {
            const int lr = lane >> 3, pc = lane & 7, rl = lane & 31, kk = lane >> 5, kbase = wave * 128;
            const unsigned lo_h = (unsigned)(lr * D + 4 * pc), lo_m = 2u * lo_h, lo_x = 4u * lo_h, lo_w = (unsigned)((4 * kk * 128 + rl * 4) * 4);
            const char* xu = (const char*)(x + (size_t)(rb * 256) * D + kbase); const char* mu = (const char*)(mixg + (size_t)(rb * 256) * D + kbase);
            unsigned char* hu = h2 + (size_t)(rb * 256) * D + kbase; const char* wu = (const char*)(Wt + (size_t)(kbase / 4) * 128);
            f32x4 xa[4], xb[4], xc[4], xd[4], wv[4]; unsigned ma[4], mb[4], mc[4], md[4];
            u32x2 hb[4][4]; f32x16 acc; float ss4[4];
#define P7_LOAD(xv, mv, T, S) do { _Pragma("unroll") for (int i = 0; i < 4; ++i) { const size_t ro_ = (size_t)(32 * (T) + 8 * i) * D + 32 * (S); \
                xv[i] = __builtin_nontemporal_load((const f32x4*)(xu + ro_ * 4 + ox)); mv[i] = *(const unsigned*)(mu + ro_ + oh); } } while (0)
#define P7_LOADW(wv, S) do { _Pragma("unroll") for (int q = 0; q < 4; ++q) wv[q] = *(const f32x4*)(wu + (size_t)((8 * (S) + q) * 512) + ow); } while (0)
#define P7_COMP(xv, mv, S, SN) do { const f32x4 g4 = *(const LAS f32x4*)(gsl + kbase + 32 * (S) + 4 * pc); \
                _Pragma("unroll") for (int i = 0; i < 4; ++i) { f32x4 v = xv[i]; \
                    { const f32x2 m01 = __builtin_amdgcn_cvt_pk_f32_fp8((int)mv[i], false), m23 = __builtin_amdgcn_cvt_pk_f32_fp8((int)mv[i], true); \
                      v.x += m01.x * (1.f / MIX_SCALE); v.y += m01.y * (1.f / MIX_SCALE); v.z += m23.x * (1.f / MIX_SCALE); v.w += m23.y * (1.f / MIX_SCALE); } \
                    ss4[i] += (v.x * v.x + v.y * v.y) + (v.z * v.z + v.w * v.w); \
                    const f32x4 h = v * g4; \
                    *(LAS f32x4*)(slab + (8 * i + lr) * 36 + 4 * pc) = h; hb[S][i] = (u32x2){pk2(h.x, h.y), pk2(h.z, h.w)}; } \
                LDS_WAIT(); \
                f32x4 hq[4]; \
                _Pragma("unroll") for (int q = 0; q < 4; ++q) hq[q] = *(const LAS f32x4*)(slab + rl * 36 + 16 * kk + 4 * q); \
                LDS_WAIT(); \
                _Pragma("unroll") for (int q = 0; q < 4; ++q) { \
                    acc = __builtin_amdgcn_mfma_f32_32x32x2f32(wv[q].x, hq[q].x, acc, 0, 0, 0); acc = __builtin_amdgcn_mfma_f32_32x32x2f32(wv[q].y, hq[q].y, acc, 0, 0, 0); \
                    acc = __builtin_amdgcn_mfma_f32_32x32x2f32(wv[q].z, hq[q].z, acc, 0, 0, 0); acc = __builtin_amdgcn_mfma_f32_32x32x2f32(wv[q].w, hq[q].w, acc, 0, 0, 0); \
                    wv[q] = *(const f32x4*)(wu + (size_t)((8 * (SN) + q) * 512) + ow); } } while (0)
            unsigned ox = lo_x, om = lo_m, oh = lo_h, ow = lo_w;
            P7_LOAD(xa, ma, 0, 0); P7_LOAD(xb, mb, 0, 1); P7_LOADW(wv, 0);
#pragma unroll 1
            for (int t = 0; t < 8; ++t) {
                asm volatile("" : "+v"(ox), "+v"(om), "+v"(oh), "+v"(ow));
                const int tn = (t + 1 < 8) ? t + 1 : 7;
                LAS float* slab = region + ((t & 1) * 8 + wave) * 1152;
                LAS float* sspb = ssp + (t & 1) * 256;
#pragma unroll
                for (int i = 0; i < 16; ++i) acc[i] = 0.f;
#pragma unroll
                for (int i = 0; i < 4; ++i) ss4[i] = 0.f;
#define P7_SB __builtin_amdgcn_sched_barrier(0)
                P7_SB; P7_LOAD(xc, mc, t, 2);  P7_SB; P7_COMP(xa, ma, 0, 1);
                P7_SB; P7_LOAD(xd, md, t, 3);  P7_SB; P7_COMP(xb, mb, 1, 2);
                P7_SB; P7_LOAD(xa, ma, tn, 0); P7_SB; P7_COMP(xc, mc, 2, 3);
                P7_SB; P7_LOAD(xb, mb, tn, 1); P7_SB; P7_COMP(xd, md, 3, 0); P7_SB;
#undef P7_SB
#pragma unroll
                for (int i = 0; i < 4; ++i) { float sv = ss4[i]; sv += __shfl_xor(sv, 1); sv += __shfl_xor(sv, 2); sv += __shfl_xor(sv, 4); ss4[i] = sv; }
                if (pc == 0) {
#pragma unroll
                    for (int i = 0; i < 4; ++i) sspb[wave * 32 + 8 * i + lr] = ss4[i]; }
#pragma unroll
                for (int i = 0; i < 16; ++i) slab[i * 64 + lane] = acc[i];
                LDS_WAIT(); asm volatile("" ::: "memory"); __builtin_amdgcn_s_barrier(); asm volatile("" ::: "memory");
                float rs4[4];
#pragma unroll
                for (int i = 0; i < 4; ++i) { float sv = 0.f;
#pragma unroll
                    for (int w = 0; w < 8; ++w) sv += sspb[w * 32 + 8 * i + lr];
                    rs4[i] = rsq_(sv * (1.f / D) + EPS); }
                if (wave == 0 && pc == 0) {
#pragma unroll
                    for (int i = 0; i < 4; ++i) rsl[t * 32 + 8 * i + lr] = rs4[i]; }
                {
                    const LAS float* rt = region + (t & 1) * 8 * 1152;
#pragma unroll
                    for (int o = 0; o < 2; ++o) { float sv = 0.f;
#pragma unroll
                        for (int w = 0; w < 8; ++w) sv += rt[w * 1152 + o * 512 + tid];
                        fin[t * 1024 + o * 512 + tid] = sv; } }
#pragma unroll
                for (int S = 0; S < 4; ++S) { const f32x4 s4 = *(const LAS f32x4*)(shl + kbase + 32 * S + 4 * pc);
#pragma unroll
                    for (int i = 0; i < 4; ++i) { const u32x2 hv = hb[S][i];
                        *(unsigned*)(hu + (size_t)(32 * t + 8 * i) * D + 32 * S + oh) = pk4_fp8(bf2f(hv.x & 0xffffu) * rs4[i] + s4.x, bf2f(hv.x >> 16) * rs4[i] + s4.y, bf2f(hv.y & 0xffffu) * rs4[i] + s4.z, bf2f(hv.y >> 16) * rs4[i] + s4.w); } }
            }
#undef P7_LOAD
#undef P7_LOADW
#undef P7_COMP
        }
        __syncthreads();
        f32x16 acc; u32x4 mk4 = {0u, 0u, 0u, 0u};
        { const float rsr = rsl[wave * 32 + (lane & 31)];
#pragma unroll
          for (int i = 0; i < 16; ++i) acc[i] = fin[wave * 1024 + i * 64 + lane] * rsr; }
        {
            const int hh = lane >> 5;
            float v[16];
#pragma unroll
            for (int i = 0; i < 16; ++i) v[i] = acc[i] + cbl[crow(i, hh)];
            float cv[8]; int ce[8];
#pragma unroll
            for (int k = 0; k < 4; ++k) { float bv = v[0]; int bi_ = 0;
#pragma unroll
                for (int i = 1; i < 16; ++i) { if (v[i] > bv) { bv = v[i]; bi_ = i; } }
                cv[k] = bv; ce[k] = crow(bi_, hh);
#pragma unroll
                for (int i = 0; i < 16; ++i) v[i] = (i == bi_) ? -INFINITY : v[i]; }
#pragma unroll
            for (int k = 0; k < 4; ++k) { cv[4 + k] = __shfl_xor(cv[k], 32); ce[4 + k] = __shfl_xor(ce[k], 32); }
            float tv[4]; int te[4];
#pragma unroll
            for (int k = 0; k < 4; ++k) { float bv = cv[0]; int be = ce[0], bj = 0;
#pragma unroll
                for (int j = 1; j < 8; ++j) { if (rt_better(cv[j], ce[j], bv, be)) { bv = cv[j]; be = ce[j]; bj = j; } }
                tv[k] = bv; te[k] = be;
#pragma unroll
                for (int j = 0; j < 8; ++j) cv[j] = (j == bj) ? -INFINITY : cv[j]; }
            const float p1 = __expf(tv[1] - tv[0]), p2 = __expf(tv[2] - tv[0]), p3 = __expf(tv[3] - tv[0]); const float isum = rcp_(1.f + p1 + p2 + p3);
            if (hh == 0) {
                const int row = wrow0 + lane;
                u32x4 m4; const f32x4 g4 = {isum, p1 * isum, p2 * isum, p3 * isum};
#pragma unroll
                for (int k = 0; k < 4; ++k) { const int lr = __hip_atomic_fetch_add(lcount + (te[k] & 31), 1, __ATOMIC_RELAXED, __HIP_MEMORY_SCOPE_WORKGROUP); m4[k] = (unsigned)(te[k] & 31) | ((unsigned)lr << 8); }
                *(f32x4*)(gatew + (size_t)row * 4) = g4;
                mk4 = m4;
            }
        }
        __syncthreads();
        if (tid < 32) { const int c = lcount[tid]; const unsigned base = __hip_atomic_fetch_add(gcnt + tid, (unsigned)c, __ATOMIC_RELAXED, __HIP_MEMORY_SCOPE_AGENT); lbase[tid] = (int)base; lcount[tid] = 0; }
        __syncthreads();
        if ((lane >> 5) == 0) {
            const int row = rb * 256 + wave * 32 + lane; u32x4 m4 = mk4; int* rts = (int*)(a.ws + WS_ROWTOKS);
#pragma unroll
            for (int k = 0; k < 4; ++k) { const int e = m4[k] & 31, rank = lbase[e] + (int)(m4[k] >> 8); m4[k] = (unsigned)e | ((unsigned)rank << 8); rts[e * 65536 + rank] = row; }
            *(u32x4*)(meta + (size_t)row * 4) = m4;
        }
    }
    __syncthreads();
}

__device__ __forceinline__ void phase8(const Args& a, Frame& F) {
    const int tid = F.tid;
    LAS int* pstart = (LAS int*)(F.lds + TAB_OFF + 320);
    LAS int* cntl = (LAS int*)(F.lds + TAB_OFF + 480);
    const unsigned* gcnt = F.ctl + CW_GCNT;
    if (tid < 64) {
        const int c = (tid < 32) ? (int)gcnt[tid] : 0; const int pad = ((c + 255) >> 8) << 8;
        int inc = pad;
#pragma unroll
        for (int o = 1; o < 32; o <<= 1) { const int t = __shfl_up(inc, o); if ((tid & 63) >= o) inc += t; }
        if (tid < 32) { cntl[tid] = c; pstart[tid] = inc - pad; }
        if (tid == 31) pstart[32] = inc;
    }
    __syncthreads();
    const unsigned* meta = (const unsigned*)(a.ws + WS_META); const int* wgbase = (const int*)(a.ws + WS_WGBASE);
    int* pos = (int*)(a.ws + WS_POS); int* rowtok = (int*)(a.ws + WS_ROWTOK);
    for (int slot = F.bx * 512 + tid; slot < NSLOT; slot += F.G * 512) {
        const unsigned m = meta[slot]; const int e = m & 255, lr = m >> 8, row = slot >> 2, rb = row >> 8;
        const int dest = pstart[e] + wgbase[rb * 32 + e] + lr;
        pos[slot] = dest; rowtok[dest] = row;
    }
    for (int e = F.bx; e < 32; e += F.G) for (int d = pstart[e] + cntl[e] + tid; d < pstart[e + 1]; d += 512) rowtok[d] = 0;
}
__device__ __forceinline__ const LAS int* moe_tiles(Frame& F) {
    LAS int* ptile = (LAS int*)(F.lds + TAB_OFF);
    const unsigned* gcnt = F.ctl + CW_GCNT;
    if (F.tid < 64) {
        const int nt_ = (F.tid < 32) ? (((int)gcnt[F.tid] + 255) >> 8) : 0;
        int inc = nt_;
#pragma unroll
        for (int o = 1; o < 32; o <<= 1) { const int t = __shfl_up(inc, o); if ((F.tid & 63) >= o) inc += t; }
        if (F.tid < 32) { ptile[F.tid] = inc - nt_; ((LAS int*)(F.lds + TAB_OFF + 480))[F.tid] = (int)gcnt[F.tid]; }
        if (F.tid == 31) ptile[32] = inc;
    }
    __syncthreads();
    {
        LAS unsigned char* texp = (LAS unsigned char*)(F.lds + TAB_OFF + 640);
        for (int t = F.tid; t < MAXTILES; t += NWAVES * 64) { int e = 0;
#pragma unroll
            for (int sft = 16; sft >= 1; sft >>= 1) { if (ptile[e + sft] <= t) e += sft; }
            texp[t] = (unsigned char)e; }
    }
    __syncthreads();
    return ptile;
}

__device__ __forceinline__ void phase11(const Args& a, Frame& F, bool have_tiles) {
    const int lane = F.lane;
    const float* x = a.in[I_X]; const float* mod = (const float*)(a.ws + WS_MOD);
    const unsigned char* mixg = a.ws + WS_MIXG; const unsigned char* orow = a.ws + WS_OUTROWS;
    const unsigned* meta = (const unsigned*)(a.ws + WS_META); const float* gatew = (const float*)(a.ws + WS_GATEW);
    const LAS int* ptile = have_tiles ? (const LAS int*)(F.lds + TAB_OFF) : moe_tiles(F);
    const int gw = F.vcu * NWAVES + F.wave, NGW = F.G * NWAVES;
    for (int row = gw; row < NTOK; row += NGW) {
        const int b = row >> 12;
        const u32x4 mq = *(const u32x4*)(meta + (size_t)row * 4);
        const int p0 = ptile[mq.x & 31] * 256 + (int)(mq.x >> 8), p1 = ptile[mq.y & 31] * 256 + (int)(mq.y >> 8), p2 = ptile[mq.z & 31] * 256 + (int)(mq.z >> 8), p3 = ptile[mq.w & 31] * 256 + (int)(mq.w >> 8);
        const f32x4 gk = *(const f32x4*)(gatew + (size_t)row * 4);
#pragma unroll
        for (int j = 0; j < 4; ++j) {
            const int col = 256 * j + 4 * lane; const size_t off = (size_t)row * D + col;
            const f32x4 xv = __builtin_nontemporal_load((const f32x4*)(x + off)); const unsigned mg = __builtin_nontemporal_load((const unsigned*)(mixg + off));
            const f32x2 mg01 = __builtin_amdgcn_cvt_pk_f32_fp8((int)mg, false), mg23 = __builtin_amdgcn_cvt_pk_f32_fp8((int)mg, true);
            const f32x4 g2 = *(const f32x4*)(mod + b * 6144 + 5120 + col);
            const unsigned e0 = *(const unsigned*)(orow + (size_t)p0 * D + col), e1 = *(const unsigned*)(orow + (size_t)p1 * D + col), e2 = *(const unsigned*)(orow + (size_t)p2 * D + col), e3 = *(const unsigned*)(orow + (size_t)p3 * D + col);
            const f32x2 a0 = __builtin_amdgcn_cvt_pk_f32_fp8((int)e0, false), b0 = __builtin_amdgcn_cvt_pk_f32_fp8((int)e0, true), a1 = __builtin_amdgcn_cvt_pk_f32_fp8((int)e1, false), b1 = __builtin_amdgcn_cvt_pk_f32_fp8((int)e1, true);
            const f32x2 a2 = __builtin_amdgcn_cvt_pk_f32_fp8((int)e2, false), b2 = __builtin_amdgcn_cvt_pk_f32_fp8((int)e2, true), a3 = __builtin_amdgcn_cvt_pk_f32_fp8((int)e3, false), b3 = __builtin_amdgcn_cvt_pk_f32_fp8((int)e3, true);
            f32x4 m;
            m.x = gk.x * a0.x + gk.y * a1.x + gk.z * a2.x + gk.w * a3.x; m.y = gk.x * a0.y + gk.y * a1.y + gk.z * a2.y + gk.w * a3.y;
            m.z = gk.x * b0.x + gk.y * b1.x + gk.z * b2.x + gk.w * b3.x; m.w = gk.x * b0.y + gk.y * b1.y + gk.z * b2.y + gk.w * b3.y;
            f32x4 o; o.x = xv.x + mg01.x * (1.f / MIX_SCALE) + g2.x * m.x; o.y = xv.y + mg01.y * (1.f / MIX_SCALE) + g2.y * m.y; o.z = xv.z + mg23.x * (1.f / MIX_SCALE) + g2.z * m.z; o.w = xv.w + mg23.y * (1.f / MIX_SCALE) + g2.w * m.w;
            *(f32x4*)(a.out + off) = o;
        }
    }
}

__global__ void __launch_bounds__(NWAVES * 64, 2) hybrid_fwd(Args args) {
    extern __shared__ __attribute__((aligned(16))) unsigned char lds[];
    Frame F;
    F.lds = (LAS unsigned char*)lds;
    F.MISC = (volatile LAS unsigned*)(F.lds + MISC_OFF);
    F.tid = threadIdx.x; F.lane = F.tid & 63; F.wave = __builtin_amdgcn_readfirstlane(F.tid >> 6);
    F.G = gridDim.x; F.bx = blockIdx.x; F.vcu = (F.G % 8 == 0) ? (F.bx % 8) * (F.G / 8) + F.bx / 8 : F.bx;
    F.ctl = (unsigned*)(args.ws + WS_CTL);
    for (int u = F.tid; u < (LDS_BYTES - LDSCTL_OFF) / 4; u += NWAVES * 64) ((LAS unsigned*)(F.lds + LDSCTL_OFF))[u] = 0u;
    __syncthreads();
    XcdBarrier bar; bar.bar = F.ctl + CW_BAR; bar.x = 0; bar.st = nullptr;
    if (N_LAUNCHES == 1) bar = xcd_barrier_post(F.ctl + CW_BAR, F.MISC + 8);
    const int lo = args.ph_lo, hi = args.ph_hi;
#ifndef PH_MASK
#define PH_MASK 0xFFF
#endif
#define IN(k) (((PH_MASK >> (k)) & 1) && lo <= (k) && (k) < hi)
#define REFRESH() do { int t_ = threadIdx.x; asm volatile("" : "+v"(t_)); F.tid = t_; F.lane = t_ & 63; F.wave = __builtin_amdgcn_readfirstlane(t_ >> 6); } while (0)
#define SEAM(k) do { if (IN(k) && IN((k) + 1)) { if (N_LAUNCHES == 1) xcd_barrier(bar); } } while (0)
    unsigned char* ws = args.ws;

    if (IN(0)) { REFRESH(); phase0(args, F); } SEAM(0);
    if (IN(1)) { REFRESH(); phase1(args, F); } SEAM(1);
    if (IN(2)) { REFRESH();
        pg8::PlainOrder S; S.init(NTOK, NP, D, F.G, F.bx, ws + WS_H, ws + WS_WINT);
        typedef pg8::EpiInproj<(long long)WS_P8 - (long long)WS_P, (long long)WS_ROPE - (long long)WS_P, (long long)WS_GTAB - (long long)WS_P> EpiP;
        EpiP E{(bf16*)(ws + WS_P), NP};
        pg8::gemm_phase<EpiP, pg8::PlainOrder, false>(F.lds + RING_OFF, D, S, E, nullptr);
    } SEAM(2);
    if (IN(3)) { REFRESH();
        if (args.sub != 2) mlstm_A_phase(args, F);
    } SEAM(3);
    if (IN(4)) { REFRESH();
        const float s1_ = wave_sum(args.in[I_LQ1][F.lane] * args.in[I_LK1][F.lane]), s2_ = wave_sum(args.in[I_LQ2][F.lane] * args.in[I_LK2][F.lane]);
        const float lam = expf(s1_) - expf(s2_) + 0.2f;
        if (args.sub != 1) phase4_scan(args, F);
        if (IN(4) && IN(5)) { if (N_LAUNCHES == 1) xcd_barrier(bar); }
        if (args.sub != 2) {
            for (int item = F.vcu; item < 256; item += F.G) attn_body::attn_pair<8>((char*)lds + RING_OFF, (const attn_body::bf16*)(ws + WS_P), (attn_body::bf16*)(ws + WS_O), ws + WS_H, args.in[I_DNG], lam, item);
        }
    }
    if (IN(5)) { REFRESH();
        if (args.sub != 2) mlstm_C_phase(args, F);
    } SEAM(5);
    if (IN(6)) { REFRESH();
        pg8::PlainOrder S; S.init(NTOK, D, D, F.G, F.bx, ws + WS_H, ws + WS_WOUTT, 1, true);
        pg8::EpiScale<true> E{(bf16*)(ws + WS_MIXG), D, (const float*)(ws + WS_MOD) + 2048, 6144, MIX_SCALE / WQ_SCALE};
        pg8::gemm_phase<pg8::EpiScale<true>, pg8::PlainOrder, true, true>(F.lds + RING_OFF, D, S, E, (const int*)(ws + WS_IDENT));
    } SEAM(6);
    if (IN(7)) { REFRESH(); phase7(args, F); } SEAM(7);
    if (IN(9)) { REFRESH();
        const LAS int* ptile = moe_tiles(F);
        pg8::MoeOrder S{ptile[32], 8, F.G, F.bx, (const char*)(ws + WS_H), (const char*)(ws + WS_WGUT), (size_t)256 * D, (size_t)2048 * D, ptile, true, (const LAS int*)(F.lds + TAB_OFF + 480), true};
        pg8::EpiSwiglu E{ws + WS_ACT, (const float*)(ws + WS_BGU), 1.f / WQ_SCALE};
        pg8::gemm_phase<pg8::EpiSwiglu, pg8::MoeOrder, true, true>(F.lds + RING_OFF, D, S, E, (const int*)(ws + WS_ROWTOKS));
    } SEAM(9);
    if (IN(10)) { REFRESH();
        const LAS int* ptile = IN(9) ? (const LAS int*)(F.lds + TAB_OFF) : moe_tiles(F);
        pg8::MoeOrder S{ptile[32], 4, F.G, F.bx, (const char*)(ws + WS_ACT), (const char*)(ws + WS_WDT), (size_t)256 * DFF, (size_t)D * DFF, ptile, true, (const LAS int*)(F.lds + TAB_OFF + 480), false};
        pg8::EpiOut<true, true> E{(bf16*)(ws + WS_OUTROWS), D, args.in[I_BD], D, 1.f / WQ_SCALE};
        pg8::gemm_phase<pg8::EpiOut<true, true>, pg8::MoeOrder, true, true>(F.lds + RING_OFF, DFF, S, E, (const int*)(ws + WS_IDENT));
    } SEAM(10);
    if (IN(11)) { REFRESH(); phase11(args, F, IN(9)); }
#undef IN
#undef SEAM
}

extern "C" void kernel_launch(void* const* d_in, const int* in_sizes, int n_in, void* d_out, int out_size, void* d_ws, size_t ws_size, hipStream_t stream) {
    static int grid = 0;
    if (grid == 0) {
        if (n_in != 26 || in_sizes[0] != NTOK * D || out_size != NTOK * D || ws_size < WS_END) { fprintf(stderr, "kernel_launch: unexpected shapes (n_in %d, ws %zu); nothing launched\n", n_in, ws_size); grid = -1; return; }
        int dev = 0, cus = 0, per_cu = 0;
        if (hipGetDevice(&dev) != hipSuccess || hipDeviceGetAttribute(&cus, hipDeviceAttributeMultiprocessorCount, dev) != hipSuccess) { grid = -1; return; }
        if (hipFuncSetAttribute((const void*)hybrid_fwd, hipFuncAttributeMaxDynamicSharedMemorySize, LDS_BYTES) != hipSuccess) { grid = -1; return; }
        if (hipOccupancyMaxActiveBlocksPerMultiprocessor(&per_cu, (const void*)hybrid_fwd, NWAVES * 64, LDS_BYTES) != hipSuccess || per_cu < 1) { fprintf(stderr, "kernel_launch: occupancy query says %d\n", per_cu); }
        (void)hipGetLastError();
        grid = cus;
        if (NTOK % (4 * grid * NWAVES) != 0 || grid % 8 != 0 || grid * NWAVES > 32 * 16 * 32) { fprintf(stderr, "kernel_launch: grid %d does not divide the row batches; nothing launched\n", grid); grid = -1; return; }
    }
    if (grid < 0) return;
    if (hipMemsetAsync((char*)d_ws + WS_CTL, 0, CTL_ZERO_BYTES, stream) != hipSuccess) return;
    Args a{};
    for (int i = 0; i < 26; ++i) a.in[i] = (const float*)d_in[i];
    a.out = (float*)d_out; a.ws = (unsigned char*)d_ws;
    for (int li = 0; li < N_LAUNCHES; ++li) {
        a.ph_lo = (N_LAUNCHES == 1) ? 0 : li; a.ph_hi = (N_LAUNCHES == 1) ? NPHASE : li + 1;
        for (int rep = 0; rep < 1 + ((N_LAUNCHES == 1) ? 0 : ((RPT_MASK >> li) & 1)); ++rep) {
            a.sub = rep ? RPT_SUB : 0;
            hipLaunchKernelGGL(hybrid_fwd, dim3(grid), dim3(NWAVES * 64), LDS_BYTES, stream, a); }
    }
}
```
